# Optimizing an MI355X kernel written in HIP

```python
import jax, jax.numpy as jnp
from jax import lax
import numpy as np

D_MODEL = 1024
BATCH = 16
SEQ = 4096
DEPTH = 1

CTX_LEN = 256
GRID_W = 64
HEAD_DIM = 64
NA_HEADS = 8
RW_HEADS = 8
NA_WIDTH = NA_HEADS * HEAD_DIM
RW_WIDTH = RW_HEADS * HEAD_DIM
D_MIX = NA_WIDTH + RW_WIDTH
NA_KH = 8
NA_KW = 16
DECAY_LORA = 64
AAA_LORA = 64
SHORT_CONV = 3
RMS_EPS = 1e-6
GN_EPS = 64e-5

O_NA_K = 0
O_NA_V = O_NA_K + NA_WIDTH
O_RW_K = O_NA_V + NA_WIDTH
RW_PREP_W = 2 * RW_WIDTH + 2 * DECAY_LORA + 2 * AAA_LORA
O_CTX_END = O_RW_K + RW_PREP_W
O_RW_R = O_CTX_END
O_CONV_END = O_RW_R + RW_WIDTH
O_NA_Q = O_CONV_END
O_NA_G = O_NA_Q + NA_WIDTH
O_RW_G = O_NA_G + NA_WIDTH
D_IN = O_RW_G + RW_WIDTH
CONV_W = O_CONV_END - O_RW_K

kernel_name = 'hybrid_na_rwkv7_dit_block'


def _rmsnorm(x, g):
    xf = x.astype(jnp.float32)
    y = xf * lax.rsqrt(jnp.mean(xf * xf, axis=-1, keepdims=True) + RMS_EPS)
    return (y * g).astype(x.dtype)


def _modulation(cvec, w_mod, b_mod):
    m = jax.nn.silu(cvec) @ w_mod + b_mod
    return jnp.split(m, 3, axis=-1)


def _short_conv(u, w):
    up = jnp.pad(u, ((0, 0), (1, 1), (0, 0)))
    return up[:, :-2] * w[0] + up[:, 1:-1] * w[1] + up[:, 2:] * w[2]


def _na_heads(t):
    B, T, _ = t.shape
    return jnp.transpose(t.reshape(B, T, NA_HEADS, HEAD_DIM), (0, 2, 1, 3))


def _merge(t):
    B, H, T, N = t.shape
    return jnp.transpose(t, (0, 2, 1, 3)).reshape(B, T, H * N)


def _rw_heads(t):
    return t.reshape(t.shape[:-1] + (RW_HEADS, HEAD_DIM))


def _neighborhood_attention(q, k, v, kc, vc, rpb):
    B, H, T, N = q.shape
    rows = T // GRID_W
    kh = min(NA_KH, rows)
    qg = (q * HEAD_DIM ** -0.5).reshape(B, H, rows, GRID_W, N)
    kg = k.reshape(B, H, rows, GRID_W, N)
    vg = v.reshape(B, H, rows, GRID_W, N)
    col = jnp.arange(GRID_W)
    col_idx = jnp.clip(col - NA_KW // 2, 0, GRID_W - NA_KW)[:, None] + jnp.arange(NA_KW)[None, :]
    col_off = col_idx - col[:, None] + (NA_KW - 1)

    def row_block(i):
        r0 = jnp.clip(i - kh // 2, 0, rows - kh)
        kw = jnp.take(lax.dynamic_slice_in_dim(kg, r0, kh, axis=2), col_idx, axis=3)
        vw = jnp.take(lax.dynamic_slice_in_dim(vg, r0, kh, axis=2), col_idx, axis=3)
        qi = lax.dynamic_index_in_dim(qg, i, axis=2, keepdims=False)
        row_off = r0 + jnp.arange(kh) - i + (NA_KH - 1)
        bias = rpb[:, row_off][:, :, col_off]
        s_loc = jnp.einsum('bhqd,bhrqcd->bhqrc', qi, kw) + jnp.transpose(bias, (0, 2, 1, 3))
        s_ctx = jnp.einsum('bhqd,bhld->bhql', qi, kc)
        s = jnp.concatenate([s_loc.reshape(B, H, GRID_W, kh * NA_KW), s_ctx], axis=-1).astype(jnp.float32)
        pr = jax.nn.softmax(s, axis=-1).astype(v.dtype)
        p_loc = pr[..., :kh * NA_KW].reshape(B, H, GRID_W, kh, NA_KW)
        return (jnp.einsum('bhqrc,bhrqcd->bhqd', p_loc, vw)
                + jnp.einsum('bhql,bhld->bhqd', pr[..., kh * NA_KW:], vc))

    out = lax.map(row_block, jnp.arange(rows))
    return jnp.transpose(out, (1, 2, 0, 3, 4)).reshape(B, H, T, N)


def _dense_attention(q, k, v):
    s = jnp.einsum('bhqd,bhkd->bhqk', q, k).astype(jnp.float32) * HEAD_DIM ** -0.5
    pr = jax.nn.softmax(s, axis=-1).astype(v.dtype)
    return jnp.einsum('bhqk,bhkd->bhqd', pr, v)


def _rwkv_prep(u, w0, w2, a0, a2, k_k, k_a):
    B, T, _ = u.shape
    k, v, wd, ad = jnp.split(u, [RW_WIDTH, 2 * RW_WIDTH, 2 * RW_WIDTH + 2 * DECAY_LORA], axis=-1)
    wd = wd.reshape(B, T, 2, DECAY_LORA)
    ad = ad.reshape(B, T, 2, AAA_LORA)
    wlog = -jax.nn.softplus(-(w0 + jnp.einsum('btdr,drc->btdc', jnp.tanh(wd), w2))) - 0.5
    decay = jnp.exp(-jnp.exp(wlog.astype(jnp.float32)))
    a = jax.nn.sigmoid(a0 + jnp.einsum('btdr,drc->btdc', ad, a2))
    kk = _rw_heads(k * k_k).astype(jnp.float32)
    kk = kk * lax.rsqrt(jnp.maximum(jnp.sum(kk * kk, axis=-1, keepdims=True), 1e-24))
    kd = k[:, :, None] * (1.0 + (a - 1.0) * k_a)
    b = kk[:, :, None] * _rw_heads(a)
    return _rw_heads(v), _rw_heads(decay), _rw_heads(kd), kk, b


def _rwkv7_scan(s0, decay, k, kk, b, v, r, reverse):
    tm = lambda t: jnp.moveaxis(t.astype(jnp.float32), 1, 0)
    xs = (tm(decay), tm(k), tm(kk), tm(b), tm(v)) + (() if r is None else (tm(r),))

    def step(s, inp):
        w_t, k_t, kk_t, b_t, v_t = inp[:5]
        sa = jnp.einsum('bhij,bhj->bhi', s, kk_t)
        s = s * w_t[:, :, None, :] - sa[..., None] * b_t[:, :, None, :] + v_t[..., None] * k_t[:, :, None, :]
        y = None if r is None else jnp.einsum('bhij,bhj->bhi', s, inp[5])
        return s, y

    s, ys = lax.scan(step, s0, xs, reverse=reverse)
    return s, (None if r is None else jnp.moveaxis(ys, 0, 1).astype(v.dtype))


def _rwkv_readout(y, r, kd, v, r_k, gn_w, gn_b):
    B, T = y.shape[:2]
    yf = y.astype(jnp.float32)
    mu = jnp.mean(yf, axis=-1, keepdims=True)
    var = jnp.mean(jnp.square(yf - mu), axis=-1, keepdims=True)
    yn = ((yf - mu) * lax.rsqrt(var + GN_EPS)).astype(y.dtype).reshape(B, T, RW_WIDTH) * gn_w + gn_b
    bonus = jnp.sum(jnp.sum(r[:, :, None] * kd * r_k, axis=-1, keepdims=True) * v[:, :, None], axis=2)
    return yn + bonus.reshape(B, T, RW_WIDTH)


def _layer(h, hc, c, c_ctx, w_mod, b_mod, norm_g, w_in, conv_w, decay_w0, decay_w2,
           aaa_a0, aaa_a2, k_k, k_a, r_k, gn_w, gn_b, na_rpb, w_out, update_ctx):
    B = h.shape[0]
    shift, scale, gate = _modulation(c, w_mod, b_mod)
    shift_c, scale_c, gate_c = _modulation(c_ctx, w_mod, b_mod)
    xn = _rmsnorm(h, norm_g) * (1.0 + scale[:, None]) + shift[:, None]
    xc = _rmsnorm(hc, norm_g) * (1.0 + scale_c) + shift_c
    c_end = D_IN if update_ctx else O_CTX_END
    rc_end = O_CONV_END if update_ctx else O_CTX_END
    p = xn @ w_in
    pc = xc @ w_in[:, :c_end]
    rw_args = (decay_w0, decay_w2, aaa_a0, aaa_a2, k_k, k_a)

    q = _na_heads(p[..., O_NA_Q:O_NA_Q + NA_WIDTH])
    k = _na_heads(p[..., O_NA_K:O_NA_K + NA_WIDTH])
    v = _na_heads(p[..., O_NA_V:O_NA_V + NA_WIDTH])
    kc = _na_heads(pc[..., O_NA_K:O_NA_K + NA_WIDTH])
    vc = _na_heads(pc[..., O_NA_V:O_NA_V + NA_WIDTH])
    na = _merge(_neighborhood_attention(q, k, v, kc, vc, na_rpb)) * jax.nn.silu(p[..., O_NA_G:O_NA_G + NA_WIDTH])

    u = _short_conv(p[..., O_RW_K:O_CONV_END], conv_w)
    uc = _short_conv(pc[..., O_RW_K:rc_end], conv_w[:, :rc_end - O_RW_K])
    v_r, dec, kd, kk, bb = _rwkv_prep(u[..., :RW_PREP_W], *rw_args)
    r_r = _rw_heads(u[..., RW_PREP_W:])
    vc_r, dec_c, kd_c, kk_c, bb_c = _rwkv_prep(uc[..., :RW_PREP_W], *rw_args)
    rc_r = _rw_heads(uc[..., RW_PREP_W:]) if update_ctx else None
    s0 = jnp.zeros((B, RW_HEADS, HEAD_DIM, HEAD_DIM), jnp.float32)
    ys, ycs = [], []
    for d, rev in ((0, False), (1, True)):
        s_ctx, y_ctx = _rwkv7_scan(s0, dec_c[:, :, d], kd_c[:, :, d], kk_c, bb_c[:, :, d], vc_r, rc_r, rev)
        _, y = _rwkv7_scan(s_ctx, dec[:, :, d], kd[:, :, d], kk, bb[:, :, d], v_r, r_r, rev)
        ys.append(y)
        ycs.append(y_ctx)
    rw = _rwkv_readout(ys[0] + ys[1], r_r, kd, v_r, r_k, gn_w, gn_b) * jax.nn.silu(p[..., O_RW_G:O_RW_G + RW_WIDTH])

    h = h + gate[:, None] * (jnp.concatenate([na, rw], axis=-1) @ w_out)
    if update_ctx:
        qc = _na_heads(pc[..., O_NA_Q:O_NA_Q + NA_WIDTH])
        na_c = _merge(_dense_attention(qc, kc, vc)) * jax.nn.silu(pc[..., O_NA_G:O_NA_G + NA_WIDTH])
        rw_c = _rwkv_readout(ycs[0] + ycs[1], rc_r, kd_c, vc_r, r_k, gn_w, gn_b) * jax.nn.silu(pc[..., O_RW_G:O_RW_G + RW_WIDTH])
        hc = hc + gate_c * (jnp.concatenate([na_c, rw_c], axis=-1) @ w_out)
    return h, hc


def setup_inputs(seed: int = 0) -> dict:
    key = jax.random.key(seed)
    ks = jax.random.split(key, 24)
    f32 = jnp.float32
    nrm = lambda kk, shape, s: s * jax.random.normal(kk, shape, f32)
    x = nrm(ks[0], (BATCH, SEQ, D_MODEL), 1.0)
    c = nrm(ks[1], (BATCH, D_MODEL), 1.0)
    ctx = nrm(ks[2], (BATCH, CTX_LEN, D_MODEL), 1.0)
    c_ctx = nrm(ks[3], (D_MODEL,), 1.0)
    w_mod = nrm(ks[4], (DEPTH, D_MODEL, 3 * D_MODEL), 0.5 * D_MODEL ** -0.5)
    b_mod = nrm(ks[5], (DEPTH, 3 * D_MODEL), 0.01)
    norm_g = 1.0 + nrm(ks[6], (DEPTH, D_MODEL), 0.02)
    w_in = nrm(ks[7], (DEPTH, D_MODEL, D_IN), D_MODEL ** -0.5)
    taps = jnp.array([0.25, 1.0, 0.25], f32)[None, :, None]
    conv_w = taps + nrm(ks[8], (DEPTH, SHORT_CONV, CONV_W), 0.05)
    decay_w0 = jax.random.uniform(ks[9], (DEPTH, 2, RW_WIDTH), f32, -6.0, 0.0)
    decay_w2 = nrm(ks[10], (DEPTH, 2, DECAY_LORA, RW_WIDTH), 0.5 * DECAY_LORA ** -0.5)
    aaa_a0 = nrm(ks[11], (DEPTH, 2, RW_WIDTH), 0.1)
    aaa_a2 = nrm(ks[12], (DEPTH, 2, AAA_LORA, RW_WIDTH), 0.5 * AAA_LORA ** -0.5)
    k_k = 0.85 + nrm(ks[13], (DEPTH, RW_WIDTH), 0.02)
    k_a = 1.0 + nrm(ks[14], (DEPTH, RW_WIDTH), 0.02)
    r_k = nrm(ks[15], (DEPTH, RW_HEADS, HEAD_DIM), 0.1)
    gn_w = 1.0 + nrm(ks[16], (DEPTH, RW_WIDTH), 0.02)
    gn_b = nrm(ks[17], (DEPTH, RW_WIDTH), 0.01)
    na_rpb = nrm(ks[18], (DEPTH, NA_HEADS, 2 * NA_KH - 1, 2 * NA_KW - 1), 0.1)
    w_out = nrm(ks[19], (DEPTH, D_MIX, D_MODEL), D_MIX ** -0.5)
    final_g = 1.0 + nrm(ks[20], (D_MODEL,), 0.02)
    return {'x': x, 'c': c, 'ctx': ctx, 'c_ctx': c_ctx, 'w_mod': w_mod, 'b_mod': b_mod,
            'norm_g': norm_g, 'w_in': w_in, 'conv_w': conv_w, 'decay_w0': decay_w0,
            'decay_w2': decay_w2, 'aaa_a0': aaa_a0, 'aaa_a2': aaa_a2, 'k_k': k_k, 'k_a': k_a,
            'r_k': r_k, 'gn_w': gn_w, 'gn_b': gn_b, 'na_rpb': na_rpb, 'w_out': w_out,
            'final_g': final_g}


def reference(x, c, ctx, c_ctx, w_mod, b_mod, norm_g, w_in, conv_w, decay_w0, decay_w2,
              aaa_a0, aaa_a2, k_k, k_a, r_k, gn_w, gn_b, na_rpb, w_out, final_g):
    h, hc = x, ctx
    for l in range(DEPTH):
        h, hc = _layer(h, hc, c, c_ctx, w_mod[l], b_mod[l], norm_g[l], w_in[l], conv_w[l],
                       decay_w0[l], decay_w2[l], aaa_a0[l], aaa_a2[l], k_k[l], k_a[l], r_k[l],
                       gn_w[l], gn_b[l], na_rpb[l], w_out[l], update_ctx=(l < DEPTH - 1))
    return _rmsnorm(h, final_g)
```

```cpp
#include <hip/hip_runtime.h>
#include <cstdio>
#include <cstdint>
namespace pg8 {
#define PG8_LAS __attribute__((address_space(3)))
typedef unsigned short bf16_t;
typedef short bf16x8 __attribute__((ext_vector_type(8)));
typedef float f32x4 __attribute__((ext_vector_type(4)));
typedef unsigned u32x4 __attribute__((ext_vector_type(4)));
constexpr int BM = 256, BK = 64, HALF = 128, HTB = HALF * BK * 2  , STAGE_BYTES = 8 * HTB, NXCD = 8, WGM = 8;

__host__ __device__ __forceinline__ int lds_byte(int r, int c) { const int st = (r >> 4) * 2 + (c >> 5), rr = r & 15, cc = c & 31, ob = rr * 64 + cc * 2; return st * 1024 + (ob ^ (((ob >> 9) & 1) << 5)); }
__host__ __device__ __forceinline__ void stage_rc(int b, int& R, int& C) { const int st = b / 1024, sb = b % 1024, swz = sb ^ (((sb >> 9) & 1) << 5); R = (st >> 1) * 16 + swz / 64; C = (st & 1) * 32 + (swz % 64) / 2; }
__host__ __device__ __forceinline__ int perm32(int rho) { const int n = rho >> 4, i = rho & 15; return 8 * (i >> 2) + 4 * n + (i & 3); }

struct Unit { int pm, pn; };
struct Gemm { const bf16_t* A; const bf16_t* Bt; int M, N, K; };

struct StaticOrder {
    int nM, nN, nwg, G, c;
    __host__ __device__ void init(int M, int N, int G_, int c_) { nM = M / BM; nN = N / BM; nwg = nM * nN; G = G_; c = c_; }
    __host__ __device__ bool next(int i, Unit& u) const {
        const long L = (long)i * G + c; if (L >= nwg) return false;
        int wgid = (int)L; { const int q = nwg / NXCD, r = nwg % NXCD, xcd = wgid % NXCD, off = wgid / NXCD; wgid = (xcd < r ? xcd * (q + 1) : r * (q + 1) + (xcd - r) * q) + off; }
        const int nig = WGM * nN, gid = wgid / nig, fm = gid * WGM, gsz = (nM - fm) < WGM ? (nM - fm) : WGM;
        u.pm = fm + ((wgid % nig) % gsz); u.pn = (wgid % nig) / gsz; return true;
    }
    __device__ __forceinline__ void a_ready(const Unit&) const {}
    __device__ __forceinline__ void done(const Unit&) const {}
};

__device__ __forceinline__ unsigned cvt_pk_bf16(float lo, float hi) { unsigned r; asm volatile("v_cvt_pk_bf16_f32 %0, %1, %2" : "=v"(r) : "v"(lo), "v"(hi)); return r; }
typedef float f32x2 __attribute__((ext_vector_type(2)));
__device__ __forceinline__ f32x2 gelu_pk(f32x2 v) {
    const f32x2 av = __builtin_elementwise_abs(v), d = av * 0.2316418882f + 1.0f;
    f32x2 t; t.x = __builtin_amdgcn_rcpf(d.x); t.y = __builtin_amdgcn_rcpf(d.y);
    f32x2 q = t * 0.5307027145f + (-0.7265760135f); q = q * t + 0.7107068705f; q = q * t + (-0.142248368f); q = q * t + 0.127414796f; q = q * t;
    const f32x2 s = (v * v) * (-0.72134752044f);
    f32x2 e; e.x = __builtin_amdgcn_exp2f(s.x); e.y = __builtin_amdgcn_exp2f(s.y);
    const f32x2 m = v * (q * e), r = v - m;
    f32x2 o; o.x = v.x < 0.f ? m.x : r.x; o.y = v.y < 0.f ? m.y : r.y; return o;
}

template <int ACT  > struct EpiBf16 {
    static constexpr bool PERM = true, AFTER_DRAIN = false; static_assert(ACT == 0 || ACT == 1, "EpiBf16: ACT is 0 (none) or 1 (gelu_pk)");
    bf16_t* O; int ldc; const float* bias; int split_cols; size_t split_stride; float scale0;
    __device__ __forceinline__ void operator()(const f32x4 (&acc)[2][2][4][2], const Unit& u, int wr, int wc, int fr, int fq) const {
        const int row0 = u.pm * BM + wr * 64 + fr; int colt = u.pn * BM; bf16_t* base = O;
        float sc = 1.f; if (split_cols) { const int t = colt / split_cols; base += (size_t)t * split_stride; colt -= t * split_cols; if (t == 0) sc = scale0; }
        const int col0 = colt + wc * 32 + 8 * fq, bcol0 = u.pn * BM + wc * 32 + 8 * fq;
        f32x4 bv[2][2];
#pragma unroll
        for (int bj = 0; bj < 2; ++bj)
#pragma unroll
            for (int n = 0; n < 2; ++n) bv[bj][n] = bias ? *(const f32x4*)(bias + bcol0 + bj * HALF + 4 * n) : (f32x4){0.f, 0.f, 0.f, 0.f};
#pragma unroll
        for (int ai = 0; ai < 2; ++ai)
#pragma unroll
            for (int m = 0; m < 4; ++m) { bf16_t* rowp = base + (size_t)(row0 + ai * HALF + m * 16) * ldc + col0;
#pragma unroll
                for (int bj = 0; bj < 2; ++bj) { f32x4 v0 = acc[ai][bj][m][0] + bv[bj][0], v1 = acc[ai][bj][m][1] + bv[bj][1];
                    if (ACT == 1) { f32x2 a = gelu_pk((f32x2){v0[0], v0[1]}), b = gelu_pk((f32x2){v0[2], v0[3]}), c = gelu_pk((f32x2){v1[0], v1[1]}), d = gelu_pk((f32x2){v1[2], v1[3]});
                        v0 = (f32x4){a.x, a.y, b.x, b.y}; v1 = (f32x4){c.x, c.y, d.x, d.y}; }
                    v0 = v0 * sc; v1 = v1 * sc; u32x4 w; w.x = cvt_pk_bf16(v0[0], v0[1]); w.y = cvt_pk_bf16(v0[2], v0[3]); w.z = cvt_pk_bf16(v1[0], v1[1]); w.w = cvt_pk_bf16(v1[2], v1[3]);
                    *(u32x4*)(rowp + bj * HALF) = w; } }
    }
};

struct EpiOut {
    static constexpr bool PERM = false, AFTER_DRAIN = false;
    const float* x; const float* mod; float* out; float* sumsq;
    __device__ __forceinline__ void operator()(const f32x4 (&acc)[2][2][4][2], const Unit& u, int wr, int wc, int fr, int fq) const {
        const int col0 = u.pn * BM + wc * 32 + 4 * fq;
        const int b = (u.pm * BM) >> 12;
        const float* gate = mod + b * 3072 + 2048;
        f32x4 gv[2][2];
#pragma unroll
        for (int bj = 0; bj < 2; ++bj)
#pragma unroll
            for (int n = 0; n < 2; ++n) gv[bj][n] = *(const f32x4*)(gate + col0 + bj * HALF + n * 16);
#pragma unroll
        for (int ai = 0; ai < 2; ++ai)
#pragma unroll
            for (int m = 0; m < 4; ++m) {
                const int row = u.pm * BM + ai * HALF + wr * 64 + m * 16 + fr;
                const size_t off = (size_t)row * 1024 + col0;
                float ss = 0.f;
#pragma unroll
                for (int bj = 0; bj < 2; ++bj)
#pragma unroll
                    for (int n = 0; n < 2; ++n) {
                        const f32x4 xv = *(const f32x4*)(x + off + bj * HALF + n * 16);
                        const f32x4 o = xv + gv[bj][n] * acc[ai][bj][m][n];
                        *(f32x4*)(out + off + bj * HALF + n * 16) = o;
                        ss += (o[0] * o[0] + o[1] * o[1]) + (o[2] * o[2] + o[3] * o[3]);
                    }
                ss += __shfl_xor(ss, 16); ss += __shfl_xor(ss, 32);
                if (fq == 0) atomicAdd(sumsq + row, ss);
                asm volatile("" ::: "memory");
            }
    }
};
template <class Epi, class Sched, bool ALIGN_EPI = false, bool SP2 = false>
__device__ __forceinline__ void gemm_phase(PG8_LAS unsigned char* lds, const Gemm g, const Sched& S, const Epi& E) {
    const int tid = threadIdx.x, wid = __builtin_amdgcn_readfirstlane(tid >> 6), lane = tid & 63, wr = wid >> 2, wc = wid & 3, fr = lane & 15, fq = lane >> 4;
    const int K = g.K, nt = K / BK;
    unsigned voffA[2], voffB[2];
#pragma unroll
    for (int i = 0; i < 2; ++i) { int R, C; stage_rc(tid * 16 + i * 8192, R, C); const int Rb = Epi::PERM ? ((R & ~31) + perm32(R & 31)) : R;
        voffA[i] = (unsigned)(R * K + C) * 2u; voffB[i] = (unsigned)(Rb * K + C) * 2u; }
    const size_t kstep = (size_t)(BK * 2);
    const size_t hstep = (size_t)HALF * K * 2;
    const size_t tstep = 2 * hstep;
    const unsigned ldsw = (unsigned)wid * 1024u;
    const int aoff = lds_byte(wr * 64 + fr, fq * 8), boff = lds_byte(wc * 32 + fr, fq * 8);
#define PG8_SA(b, h) (((b) * 2 + (h)) * HTB)
#define PG8_SB(b, h) ((4 + (b) * 2 + (h)) * HTB)
#define PG8_STAGE(bufoff, gbase, voff) do { _Pragma("unroll") for (int _i = 0; _i < 2; ++_i) \
        __builtin_amdgcn_global_load_lds((const unsigned*)((const char*)(gbase) + (voff)[_i]), (PG8_LAS unsigned*)(lds + (bufoff) + ldsw + _i * 8192), 16, 0, 0); } while (0)
#define PG8_LDA(dst, b, h) do { _Pragma("unroll") for (int m = 0; m < 4; ++m) _Pragma("unroll") for (int k = 0; k < 2; ++k) dst[m][k] = *(const PG8_LAS bf16x8*)(lds + PG8_SA(b, h) + aoff + m * 2048 + k * 1024); } while (0)
#define PG8_LDB(dst, b, h) do { _Pragma("unroll") for (int n = 0; n < 2; ++n) _Pragma("unroll") for (int k = 0; k < 2; ++k) dst[n][k] = *(const PG8_LAS bf16x8*)(lds + PG8_SB(b, h) + boff + n * 2048 + k * 1024); } while (0)
#define PG8_MMA(ai, bj, At, Bt) do { __builtin_amdgcn_s_setprio(1); _Pragma("unroll") for (int m = 0; m < 4; ++m) _Pragma("unroll") for (int n = 0; n < 2; ++n) _Pragma("unroll") for (int k = 0; k < 2; ++k) \
        acc[ai][bj][m][n] = __builtin_amdgcn_mfma_f32_16x16x32_bf16(Bt[n][k], At[m][k], acc[ai][bj][m][n], 0, 0, 0); __builtin_amdgcn_s_setprio(0); } while (0)
#define PG8_WAIT_V(n) asm volatile("s_waitcnt vmcnt(" #n ")" ::: "memory")
#define PG8_WAIT_L(n) asm volatile("s_waitcnt lgkmcnt(" #n ")" ::: "memory")
#define PG8_BAR __builtin_amdgcn_s_barrier()
#define PG8_SCHED __builtin_amdgcn_sched_barrier(0)
    Unit cur, nxt; int ui = 0;
    if (!S.next(0, cur)) return;
    f32x4 acc[2][2][4][2];
#pragma unroll
    for (int a = 0; a < 2; ++a)
#pragma unroll
        for (int b = 0; b < 2; ++b)
#pragma unroll
            for (int m = 0; m < 4; ++m)
#pragma unroll
                for (int n = 0; n < 2; ++n) acc[a][b][m][n] = (f32x4){0.f, 0.f, 0.f, 0.f};
    bf16x8 At[4][2], B0[2][2], B1[2][2];
    const char* cA = (const char*)g.A + (size_t)cur.pm * tstep; const char* cB = (const char*)g.Bt + (size_t)cur.pn * tstep;
    S.a_ready(cur);
    if constexpr (SP2) {
        PG8_STAGE(PG8_SB(0, 0), cB, voffB); PG8_STAGE(PG8_SB(0, 1), cB + hstep, voffB); PG8_STAGE(PG8_SA(0, 0), cA, voffA); PG8_STAGE(PG8_SA(0, 1), cA + hstep, voffA);
        if (wr == 1) PG8_BAR;
        PG8_WAIT_V(2); PG8_BAR;
        PG8_STAGE(PG8_SB(1, 0), cB + kstep, voffB); PG8_STAGE(PG8_SA(1, 0), cA + kstep, voffA); PG8_STAGE(PG8_SB(1, 1), cB + hstep + kstep, voffB);
        PG8_WAIT_V(6); PG8_BAR;
    } else {
        PG8_STAGE(PG8_SB(0, 0), cB, voffB); PG8_STAGE(PG8_SA(0, 0), cA, voffA); PG8_STAGE(PG8_SB(0, 1), cB + hstep, voffB); PG8_STAGE(PG8_SA(0, 1), cA + hstep, voffA);
        if (wr == 1) PG8_BAR;
        PG8_WAIT_V(4); PG8_BAR;
        PG8_STAGE(PG8_SB(1, 0), cB + kstep, voffB); PG8_STAGE(PG8_SA(1, 0), cA + kstep, voffA); PG8_STAGE(PG8_SB(1, 1), cB + hstep + kstep, voffB);
        PG8_WAIT_V(6); PG8_BAR;
    }
    for (;;) {
        const bool has_next = S.next(ui + 1, nxt);
        const char* nA = has_next ? (const char*)g.A + (size_t)nxt.pm * tstep : cA; const char* nB = has_next ? (const char*)g.Bt + (size_t)nxt.pn * tstep : cB;
        for (int t = 0; t < nt; t += 2) {
            const bool last = (t == nt - 2);
            const char* a1 = cA + (size_t)(t + 1) * kstep;
            const char* a2 = last ? nA : cA + (size_t)(t + 2) * kstep; const char* b2 = last ? nB : cB + (size_t)(t + 2) * kstep;
            const char* a3 = a2 + kstep; const char* b3 = b2 + kstep;
            if (last && has_next) S.a_ready(nxt);
            if constexpr (SP2) {
            PG8_LDB(B0, 0, 0); PG8_LDB(B1, 0, 1); PG8_SCHED; PG8_LDA(At, 0, 0); PG8_STAGE(PG8_SA(1, 1), a1 + hstep, voffA);
            PG8_WAIT_V(8); PG8_WAIT_L(0); PG8_BAR; PG8_MMA(0, 0, At, B0); PG8_MMA(0, 1, At, B1); PG8_BAR; PG8_SCHED;
            PG8_LDA(At, 0, 1); PG8_STAGE(PG8_SB(0, 0), b2, voffB); PG8_STAGE(PG8_SB(0, 1), b2 + hstep, voffB); PG8_STAGE(PG8_SA(0, 0), a2, voffA);
            PG8_WAIT_V(8); PG8_WAIT_L(0); PG8_BAR; PG8_MMA(1, 0, At, B0); PG8_MMA(1, 1, At, B1); PG8_BAR; PG8_SCHED;
            PG8_LDB(B0, 1, 0); PG8_LDB(B1, 1, 1); PG8_SCHED; PG8_LDA(At, 1, 0); PG8_STAGE(PG8_SA(0, 1), a2 + hstep, voffA);
            PG8_WAIT_V(8); PG8_WAIT_L(0); PG8_BAR; PG8_MMA(0, 0, At, B0); PG8_MMA(0, 1, At, B1); PG8_BAR; PG8_SCHED;
            PG8_LDA(At, 1, 1); PG8_STAGE(PG8_SB(1, 0), b3, voffB); PG8_STAGE(PG8_SB(1, 1), b3 + hstep, voffB); PG8_STAGE(PG8_SA(1, 0), a3, voffA);
            PG8_WAIT_V(8); PG8_WAIT_L(0); PG8_BAR; PG8_MMA(1, 0, At, B0); PG8_MMA(1, 1, At, B1); PG8_BAR; PG8_SCHED;
            } else {
            PG8_LDB(B0, 0, 0); PG8_SCHED; PG8_LDA(At, 0, 0); PG8_STAGE(PG8_SA(1, 1), a1 + hstep, voffA);
            PG8_WAIT_L(8); PG8_BAR; PG8_WAIT_L(0); PG8_MMA(0, 0, At, B0); PG8_BAR; PG8_SCHED;
            PG8_LDB(B1, 0, 1); PG8_STAGE(PG8_SB(0, 0), b2, voffB);
            PG8_BAR; PG8_WAIT_L(0); PG8_MMA(0, 1, At, B1); PG8_BAR;
            PG8_LDA(At, 0, 1); PG8_STAGE(PG8_SA(0, 0), a2, voffA);
            PG8_BAR; PG8_WAIT_L(0); PG8_MMA(1, 0, At, B0); PG8_BAR; PG8_SCHED;
            PG8_STAGE(PG8_SB(0, 1), b2 + hstep, voffB);
            PG8_WAIT_V(6); PG8_BAR; PG8_MMA(1, 1, At, B1); PG8_BAR;
            PG8_LDB(B0, 1, 0); PG8_SCHED; PG8_LDA(At, 1, 0); PG8_STAGE(PG8_SA(0, 1), a2 + hstep, voffA);
            PG8_WAIT_L(8); PG8_BAR; PG8_WAIT_L(0); PG8_MMA(0, 0, At, B0); PG8_BAR; PG8_SCHED;
            PG8_LDB(B1, 1, 1); PG8_STAGE(PG8_SB(1, 0), b3, voffB);
            PG8_BAR; PG8_WAIT_L(0); PG8_MMA(0, 1, At, B1); PG8_BAR;
            PG8_LDA(At, 1, 1); PG8_STAGE(PG8_SA(1, 0), a3, voffA);
            PG8_BAR; PG8_WAIT_L(0); PG8_MMA(1, 0, At, B0); PG8_BAR; PG8_SCHED;
            PG8_STAGE(PG8_SB(1, 1), b3 + hstep, voffB);
            PG8_WAIT_V(6); PG8_BAR; PG8_MMA(1, 1, At, B1); PG8_BAR;
            }
        }
        if constexpr (ALIGN_EPI) { if (wr == 0) PG8_BAR; }
        if constexpr (!Epi::AFTER_DRAIN) { E(acc, cur, wr, wc, fr, fq); S.done(cur); }
        if (!has_next) break;
#pragma unroll
        for (int a = 0; a < 2; ++a)
#pragma unroll
            for (int b = 0; b < 2; ++b)
#pragma unroll
                for (int m = 0; m < 4; ++m)
#pragma unroll
                    for (int n = 0; n < 2; ++n) acc[a][b][m][n] = (f32x4){0.f, 0.f, 0.f, 0.f};
        cur = nxt; cA = nA; cB = nB; ++ui;
        if constexpr (ALIGN_EPI) { if (wr == 1) PG8_BAR; }
    }
    PG8_WAIT_V(0);
    if constexpr (!ALIGN_EPI) { if (wr == 0) PG8_BAR; }
    PG8_BAR;
    if constexpr (Epi::AFTER_DRAIN) { E.fused(acc, cur, wr, wc, fr, fq, lds, wid, lane); S.done(cur); }
#undef PG8_SA
#undef PG8_SB
#undef PG8_STAGE
#undef PG8_LDA
#undef PG8_LDB
#undef PG8_MMA
#undef PG8_WAIT_V
#undef PG8_WAIT_L
#undef PG8_BAR
#undef PG8_SCHED
}
}
#define GAS __attribute__((address_space(1)))
#define LAS __attribute__((address_space(3)))
typedef unsigned short bf16;
typedef unsigned v4u __attribute__((ext_vector_type(4)));
typedef float f32x4 __attribute__((ext_vector_type(4)));
typedef short bf16x8 __attribute__((ext_vector_type(8)));
typedef GAS unsigned gu32;
typedef GAS unsigned long long gu64;
#define RLX_AGENT __ATOMIC_RELAXED, __HIP_MEMORY_SCOPE_AGENT
#define LDS_WAIT() asm volatile("s_waitcnt lgkmcnt(0)" ::: "memory")
#define VM_WAIT() asm volatile("s_waitcnt vmcnt(0)" ::: "memory")
__device__ __forceinline__ unsigned long long rt() { return __builtin_amdgcn_s_memrealtime(); }
__device__ __forceinline__ unsigned f2bf(float f) { unsigned u = __builtin_bit_cast(unsigned, f); return (u + 0x7fffu + ((u >> 16) & 1u)) >> 16; }
__device__ __forceinline__ unsigned pk2(float lo, float hi) { return f2bf(lo) | (f2bf(hi) << 16); }

#define XB_TMO      128
#define XB_XCNT(j)  (256  + 64 * (j))
#define XB_XSUB(j)  (1280 + 64 * (j))
#define XB_XGEN(j)  (2304 + 64 * (j))
#define XB_TOP      3328
#define XB_TOPGEN   3392
#define XCD_BAR_WORDS 3456
#define XB_SPIN_CAP (1u << 18)

__device__ __forceinline__ unsigned xb_ld(unsigned* p)              { return __hip_atomic_load(p, __ATOMIC_RELAXED, __HIP_MEMORY_SCOPE_AGENT); }
__device__ __forceinline__ unsigned xb_add(unsigned* p, unsigned v) { return __hip_atomic_fetch_add(p, v, __ATOMIC_RELAXED, __HIP_MEMORY_SCOPE_AGENT); }
__device__ __forceinline__ unsigned xb_xcc_id() { return (unsigned)__builtin_amdgcn_s_getreg((3 << 11) | 20) & 0xFu; }
#define XB_SPIN(cond, bar) do { unsigned _sp = 0; while (cond) { __builtin_amdgcn_s_sleep(1); \
    if ((++_sp & 255u) == 0u) { if (xb_ld(&(bar)[XB_TMO])) break; if (_sp > XB_SPIN_CAP) { atomicAdd(&(bar)[XB_TMO], 1u); break; } } } } while (0)

struct XcdBarrier {
    unsigned* bar; unsigned x;
    volatile LAS unsigned* st;
};

__device__ __forceinline__ XcdBarrier xcd_barrier_post(unsigned* bar, volatile LAS unsigned* st) {
    XcdBarrier b; b.bar = bar; b.x = xb_xcc_id(); b.st = st;
    if (threadIdx.x == 0) (void)xb_add(&bar[XB_XCNT(b.x)], 1u);
    return b;
}
__device__ __forceinline__ void xcd_barrier_complete(unsigned* bar, unsigned x, unsigned& nloc, unsigned& nx) {
    const unsigned G = gridDim.x * gridDim.y * gridDim.z;
    unsigned sum, cnt, mine, sp = 0u;
    for (;;) {
        sum = 0u; cnt = 0u; mine = 0u;
#pragma unroll
        for (unsigned j = 0; j < 16; ++j) { const unsigned c = xb_ld(&bar[XB_XCNT(j)]); sum += c; cnt += (c > 0u) ? 1u : 0u; mine = (j == x) ? c : mine; }
        if (sum == G) break;
        __builtin_amdgcn_s_sleep(1);
        if ((++sp & 255u) == 0u) { if (xb_ld(&bar[XB_TMO])) break; if (sp > XB_SPIN_CAP) { atomicAdd(&bar[XB_TMO], 1u); break; } }
    }
    nloc = mine > 0u ? mine : 1u; nx = cnt > 0u ? cnt : 1u;
}

__device__ __forceinline__ void xcd_barrier(const XcdBarrier& b) {
    asm volatile("s_waitcnt vmcnt(0)" ::: "memory");
    __syncthreads();
    if (threadIdx.x == 0) {
        unsigned* bar = b.bar;
        __builtin_amdgcn_s_waitcnt(0);
        unsigned nloc = b.st[0], nx = b.st[1];
        if (nloc == 0u) { xcd_barrier_complete(bar, b.x, nloc, nx); b.st[0] = nloc; b.st[1] = nx; }
        const unsigned old = xb_add(&bar[XB_XSUB(b.x)], 1u);
        const unsigned gen = old / nloc;
        if (old + 1u == (gen + 1u) * nloc) {
            __builtin_amdgcn_fence(__ATOMIC_RELEASE, "agent");
            asm volatile("s_waitcnt vmcnt(0)" ::: "memory");
            const unsigned og = xb_add(&bar[XB_TOP], 1u);
            const unsigned tg = og / nx;
            if (og + 1u == (tg + 1u) * nx) xb_add(&bar[XB_TOPGEN], 1u);
            else XB_SPIN(xb_ld(&bar[XB_TOPGEN]) == tg, bar);
            __builtin_amdgcn_fence(__ATOMIC_ACQUIRE, "agent");
            xb_add(&bar[XB_XGEN(b.x)], 1u);
            asm volatile("s_waitcnt vmcnt(0)" ::: "memory");
        } else {
            XB_SPIN(xb_ld(&bar[XB_XGEN(b.x)]) == gen, bar);
            __builtin_amdgcn_fence(__ATOMIC_ACQUIRE, "agent");
            asm volatile("s_waitcnt vmcnt(0)" ::: "memory");
        }
    }
    __syncthreads();
}

constexpr int NWAVES = 8;
constexpr int DM = 1024, NB = 16, SEQ = 4096, CTXL = 256, NH = 8, HD = 64;
constexpr int ML = NB * SEQ;
constexpr int MC = NB * CTXL;
constexpr int MT = ML + MC;
constexpr int PW = 3840;
constexpr int PCW = 1792;
constexpr int PC_NAK = 0, PC_RWK = 512, PC_RWV = 1024, PC_WD = 1536, PC_AD = 1664, PC_RWR = 1792, PC_NAQ = 2304, PC_NAG = 2816, PC_RWG = 3328;
constexpr float RMS_EPS = 1e-6f, GN_EPS = 64e-5f;
constexpr float LOG2E = 1.4426950408889634f;

constexpr size_t MiB = 1u << 20;
constexpr size_t WS_CTL = 0, CTL_ZERO_BYTES = 1 * MiB;
constexpr size_t WS_MOD = 256 * 1024;
constexpr size_t WS_SUMSQ = 512 * 1024;
constexpr size_t WS_WOUT = 2 * MiB;
constexpr size_t WS_WIN = 4 * MiB;
constexpr size_t WS_BONUS = 16 * MiB;
constexpr size_t WS_XN = 32 * MiB;
constexpr size_t WS_P = 168 * MiB;
constexpr size_t WS_VT = 678 * MiB;
constexpr size_t WS_MIX = 746 * MiB;
constexpr size_t WS_END = 874 * MiB;
static_assert(WS_WIN + (size_t)4352 * 1024 * 2 <= WS_BONUS && WS_BONUS + (size_t)ML * 16 * 4 <= WS_XN && WS_XN + (size_t)MT * 1024 * 2 <= WS_P && WS_P + (size_t)MT * PW * 2 <= WS_VT && WS_VT + (size_t)512 * MT * 2 <= WS_MIX && WS_MIX + (size_t)ML * 1024 * 2 <= WS_END, "ws map");
constexpr int CW_BAR = 4096;

constexpr int LDS_BYTES = 160 * 1024;
constexpr int MISC_OFF = LDS_BYTES - 256;

struct Frame {
    LAS unsigned char* lds;
    int tid, lane, wave, vcu, G;
    const float *x, *c, *ctx, *c_ctx, *w_mod, *b_mod, *norm_g, *w_in, *conv_w, *decay_w0, *decay_w2, *aaa_a0, *aaa_a2, *k_k, *k_a, *r_k, *gn_w, *gn_b, *na_rpb, *w_out, *final_g;
    float* out;
    float *mod, *sumsq, *bonus;
    bf16 *WoutT, *WinT, *XN, *P, *VT, *MIX;
};

__device__ __forceinline__ float wave_sum(float v) {
#pragma unroll
    for (int o = 1; o < 64; o <<= 1) v += __shfl_xor(v, o);
    return v;
}
__device__ __forceinline__ float bf2f(unsigned h) { return __uint_as_float(h << 16); }
__device__ __forceinline__ float sigmoidf_(float x) { return 1.f / (1.f + __expf(-x)); }
__device__ __forceinline__ float siluf_(float x) { return x / (1.f + __expf(-x)); }
typedef float f32x16 __attribute__((ext_vector_type(16)));
typedef unsigned u32x2 __attribute__((ext_vector_type(2)));

__device__ __forceinline__ void p0_transpose_item(const float* W, int K, int N, bf16* WT, int k0, int n0, int drow0, LAS float* scr, int lane) {
#pragma unroll 8
    for (int i = 0; i < 32; ++i) { const int kk = 2 * i + (lane >> 5); scr[kk * 33 + (lane & 31)] = W[(size_t)(k0 + kk) * N + n0 + (lane & 31)]; }
    LDS_WAIT(); asm volatile("" ::: "memory");
    const int c = lane & 7;
#pragma unroll
    for (int j = 0; j < 4; ++j) { const int n = (lane >> 3) + 8 * j; const LAS float* s = scr + (8 * c) * 33 + n;
        v4u o; o.x = pk2(s[0 * 33], s[1 * 33]); o.y = pk2(s[2 * 33], s[3 * 33]); o.z = pk2(s[4 * 33], s[5 * 33]); o.w = pk2(s[6 * 33], s[7 * 33]);
        *(GAS v4u*)(WT + (size_t)(drow0 + n) * K + k0 + 8 * c) = o; }
    LDS_WAIT(); asm volatile("" ::: "memory");
}
__device__ __forceinline__ void p0_prologue(Frame& F) {
    LAS float* scr = (LAS float*)(F.lds + F.wave * 16384);
    const int gw = F.vcu * NWAVES + F.wave, NGW = F.G * NWAVES;
    for (int it = gw; it < 48 * 32; it += NGW) {
        const int cc = it % 48, ks = it / 48, n = cc * 64 + F.lane, k0 = ks * 32;
        for (int e = F.lane; e < 17 * 32; e += 64) { const int row = e >> 5, kk = e & 31; const float cv = (row < 16) ? F.c[row * 1024 + k0 + kk] : F.c_ctx[k0 + kk]; scr[e] = siluf_(cv); }
        LDS_WAIT(); asm volatile("" ::: "memory");
        float acc[17];
#pragma unroll
        for (int r = 0; r < 17; ++r) acc[r] = 0.f;
        for (int kk = 0; kk < 32; ++kk) { const float w = F.w_mod[(size_t)(k0 + kk) * 3072 + n];
#pragma unroll
            for (int r = 0; r < 17; ++r) acc[r] += scr[r * 32 + kk] * w; }
        if (ks == 0) { const float bb = F.b_mod[n];
#pragma unroll
            for (int r = 0; r < 17; ++r) acc[r] += bb; }
#pragma unroll
        for (int r = 0; r < 17; ++r) atomicAdd(F.mod + r * 3072 + n, acc[r]);
        LDS_WAIT(); asm volatile("" ::: "memory");
    }
    constexpr int I_IN = 16 * 136, I_OUT = 16 * 32;
    for (int it = gw; it < I_IN + I_OUT; it += NGW) {
        if (it < I_IN) { const int kb = it / 136, nb = it % 136, n0 = nb * 32; const int drow0 = (n0 < 512) ? n0 : (n0 < 1024 ? n0 + 3328 : n0 - 512);
            p0_transpose_item(F.w_in, 1024, 4352, F.WinT, kb * 64, n0, drow0, scr, F.lane); }
        else { const int r = it - I_IN, kb = r / 32, nb = r % 32; p0_transpose_item(F.w_out, 1024, 1024, F.WoutT, kb * 64, nb * 32, nb * 32, scr, F.lane); }
    }
}

__device__ __forceinline__ void p1_xn(Frame& F) {
    const int gw = F.vcu * NWAVES + F.wave, NGW = F.G * NWAVES;
    for (int m = gw; m < MT; m += NGW) {
        const float* xrow; const float* md;
        if (m < ML) { xrow = F.x + (size_t)m * DM; md = F.mod + (m >> 12) * 3072; } else { xrow = F.ctx + (size_t)(m - ML) * DM; md = F.mod + 16 * 3072; }
        const GAS f32x4* xr = (const GAS f32x4*)xrow + F.lane;
        f32x4 v[4]; float s = 0.f;
#pragma unroll
        for (int j = 0; j < 4; ++j) { v[j] = xr[64 * j]; s += (v[j].x * v[j].x + v[j].y * v[j].y) + (v[j].z * v[j].z + v[j].w * v[j].w); }
        const float rstd = rsqrtf(wave_sum(s) * (1.f / DM) + RMS_EPS);
        GAS unsigned long long* o8 = (GAS unsigned long long*)(F.XN + (size_t)m * DM) + F.lane;
#pragma unroll
        for (int j = 0; j < 4; ++j) {
            const int c0 = 4 * (F.lane + 64 * j);
            const f32x4 g = *(const f32x4*)(F.norm_g + c0), sh = *(const f32x4*)(md + c0), sc = *(const f32x4*)(md + 1024 + c0);
            const f32x4 y = (v[j] * rstd * g) * (sc + 1.0f) + sh;
            o8[64 * j] = (unsigned long long)pk2(y.x, y.y) | ((unsigned long long)pk2(y.z, y.w) << 32);
        }
    }
}

__device__ __forceinline__ void p3_attention(Frame& F) {
    LAS float* wsf = (LAS float*)(F.lds + F.wave * 4096);
    LAS float* bt = wsf + 64;
    const int lane = F.lane, q = lane & 31, hh = lane >> 5;
    const int gw = F.vcu * NWAVES + F.wave, NGW = F.G * NWAVES;
    const float C2 = 0.125f * LOG2E;
    for (int u0 = gw * 8; u0 < NB * NH * 64 * 2; u0 += NGW * 8) {
        const int h = (u0 >> 7) & 7, b = u0 >> 10;
        for (int e = lane; e < 15 * 31; e += 64) bt[e] = F.na_rpb[h * 465 + e] * LOG2E;
        for (int uu = 0; uu < 8; ++uu) {
            const int u = u0 + uu, J = u & 1, i = (u >> 1) & 63;
            const int r0 = min(max(i - 4, 0), 56);
            const int qc = 32 * J + q, c0 = min(max(qc - 8, 0), 48);
            const size_t qrow = (size_t)(b * SEQ + i * 64 + qc);
            bf16x8 qf[4];
#pragma unroll
            for (int s = 0; s < 4; ++s) qf[s] = *(const bf16x8*)(F.P + qrow * PW + PC_NAQ + h * 64 + 16 * s + 8 * hh);
            float m_run = -1e30f, l_run = 0.f;
            f32x16 o0, o1;
#pragma unroll
            for (int r = 0; r < 16; ++r) { o0[r] = 0.f; o1[r] = 0.f; }
            for (int tile = 0; tile < 20; ++tile) {
                const bool loc = tile >= 8;
                const int lt = tile - 8, rp = lt / 3, cb = J + lt % 3;
                const size_t krow = loc ? (size_t)(b * SEQ + (r0 + 2 * rp + (q >> 4)) * 64 + 16 * cb + (q & 15)) : (size_t)(ML + b * CTXL + 32 * tile + q);
                bf16x8 kf[4];
#pragma unroll
                for (int s = 0; s < 4; ++s) kf[s] = *(const bf16x8*)(F.P + krow * PW + PC_NAK + h * 64 + 16 * s + 8 * hh);
                const size_t tc0 = loc ? (size_t)(b * SEQ + (r0 + 2 * rp) * 64 + 16 * cb) : (size_t)(ML + b * CTXL + 32 * tile);
                const size_t tstep = loc ? 64 : 16;
                bf16x8 vf[2][2];
#pragma unroll
                for (int db = 0; db < 2; ++db)
#pragma unroll
                    for (int s = 0; s < 2; ++s) {
                        const bf16* vp = F.VT + (size_t)(h * 64 + 32 * db + q) * MT + tc0 + s * tstep + 4 * hh;
                        const u32x2 lo = *(const u32x2*)vp, hi = *(const u32x2*)(vp + 8);
                        v4u w; w.x = lo.x; w.y = lo.y; w.z = hi.x; w.w = hi.y;
                        vf[db][s] = __builtin_bit_cast(bf16x8, w);
                    }
                f32x16 sc;
#pragma unroll
                for (int r = 0; r < 16; ++r) sc[r] = 0.f;
#pragma unroll
                for (int s = 0; s < 4; ++s) sc = __builtin_amdgcn_mfma_f32_32x32x16_bf16(kf[s], qf[s], sc, 0, 0, 0);
                float tmax = -1e30f;
#pragma unroll
                for (int r = 0; r < 16; ++r) {
                    const int kr = (r & 3) + 8 * (r >> 2) + 4 * hh;
                    float val = sc[r] * C2;
                    if (loc) {
                        const int krow_g = r0 + 2 * rp + (kr >> 4), kcol = 16 * cb + (kr & 15), dc = kcol - c0;
                        const bool valid = (unsigned)dc < 16u;
                        const int bidx = valid ? (krow_g - i + 7) * 31 + (kcol - qc + 15) : 0;
                        val = valid ? val + bt[bidx] : -1e30f;
                    }
                    sc[r] = val; tmax = fmaxf(tmax, val);
                }
                tmax = fmaxf(tmax, __shfl_xor(tmax, 32));
                const float m_new = fmaxf(m_run, tmax), alpha = exp2f(m_run - m_new);
                m_run = m_new;
                float psum = 0.f;
#pragma unroll
                for (int r = 0; r < 16; ++r) { sc[r] = exp2f(sc[r] - m_new); psum += sc[r]; }
                l_run = l_run * alpha + psum;
                if (hh == 0) wsf[q] = alpha;
                LDS_WAIT(); asm volatile("" ::: "memory");
#pragma unroll
                for (int r = 0; r < 16; ++r) { const float a = wsf[(r & 3) + 8 * (r >> 2) + 4 * hh]; o0[r] *= a; o1[r] *= a; }
                LDS_WAIT(); asm volatile("" ::: "memory");
                bf16x8 pa[2];
#pragma unroll
                for (int s = 0; s < 2; ++s) { v4u w; w.x = pk2(sc[8 * s + 0], sc[8 * s + 1]); w.y = pk2(sc[8 * s + 2], sc[8 * s + 3]); w.z = pk2(sc[8 * s + 4], sc[8 * s + 5]); w.w = pk2(sc[8 * s + 6], sc[8 * s + 7]); pa[s] = __builtin_bit_cast(bf16x8, w); }
#pragma unroll
                for (int s = 0; s < 2; ++s) { o0 = __builtin_amdgcn_mfma_f32_32x32x16_bf16(pa[s], vf[0][s], o0, 0, 0, 0); o1 = __builtin_amdgcn_mfma_f32_32x32x16_bf16(pa[s], vf[1][s], o1, 0, 0, 0); }
            }
            const float l_tot = l_run + __shfl_xor(l_run, 32);
            if (hh == 0) wsf[32 + q] = 1.f / l_tot;
            LDS_WAIT(); asm volatile("" ::: "memory");
#pragma unroll
            for (int r = 0; r < 16; ++r) {
                const int qr = (r & 3) + 8 * (r >> 2) + 4 * hh; const float inv = wsf[32 + qr];
                const size_t tq = (size_t)(b * SEQ + i * 64 + 32 * J + qr);
                const float g0 = bf2f(F.P[tq * PW + PC_NAG + h * 64 + q]), g1 = bf2f(F.P[tq * PW + PC_NAG + h * 64 + 32 + q]);
                F.MIX[tq * DM + h * 64 + q] = (bf16)f2bf(o0[r] * inv * siluf_(g0));
                F.MIX[tq * DM + h * 64 + 32 + q] = (bf16)f2bf(o1[r] * inv * siluf_(g1));
            }
            LDS_WAIT(); asm volatile("" ::: "memory");
        }
    }
}

constexpr int SC_KD = 0, SC_V = 16384, SC_R = 32768, SC_W = 49152, SC_B = 65536, SC_KK = 81920, SC_TW = 98304, SC_AD = SC_TW + 9216, SC_W2 = SC_AD + 9216, SC_A2 = SC_W2 + 9216, SC_YB = SC_A2 + 9216, SC_BON = SC_YB + 16384, SC_END = SC_BON + 256;
static_assert(SC_END <= MISC_OFF, "scan LDS map");
constexpr int LROW = 72;
__device__ __forceinline__ void p4_scan(Frame& F) {
    if (F.vcu >= NB * NH * 2) return;
    const int chain = F.vcu, d = chain & 1, h = (chain >> 1) & 7, b = chain >> 4;
    const int tid = F.tid, lane = F.lane, wave = F.wave;
    LAS float* KD = (LAS float*)(F.lds + SC_KD); LAS float* Vv = (LAS float*)(F.lds + SC_V); LAS float* Rr = (LAS float*)(F.lds + SC_R);
    LAS float* Ww = (LAS float*)(F.lds + SC_W); LAS float* Bb = (LAS float*)(F.lds + SC_B); LAS float* KK = (LAS float*)(F.lds + SC_KK);
    LAS bf16* TW = (LAS bf16*)(F.lds + SC_TW); LAS bf16* AD = (LAS bf16*)(F.lds + SC_AD); LAS bf16* W2 = (LAS bf16*)(F.lds + SC_W2); LAS bf16* A2 = (LAS bf16*)(F.lds + SC_A2);
    LAS float* YB = (LAS float*)(F.lds + SC_YB); LAS float* BON = (LAS float*)(F.lds + SC_BON);
    for (int e = tid; e < 4096; e += 512) { const int r = e >> 6, n = e & 63;
        W2[n * LROW + r] = (bf16)f2bf(F.decay_w2[((size_t)d * 64 + r) * 512 + h * 64 + n]);
        A2[n * LROW + r] = (bf16)f2bf(F.aaa_a2[((size_t)d * 64 + r) * 512 + h * 64 + n]); }
    float S[8];
#pragma unroll
    for (int e = 0; e < 8; ++e) S[e] = 0.f;
    const int tt = tid >> 3, nn = tid & 7;
    const int si = tid >> 3, so = tid & 7;
    for (int ci = 0; ci < 68; ++ci) {
        const bool lat = ci >= 4;
        const int cidx = lat ? (d == 0 ? ci - 4 : 67 - ci) : (d == 0 ? ci : 3 - ci);
        const int L = lat ? SEQ : CTXL, tl0 = cidx * 64;
        const size_t rbase = lat ? (size_t)b * SEQ : (size_t)ML + (size_t)b * CTXL;
        {
            const int tl = tl0 + tt; const bool hp = tl > 0, hn = tl + 1 < L;
            const bf16* prow = F.P + (rbase + tl) * PW;
#pragma unroll
            for (int g = 0; g < 5; ++g) {
                if (g == 4 && !lat) continue;
                const int col = (g == 0 ? PC_RWK + h * 64 : g == 1 ? PC_RWV + h * 64 : g == 2 ? PC_WD + d * 64 : g == 3 ? PC_AD + d * 64 : PC_RWR + h * 64) + 8 * nn;
                const v4u z = {0u, 0u, 0u, 0u};
                const v4u pm = hp ? *(const v4u*)(prow - PW + col) : z, p0 = *(const v4u*)(prow + col), pp = hn ? *(const v4u*)(prow + PW + col) : z;
                const float* cw = F.conv_w + (col - 512);
                float u[8];
#pragma unroll
                for (int e2 = 0; e2 < 4; ++e2) {
                    const unsigned a = pm[e2], c = p0[e2], n2 = pp[e2];
                    u[2 * e2] = cw[2 * e2] * bf2f(a & 0xffffu) + cw[1792 + 2 * e2] * bf2f(c & 0xffffu) + cw[3584 + 2 * e2] * bf2f(n2 & 0xffffu);
                    u[2 * e2 + 1] = cw[2 * e2 + 1] * bf2f(a >> 16) + cw[1792 + 2 * e2 + 1] * bf2f(c >> 16) + cw[3584 + 2 * e2 + 1] * bf2f(n2 >> 16);
                }
                if (g == 0 || g == 1 || g == 4) { LAS float* dst = (g == 0 ? KD : g == 1 ? Vv : Rr) + tt * 64 + 8 * nn;
#pragma unroll
                    for (int e = 0; e < 8; ++e) dst[e] = u[e]; }
                else { LAS bf16* dst = (g == 2 ? TW : AD) + tt * LROW + 8 * nn;
#pragma unroll
                    for (int e = 0; e < 8; ++e) { float v = u[e]; if (g == 2) { const float t2 = __expf(2.f * v); v = 1.f - 2.f / (t2 + 1.f); } dst[e] = (bf16)f2bf(v); } }
            }
        }
        __syncthreads();
        {
            const int mat = wave >> 2, tb = (wave >> 1) & 1, nb = wave & 1, q = lane & 31, hh = lane >> 5;
            const LAS bf16* Am = (mat == 0 ? TW : AD) + (32 * tb + q) * LROW + 8 * hh;
            const LAS bf16* Bm = (mat == 0 ? W2 : A2) + (32 * nb + q) * LROW + 8 * hh;
            f32x16 acc;
#pragma unroll
            for (int r = 0; r < 16; ++r) acc[r] = 0.f;
#pragma unroll
            for (int s = 0; s < 4; ++s) acc = __builtin_amdgcn_mfma_f32_32x32x16_bf16(*(const LAS bf16x8*)(Am + 16 * s), *(const LAS bf16x8*)(Bm + 16 * s), acc, 0, 0, 0);
            LAS float* dst = (mat == 0 ? Ww : Bb);
#pragma unroll
            for (int r = 0; r < 16; ++r) dst[(32 * tb + (r & 3) + 8 * (r >> 2) + 4 * hh) * 64 + 32 * nb + q] = acc[r];
        }
        __syncthreads();
        {
            const int cbase = h * 64 + 8 * nn;
            float w[8], a[8], kkr[8], kd[8]; float ss = 0.f, bon = 0.f;
#pragma unroll
            for (int e = 0; e < 8; ++e) {
                const float wl = F.decay_w0[d * 512 + cbase + e] + Ww[tt * 64 + 8 * nn + e];
                w[e] = __expf(-0.6065306597126334f * sigmoidf_(wl));
                a[e] = sigmoidf_(F.aaa_a0[d * 512 + cbase + e] + Bb[tt * 64 + 8 * nn + e]);
                const float kraw = KD[tt * 64 + 8 * nn + e];
                kkr[e] = kraw * F.k_k[cbase + e]; ss += kkr[e] * kkr[e];
                kd[e] = kraw * (1.f + (a[e] - 1.f) * F.k_a[cbase + e]);
                if (lat) bon += Rr[tt * 64 + 8 * nn + e] * kd[e] * F.r_k[cbase + e];
            }
            ss += __shfl_xor(ss, 1); ss += __shfl_xor(ss, 2); ss += __shfl_xor(ss, 4);
            bon += __shfl_xor(bon, 1); bon += __shfl_xor(bon, 2); bon += __shfl_xor(bon, 4);
            const float inv = rsqrtf(fmaxf(ss, 1e-24f));
#pragma unroll
            for (int e = 0; e < 8; ++e) { const float kk = kkr[e] * inv; Ww[tt * 64 + 8 * nn + e] = w[e]; Bb[tt * 64 + 8 * nn + e] = kk * a[e]; KK[tt * 64 + 8 * nn + e] = kk; KD[tt * 64 + 8 * nn + e] = kd[e]; }
            if (nn == 0) BON[tt] = bon;
        }
        __syncthreads();
        for (int st = 0; st < 64; ++st) {
            const int t = (d == 0) ? st : 63 - st;
            const LAS f32x4* kk4 = (const LAS f32x4*)(KK + t * 64 + 8 * so); const LAS f32x4* w4 = (const LAS f32x4*)(Ww + t * 64 + 8 * so);
            const LAS f32x4* b4 = (const LAS f32x4*)(Bb + t * 64 + 8 * so); const LAS f32x4* kd4 = (const LAS f32x4*)(KD + t * 64 + 8 * so);
            const f32x4 kka = kk4[0], kkb = kk4[1], wa = w4[0], wb = w4[1], ba = b4[0], bb = b4[1], ka = kd4[0], kb = kd4[1];
            const float vi = Vv[t * 64 + si];
            float sa = (S[0] * kka[0] + S[1] * kka[1]) + (S[2] * kka[2] + S[3] * kka[3]) + (S[4] * kkb[0] + S[5] * kkb[1]) + (S[6] * kkb[2] + S[7] * kkb[3]);
            sa += __shfl_xor(sa, 1); sa += __shfl_xor(sa, 2); sa += __shfl_xor(sa, 4);
#pragma unroll
            for (int e = 0; e < 4; ++e) { S[e] = S[e] * wa[e] - sa * ba[e] + vi * ka[e]; S[4 + e] = S[4 + e] * wb[e] - sa * bb[e] + vi * kb[e]; }
            if (lat) {
                const LAS f32x4* r4 = (const LAS f32x4*)(Rr + t * 64 + 8 * so); const f32x4 ra = r4[0], rb = r4[1];
                float y = (S[0] * ra[0] + S[1] * ra[1]) + (S[2] * ra[2] + S[3] * ra[3]) + (S[4] * rb[0] + S[5] * rb[1]) + (S[6] * rb[2] + S[7] * rb[3]);
                y += __shfl_xor(y, 1); y += __shfl_xor(y, 2); y += __shfl_xor(y, 4);
                if (so == 0) YB[t * 64 + si] = y;
            }
        }
        __syncthreads();
        if (lat) {
            float* yo = F.out + ((size_t)d * ML + rbase + tl0 + tt) * 512 + h * 64 + 8 * nn;
            *(f32x4*)yo = *(const LAS f32x4*)(YB + tt * 64 + 8 * nn); *(f32x4*)(yo + 4) = *(const LAS f32x4*)(YB + tt * 64 + 8 * nn + 4);
            if (tid < 64) F.bonus[(rbase + tl0 + tid) * 16 + h * 2 + d] = BON[tid];
        }
    }
}

__device__ __forceinline__ void p5_readout(Frame& F) {
    const int gw = F.vcu * NWAVES + F.wave, NGW = F.G * NWAVES, lane = F.lane;
    const int c8 = 8 * lane, hd = lane >> 3;
    for (int m = gw; m < ML; m += NGW) {
        const int tl = m & (SEQ - 1); const bool hp = tl > 0, hn = tl + 1 < SEQ;
        const float* y0 = F.out + (size_t)m * 512 + c8; const float* y1 = F.out + ((size_t)ML + m) * 512 + c8;
        const f32x4 a0 = *(const f32x4*)y0, a1 = *(const f32x4*)(y0 + 4), b0 = *(const f32x4*)y1, b1 = *(const f32x4*)(y1 + 4);
        float y[8] = {a0[0] + b0[0], a0[1] + b0[1], a0[2] + b0[2], a0[3] + b0[3], a1[0] + b1[0], a1[1] + b1[1], a1[2] + b1[2], a1[3] + b1[3]};
        float s = 0.f;
#pragma unroll
        for (int e = 0; e < 8; ++e) s += y[e];
        s += __shfl_xor(s, 1); s += __shfl_xor(s, 2); s += __shfl_xor(s, 4);
        const float mu = s * (1.f / 64.f); float q = 0.f;
#pragma unroll
        for (int e = 0; e < 8; ++e) { y[e] -= mu; q += y[e] * y[e]; }
        q += __shfl_xor(q, 1); q += __shfl_xor(q, 2); q += __shfl_xor(q, 4);
        const float rstd = rsqrtf(q * (1.f / 64.f) + GN_EPS);
        const float bonus = F.bonus[(size_t)m * 16 + hd * 2] + F.bonus[(size_t)m * 16 + hd * 2 + 1];
        const bf16* prow = F.P + (size_t)m * PW;
        const v4u z = {0u, 0u, 0u, 0u};
        const v4u vm = hp ? *(const v4u*)(prow - PW + PC_RWV + c8) : z, v0 = *(const v4u*)(prow + PC_RWV + c8), vp = hn ? *(const v4u*)(prow + PW + PC_RWV + c8) : z;
        const v4u gg = *(const v4u*)(prow + PC_RWG + c8);
        const float* cw = F.conv_w + 512 + c8;
        float o[8];
#pragma unroll
        for (int e2 = 0; e2 < 4; ++e2) {
#pragma unroll
            for (int hb = 0; hb < 2; ++hb) {
                const int e = 2 * e2 + hb;
                const float pv_m = hb ? bf2f(vm[e2] >> 16) : bf2f(vm[e2] & 0xffffu), pv_0 = hb ? bf2f(v0[e2] >> 16) : bf2f(v0[e2] & 0xffffu), pv_p = hb ? bf2f(vp[e2] >> 16) : bf2f(vp[e2] & 0xffffu);
                const float vc = cw[e] * pv_m + cw[1792 + e] * pv_0 + cw[3584 + e] * pv_p;
                const float g = hb ? bf2f(gg[e2] >> 16) : bf2f(gg[e2] & 0xffffu);
                const float yn = y[e] * rstd * F.gn_w[c8 + e] + F.gn_b[c8 + e];
                o[e] = (yn + bonus * vc) * siluf_(g);
            }
        }
        v4u w; w.x = pk2(o[0], o[1]); w.y = pk2(o[2], o[3]); w.z = pk2(o[4], o[5]); w.w = pk2(o[6], o[7]);
        *(GAS v4u*)(F.MIX + (size_t)m * DM + 512 + c8) = w;
    }
}

__device__ __forceinline__ void p7_final(Frame& F) {
    const int gw = F.vcu * NWAVES + F.wave, NGW = F.G * NWAVES;
    for (int m = gw; m < ML; m += NGW) {
        const float rstd = rsqrtf(__hip_atomic_load(F.sumsq + m, __ATOMIC_RELAXED, __HIP_MEMORY_SCOPE_AGENT) * (1.f / DM) + RMS_EPS);
        GAS f32x4* o = (GAS f32x4*)(F.out + (size_t)m * DM) + F.lane;
#pragma unroll
        for (int j = 0; j < 4; ++j) { const f32x4 g = *(const f32x4*)(F.final_g + 4 * (F.lane + 64 * j)); o[64 * j] = o[64 * j] * rstd * g; }
    }
}

struct Args { const float* in[21]; float* out; unsigned char* ws; };
__global__ void __launch_bounds__(NWAVES * 64, 2) mk_fwd(Args args) {
    extern __shared__ __attribute__((aligned(16))) unsigned char lds[];
    Frame F;
    F.lds = (LAS unsigned char*)lds;
    volatile LAS unsigned* MISC = (volatile LAS unsigned*)(F.lds + MISC_OFF);
    F.tid = threadIdx.x; F.lane = F.tid & 63; F.wave = __builtin_amdgcn_readfirstlane(F.tid >> 6);
    F.G = gridDim.x; { const int bx = blockIdx.x; F.vcu = (F.G % 8 == 0) ? (bx % 8) * (F.G / 8) + bx / 8 : bx; }
    unsigned char* ws = args.ws;
    gu32* ctl = (gu32*)(ws + WS_CTL);
    F.x = args.in[0]; F.c = args.in[1]; F.ctx = args.in[2]; F.c_ctx = args.in[3]; F.w_mod = args.in[4]; F.b_mod = args.in[5]; F.norm_g = args.in[6]; F.w_in = args.in[7];
    F.conv_w = args.in[8]; F.decay_w0 = args.in[9]; F.decay_w2 = args.in[10]; F.aaa_a0 = args.in[11]; F.aaa_a2 = args.in[12]; F.k_k = args.in[13]; F.k_a = args.in[14];
    F.r_k = args.in[15]; F.gn_w = args.in[16]; F.gn_b = args.in[17]; F.na_rpb = args.in[18]; F.w_out = args.in[19]; F.final_g = args.in[20];
    F.out = args.out;
    F.mod = (float*)(ws + WS_MOD); F.sumsq = (float*)(ws + WS_SUMSQ); F.bonus = (float*)(ws + WS_BONUS);
    F.WoutT = (bf16*)(ws + WS_WOUT); F.WinT = (bf16*)(ws + WS_WIN); F.XN = (bf16*)(ws + WS_XN); F.P = (bf16*)(ws + WS_P); F.VT = (bf16*)(ws + WS_VT); F.MIX = (bf16*)(ws + WS_MIX);
    for (int u = F.tid; u < 64; u += NWAVES * 64) ((LAS unsigned*)(F.lds + MISC_OFF))[u] = 0u;
    __syncthreads();
    XcdBarrier bar = xcd_barrier_post((unsigned*)(ctl + CW_BAR), MISC + 8);

    p0_prologue(F);
    xcd_barrier(bar);
    p1_xn(F);
    xcd_barrier(bar);
    {
        { pg8::Gemm g{F.XN, F.WinT, ML, PW, DM}; pg8::StaticOrder S; S.init(ML, PW, F.G, (int)blockIdx.x);
          pg8::EpiBf16<0> E{F.P, PW, nullptr, 0, 0, 1.f};
          pg8::gemm_phase<pg8::EpiBf16<0>, pg8::StaticOrder, true, true>(F.lds, g, S, E); }
        { pg8::Gemm g{F.WinT + (size_t)PW * DM, F.XN, 512, MT, DM}; pg8::StaticOrder S; S.init(512, MT, F.G, (int)blockIdx.x);
          pg8::EpiBf16<0> E{F.VT, MT, nullptr, 0, 0, 1.f};
          pg8::gemm_phase<pg8::EpiBf16<0>, pg8::StaticOrder, true, true>(F.lds, g, S, E); }
        { pg8::Gemm g{F.XN + (size_t)ML * DM, F.WinT, MC, PCW, DM}; pg8::StaticOrder S; S.init(MC, PCW, F.G, (int)blockIdx.x);
          pg8::EpiBf16<0> E{F.P + (size_t)ML * PW, PW, nullptr, 0, 0, 1.f};
          pg8::gemm_phase<pg8::EpiBf16<0>, pg8::StaticOrder, true, true>(F.lds, g, S, E); }
    }
    xcd_barrier(bar);
    p3_attention(F);
    __syncthreads();
    p4_scan(F);
    xcd_barrier(bar);
    p5_readout(F);
    xcd_barrier(bar);
    {
        pg8::Gemm g{F.MIX, F.WoutT, ML, DM, DM}; pg8::StaticOrder S; S.init(ML, DM, F.G, (int)blockIdx.x);
        pg8::EpiOut E{F.x, F.mod, F.out, F.sumsq};
        pg8::gemm_phase<pg8::EpiOut, pg8::StaticOrder, true, true>(F.lds, g, S, E);
    }
    xcd_barrier(bar);
    p7_final(F);
}

extern "C" void kernel_launch(void* const* d_in, const int* in_sizes, int n_in, void* d_out, int out_size, void* d_ws, size_t ws_size, hipStream_t stream) {
    static int grid = 0;
    if (grid == 0) {
        if (n_in != 21 || out_size != ML * DM || ws_size < WS_END) { fprintf(stderr, "kernel_launch: unexpected shapes (n_in %d, out %d, ws %zu)\n", n_in, out_size, ws_size); grid = -1; return; }
        int dev = 0, cus = 0, per_cu = 0;
        if (hipGetDevice(&dev) != hipSuccess || hipDeviceGetAttribute(&cus, hipDeviceAttributeMultiprocessorCount, dev) != hipSuccess) { grid = -1; return; }
        if (hipFuncSetAttribute((const void*)mk_fwd, hipFuncAttributeMaxDynamicSharedMemorySize, LDS_BYTES) != hipSuccess) { fprintf(stderr, "kernel_launch: hipFuncSetAttribute failed\n"); grid = -1; return; }
        if (hipOccupancyMaxActiveBlocksPerMultiprocessor(&per_cu, (const void*)mk_fwd, NWAVES * 64, LDS_BYTES) != hipSuccess || per_cu < 1) { fprintf(stderr, "kernel_launch: occupancy query says %d\n", per_cu); }
        (void)hipGetLastError();
        grid = cus;
    }
    if (grid < 0) return;
    if (hipMemsetAsync((char*)d_ws + WS_CTL, 0, CTL_ZERO_BYTES, stream) != hipSuccess) return;
    Args a{};
    for (int i = 0; i < 21; ++i) a.in[i] = (const float*)d_in[i];
    a.out = (float*)d_out; a.ws = (unsigned char*)d_ws;
    hipLaunchKernelGGL(mk_fwd, dim3(grid), dim3(NWAVES * 64), LDS_BYTES, stream, a);
}
```

```cpp
#include <hip/hip_runtime.h>
#include <cstdio>
#include <cstdint>
namespace pg8 {
#define PG8_LAS __attribute__((address_space(3)))
typedef unsigned short bf16_t;
typedef short bf16x8 __attribute__((ext_vector_type(8)));
typedef float f32x4 __attribute__((ext_vector_type(4)));
typedef unsigned u32x4 __attribute__((ext_vector_type(4)));
constexpr int BM = 256, BK = 64, HALF = 128, HTB = HALF * BK * 2  , STAGE_BYTES = 8 * HTB, NXCD = 8, WGM = 4;

__host__ __device__ __forceinline__ int lds_byte(int r, int c) { const int st = (r >> 4) * 2 + (c >> 5), rr = r & 15, cc = c & 31, ob = rr * 64 + cc * 2; return st * 1024 + (ob ^ (((ob >> 9) & 1) << 5)); }
__host__ __device__ __forceinline__ void stage_rc(int b, int& R, int& C) { const int st = b / 1024, sb = b % 1024, swz = sb ^ (((sb >> 9) & 1) << 5); R = (st >> 1) * 16 + swz / 64; C = (st & 1) * 32 + (swz % 64) / 2; }
__host__ __device__ __forceinline__ int perm32(int rho) { const int n = rho >> 4, i = rho & 15; return 8 * (i >> 2) + 4 * n + (i & 3); }

struct Unit { int pm, pn; };
struct Gemm { const bf16_t* A; const bf16_t* Bt; int M, N, K; };

struct StaticOrder {
    int nM, nN, nwg, G, c;
    __host__ __device__ void init(int M, int N, int G_, int c_) { nM = M / BM; nN = N / BM; nwg = nM * nN; G = G_; c = c_; }
    __host__ __device__ bool next(int i, Unit& u) const {
        const long L = (long)i * G + c; if (L >= nwg) return false;
        int wgid = (int)L; { const int q = nwg / NXCD, r = nwg % NXCD, xcd = wgid % NXCD, off = wgid / NXCD; wgid = (xcd < r ? xcd * (q + 1) : r * (q + 1) + (xcd - r) * q) + off; }
        const int nig = WGM * nN, gid = wgid / nig, fm = gid * WGM, gsz = (nM - fm) < WGM ? (nM - fm) : WGM;
        u.pm = fm + ((wgid % nig) % gsz); u.pn = (wgid % nig) / gsz; return true;
    }
    __device__ __forceinline__ void a_ready(const Unit&) const {}
    __device__ __forceinline__ void done(const Unit&) const {}
};

__device__ __forceinline__ unsigned cvt_pk_bf16(float lo, float hi) { unsigned r; asm volatile("v_cvt_pk_bf16_f32 %0, %1, %2" : "=v"(r) : "v"(lo), "v"(hi)); return r; }
typedef float f32x2 __attribute__((ext_vector_type(2)));
__device__ __forceinline__ f32x2 gelu_pk(f32x2 v) {
    const f32x2 av = __builtin_elementwise_abs(v), d = av * 0.2316418882f + 1.0f;
    f32x2 t; t.x = __builtin_amdgcn_rcpf(d.x); t.y = __builtin_amdgcn_rcpf(d.y);
    f32x2 q = t * 0.5307027145f + (-0.7265760135f); q = q * t + 0.7107068705f; q = q * t + (-0.142248368f); q = q * t + 0.127414796f; q = q * t;
    const f32x2 s = (v * v) * (-0.72134752044f);
    f32x2 e; e.x = __builtin_amdgcn_exp2f(s.x); e.y = __builtin_amdgcn_exp2f(s.y);
    const f32x2 m = v * (q * e), r = v - m;
    f32x2 o; o.x = v.x < 0.f ? m.x : r.x; o.y = v.y < 0.f ? m.y : r.y; return o;
}

template <int ACT  > struct EpiBf16 {
    static constexpr bool PERM = true, AFTER_DRAIN = false; static_assert(ACT == 0 || ACT == 1, "EpiBf16: ACT is 0 (none) or 1 (gelu_pk)");
    bf16_t* O; int ldc; const float* bias; int split_cols; size_t split_stride; float scale0;
    __device__ __forceinline__ void operator()(const f32x4 (&acc)[2][2][4][2], const Unit& u, int wr, int wc, int fr, int fq) const {
        const int row0 = u.pm * BM + wr * 64 + fr; int colt = u.pn * BM; bf16_t* base = O;
        float sc = 1.f; if (split_cols) { const int t = colt / split_cols; base += (size_t)t * split_stride; colt -= t * split_cols; if (t == 0) sc = scale0; }
        const int col0 = colt + wc * 32 + 8 * fq, bcol0 = u.pn * BM + wc * 32 + 8 * fq;
        f32x4 bv[2][2];
#pragma unroll
        for (int bj = 0; bj < 2; ++bj)
#pragma unroll
            for (int n = 0; n < 2; ++n) bv[bj][n] = bias ? *(const f32x4*)(bias + bcol0 + bj * HALF + 4 * n) : (f32x4){0.f, 0.f, 0.f, 0.f};
#pragma unroll
        for (int ai = 0; ai < 2; ++ai)
#pragma unroll
            for (int m = 0; m < 4; ++m) { bf16_t* rowp = base + (size_t)(row0 + ai * HALF + m * 16) * ldc + col0;
#pragma unroll
                for (int bj = 0; bj < 2; ++bj) { f32x4 v0 = acc[ai][bj][m][0] + bv[bj][0], v1 = acc[ai][bj][m][1] + bv[bj][1];
                    if (ACT == 1) { f32x2 a = gelu_pk((f32x2){v0[0], v0[1]}), b = gelu_pk((f32x2){v0[2], v0[3]}), c = gelu_pk((f32x2){v1[0], v1[1]}), d = gelu_pk((f32x2){v1[2], v1[3]});
                        v0 = (f32x4){a.x, a.y, b.x, b.y}; v1 = (f32x4){c.x, c.y, d.x, d.y}; }
                    v0 = v0 * sc; v1 = v1 * sc; u32x4 w; w.x = cvt_pk_bf16(v0[0], v0[1]); w.y = cvt_pk_bf16(v0[2], v0[3]); w.z = cvt_pk_bf16(v1[0], v1[1]); w.w = cvt_pk_bf16(v1[2], v1[3]);
                    *(u32x4*)(rowp + bj * HALF) = w; } }
    }
};

struct MergedOrder {
    StaticOrder so; int G, c;
    __host__ __device__ void init(int G_, int c_) { so.init(65536, 3840, G_, c_); G = G_; c = c_; }
    __host__ __device__ bool next(int i, Unit& u) const {
        const long L = (long)i * G + c;
        if (L < 3840) { Unit t; so.next(i, t); u.pm = 64 + t.pm; u.pn = 8 + t.pn; return true; }
        const int r = (int)(L - 3840);
        if (r < 544) { u.pm = 8 + 15 + (r & 1); u.pn = 64 + (r >> 1); return true; }
        if (r < 656) { const int r2 = r - 544; u.pm = 64 + 256 + (r2 & 15); u.pn = 8 + (r2 >> 4); return true; }
        return false;
    }
    __device__ __forceinline__ void a_ready(const Unit&) const {}
    __device__ __forceinline__ void done(const Unit&) const {}
};
template <int CTRL> __device__ __forceinline__ float dppf(float x) { return __builtin_bit_cast(float, __builtin_amdgcn_update_dpp(0, __builtin_bit_cast(int, x), CTRL, 0xf, 0xf, true)); }
constexpr int EPI_EDGE_OFF = 131072, EPI_CW_OFF = 139264;
struct EpiMerged {
    static constexpr bool PERM = true, AFTER_DRAIN = false;
    bf16_t* P; bf16_t* VT; int ldp, ldv; bf16_t* EDGE; PG8_LAS unsigned char* lds;
    __device__ __forceinline__ void operator()(const f32x4 (&acc)[2][2][4][2], const Unit& u, int wr, int wc, int fr, int fq) const {
        const bool isv = u.pm < 64;
        const int rp = isv ? u.pm - 23 : u.pm - 64, cp = isv ? u.pn - 64 : u.pn - 8, ldc = isv ? ldv : ldp;
        bf16_t* base = isv ? VT : P;
        const int row0 = rp * BM + wr * 64 + fr, col0 = cp * BM + wc * 32 + 8 * fq;
        if (isv || cp < 2 || cp >= 9) {
#pragma unroll
        for (int ai = 0; ai < 2; ++ai)
#pragma unroll
            for (int m = 0; m < 4; ++m) { bf16_t* rowp = base + (size_t)(row0 + ai * HALF + m * 16) * ldc + col0;
#pragma unroll
                for (int bj = 0; bj < 2; ++bj) { const f32x4 v0 = acc[ai][bj][m][0], v1 = acc[ai][bj][m][1];
                    u32x4 w; w.x = cvt_pk_bf16(v0[0], v0[1]); w.y = cvt_pk_bf16(v0[2], v0[3]); w.z = cvt_pk_bf16(v1[0], v1[1]); w.w = cvt_pk_bf16(v1[2], v1[3]);
                    *(u32x4*)(rowp + bj * HALF) = w; } }
        } else {
            int fq8 = 8 * fq; asm volatile("" : "+v"(fq8));
            PG8_LAS float* EL = (PG8_LAS float*)(lds + EPI_EDGE_OFF) + wc * 32 + fq8;
            const PG8_LAS float* CWL = (const PG8_LAS float*)(lds + EPI_CW_OFF) + (cp - 2) * BM + wc * 32 + fq8;
            if (fr == 0) {
#pragma unroll
                for (int ai = 0; ai < 2; ++ai)
#pragma unroll
                    for (int bj = 0; bj < 2; ++bj)
#pragma unroll
                        for (int n = 0; n < 2; ++n) *(PG8_LAS f32x4*)(EL + ((2 * ai + wr) * 2 + 0) * 256 + bj * HALF + 4 * n) = acc[ai][bj][0][n];
            }
            if (fr == 15) {
#pragma unroll
                for (int ai = 0; ai < 2; ++ai)
#pragma unroll
                    for (int bj = 0; bj < 2; ++bj)
#pragma unroll
                        for (int n = 0; n < 2; ++n) *(PG8_LAS f32x4*)(EL + ((2 * ai + wr) * 2 + 1) * 256 + bj * HALF + 4 * n) = acc[ai][bj][3][n];
            }
            asm volatile("s_waitcnt lgkmcnt(0)" ::: "memory"); __builtin_amdgcn_s_barrier();
            if (wr == 0 && fr == 0) {
#pragma unroll
                for (int bj = 0; bj < 2; ++bj) { const f32x4 v0 = acc[0][bj][0][0], v1 = acc[0][bj][0][1];
                    u32x4 w; w.x = cvt_pk_bf16(v0[0], v0[1]); w.y = cvt_pk_bf16(v0[2], v0[3]); w.z = cvt_pk_bf16(v1[0], v1[1]); w.w = cvt_pk_bf16(v1[2], v1[3]);
                    *(u32x4*)(EDGE + (size_t)(rp * 2 + 0) * 1792 + (cp - 2) * BM + wc * 32 + 8 * fq + bj * HALF) = w; }
            }
            if (wr == 1 && fr == 15) {
#pragma unroll
                for (int bj = 0; bj < 2; ++bj) { const f32x4 v0 = acc[1][bj][3][0], v1 = acc[1][bj][3][1];
                    u32x4 w; w.x = cvt_pk_bf16(v0[0], v0[1]); w.y = cvt_pk_bf16(v0[2], v0[3]); w.z = cvt_pk_bf16(v1[0], v1[1]); w.w = cvt_pk_bf16(v1[2], v1[3]);
                    *(u32x4*)(EDGE + (size_t)(rp * 2 + 1) * 1792 + (cp - 2) * BM + wc * 32 + 8 * fq + bj * HALF) = w; }
            }
            const f32x4 zz = {0.f, 0.f, 0.f, 0.f};
#pragma unroll
            for (int bj = 0; bj < 2; ++bj) {
                f32x4 w0[2], w1[2], w2[2];
#pragma unroll
                for (int n = 0; n < 2; ++n) { w0[n] = *(const PG8_LAS f32x4*)(CWL + bj * HALF + 4 * n); w1[n] = *(const PG8_LAS f32x4*)(CWL + 1792 + bj * HALF + 4 * n); w2[n] = *(const PG8_LAS f32x4*)(CWL + 3584 + bj * HALF + 4 * n); }
#pragma unroll
                for (int ai = 0; ai < 2; ++ai) {
                    const int b4 = 2 * ai + wr;
                    f32x4 hp[2], hn[2];
#pragma unroll
                    for (int n = 0; n < 2; ++n) { hp[n] = b4 > 0 ? *(const PG8_LAS f32x4*)(EL + ((b4 - 1) * 2 + 1) * 256 + bj * HALF + 4 * n) : zz; hn[n] = b4 < 3 ? *(const PG8_LAS f32x4*)(EL + ((b4 + 1) * 2 + 0) * 256 + bj * HALF + 4 * n) : zz; }
#pragma unroll
                    for (int m = 0; m < 4; ++m) {
                        f32x4 t[2];
#pragma unroll
                        for (int n = 0; n < 2; ++n)
#pragma unroll
                            for (int e = 0; e < 4; ++e) {
                                const float c = acc[ai][bj][m][n][e];
                                const float up = m > 0 ? dppf<0x121>(acc[ai][bj][m > 0 ? m - 1 : 0][n][e]) : hp[n][e];
                                const float dn = m < 3 ? dppf<0x12F>(acc[ai][bj][m < 3 ? m + 1 : 3][n][e]) : hn[n][e];
                                const float pv = __builtin_bit_cast(float, __builtin_amdgcn_update_dpp(__builtin_bit_cast(int, up), __builtin_bit_cast(int, c), 0x111, 0xf, 0xf, false));
                                const float nv = __builtin_bit_cast(float, __builtin_amdgcn_update_dpp(__builtin_bit_cast(int, dn), __builtin_bit_cast(int, c), 0x101, 0xf, 0xf, false));
                                t[n][e] = w0[n][e] * pv + w1[n][e] * c + w2[n][e] * nv;
                            }
                        if (bj == 0 && cp == 6) {
                            const bool er = (ai == 0 && m == 0) ? (wr == 0 && fr == 0) : (ai == 1 && m == 3) ? (wr == 1 && fr == 15) : false;
#pragma unroll
                            for (int n = 0; n < 2; ++n)
#pragma unroll
                                for (int e = 0; e < 4; ++e) { const float th = 1.f - 2.f * __builtin_amdgcn_rcpf(__builtin_amdgcn_exp2f(t[n][e] * 2.885390081777927f) + 1.f); t[n][e] = er ? t[n][e] : th; }
                        }
                        u32x4 w; w.x = cvt_pk_bf16(t[0][0], t[0][1]); w.y = cvt_pk_bf16(t[0][2], t[0][3]); w.z = cvt_pk_bf16(t[1][0], t[1][1]); w.w = cvt_pk_bf16(t[1][2], t[1][3]);
                        *(u32x4*)(base + (size_t)(row0 + ai * HALF + m * 16) * ldc + col0 + bj * HALF) = w;
                    }
                }
            }
        }
    }
};
struct PanelOrder {
    int G, c;
    __host__ __device__ void init(int G_, int c_) { G = G_; c = c_; }
    __host__ __device__ bool next(int i, Unit& u) const { u.pm = c + (i >> 2) * G; u.pn = i & 3; return u.pm < 256; }
    __device__ __forceinline__ void a_ready(const Unit&) const {}
    __device__ __forceinline__ void done(const Unit&) const {}
};
struct EpiOutP {
    static constexpr bool PERM = false, AFTER_DRAIN = false;
    const float* x; const float* mod; float* out; PG8_LAS float* ssq;
    __device__ __forceinline__ void operator()(const f32x4 (&acc)[2][2][4][2], const Unit& u, int wr, int wc, int fr, int fq) const {
        const int col0 = u.pn * BM + wc * 32 + 4 * fq;
        const int b = (u.pm * BM) >> 12;
        const float* gate = mod + b * 3072 + 2048;
        f32x4 gv[2][2];
#pragma unroll
        for (int bj = 0; bj < 2; ++bj)
#pragma unroll
            for (int n = 0; n < 2; ++n) gv[bj][n] = *(const f32x4*)(gate + col0 + bj * HALF + n * 16);
#pragma unroll
        for (int ai = 0; ai < 2; ++ai)
#pragma unroll
            for (int m = 0; m < 4; ++m) {
                const int rl = ai * HALF + wr * 64 + m * 16 + fr, row = u.pm * BM + rl;
                const size_t off = (size_t)row * 1024 + col0;
                float ss = 0.f;
#pragma unroll
                for (int bj = 0; bj < 2; ++bj)
#pragma unroll
                    for (int n = 0; n < 2; ++n) {
                        const f32x4 xv = *(const f32x4*)(x + off + bj * HALF + n * 16);
                        const f32x4 o = xv + gv[bj][n] * acc[ai][bj][m][n];
                        *(f32x4*)(out + off + bj * HALF + n * 16) = o;
                        ss += (o[0] * o[0] + o[1] * o[1]) + (o[2] * o[2] + o[3] * o[3]);
                    }
                { auto r1 = __builtin_amdgcn_permlane16_swap(__float_as_uint(ss), __float_as_uint(ss), false, false); ss = __uint_as_float(r1[0]) + __uint_as_float(r1[1]);
                  auto r2 = __builtin_amdgcn_permlane32_swap(__float_as_uint(ss), __float_as_uint(ss), false, false); ss = __uint_as_float(r2[0]) + __uint_as_float(r2[1]); }
                if (fq == 0) __hip_atomic_fetch_add(ssq + rl, ss, __ATOMIC_RELAXED, __HIP_MEMORY_SCOPE_WORKGROUP);
                asm volatile("" ::: "memory");
            }
    }
};
struct EpiOutH {
    static constexpr bool PERM = true, AFTER_DRAIN = false;
    const float* x; const float* mod; bf16_t* H; PG8_LAS float* ssq;
    __device__ __forceinline__ void operator()(const f32x4 (&acc)[2][2][4][2], const Unit& u, int wr, int wc, int fr, int fq) const {
        const int col0 = u.pn * BM + wc * 32 + 8 * fq;
        const int b = (u.pm * BM) >> 12;
        const float* gate = mod + b * 3072 + 2048;
        f32x4 gv[2][2];
#pragma unroll
        for (int bj = 0; bj < 2; ++bj)
#pragma unroll
            for (int n = 0; n < 2; ++n) gv[bj][n] = *(const f32x4*)(gate + col0 + bj * HALF + 4 * n);
#pragma unroll
        for (int ai = 0; ai < 2; ++ai)
#pragma unroll
            for (int m = 0; m < 4; ++m) {
                const int rl = ai * HALF + wr * 64 + m * 16 + fr, row = u.pm * BM + rl;
                const size_t off = (size_t)row * 1024 + col0;
                float ss = 0.f;
#pragma unroll
                for (int bj = 0; bj < 2; ++bj) {
                    const f32x4 xa = *(const f32x4*)(x + off + bj * HALF), xb = *(const f32x4*)(x + off + bj * HALF + 4);
                    const f32x4 o0 = xa + gv[bj][0] * acc[ai][bj][m][0], o1 = xb + gv[bj][1] * acc[ai][bj][m][1];
                    u32x4 w; w.x = cvt_pk_bf16(o0[0], o0[1]); w.y = cvt_pk_bf16(o0[2], o0[3]); w.z = cvt_pk_bf16(o1[0], o1[1]); w.w = cvt_pk_bf16(o1[2], o1[3]);
                    *(u32x4*)(H + off + bj * HALF) = w;
                    ss += ((o0[0] * o0[0] + o0[1] * o0[1]) + (o0[2] * o0[2] + o0[3] * o0[3])) + ((o1[0] * o1[0] + o1[1] * o1[1]) + (o1[2] * o1[2] + o1[3] * o1[3]));
                }
                { auto r1 = __builtin_amdgcn_permlane16_swap(__float_as_uint(ss), __float_as_uint(ss), false, false); ss = __uint_as_float(r1[0]) + __uint_as_float(r1[1]);
                  auto r2 = __builtin_amdgcn_permlane32_swap(__float_as_uint(ss), __float_as_uint(ss), false, false); ss = __uint_as_float(r2[0]) + __uint_as_float(r2[1]); }
                if (fq == 0) __hip_atomic_fetch_add(ssq + rl, ss, __ATOMIC_RELAXED, __HIP_MEMORY_SCOPE_WORKGROUP);
                asm volatile("" ::: "memory");
            }
    }
};
struct EpiOut {
    static constexpr bool PERM = false, AFTER_DRAIN = false;
    const float* x; const float* mod; float* out; float* sumsq;
    __device__ __forceinline__ void operator()(const f32x4 (&acc)[2][2][4][2], const Unit& u, int wr, int wc, int fr, int fq) const {
        const int col0 = u.pn * BM + wc * 32 + 4 * fq;
        const int b = (u.pm * BM) >> 12;
        const float* gate = mod + b * 3072 + 2048;
        f32x4 gv[2][2];
#pragma unroll
        for (int bj = 0; bj < 2; ++bj)
#pragma unroll
            for (int n = 0; n < 2; ++n) gv[bj][n] = *(const f32x4*)(gate + col0 + bj * HALF + n * 16);
#pragma unroll
        for (int ai = 0; ai < 2; ++ai)
#pragma unroll
            for (int m = 0; m < 4; ++m) {
                const int row = u.pm * BM + ai * HALF + wr * 64 + m * 16 + fr;
                const size_t off = (size_t)row * 1024 + col0;
                float ss = 0.f;
#pragma unroll
                for (int bj = 0; bj < 2; ++bj)
#pragma unroll
                    for (int n = 0; n < 2; ++n) {
                        const f32x4 xv = *(const f32x4*)(x + off + bj * HALF + n * 16);
                        const f32x4 o = xv + gv[bj][n] * acc[ai][bj][m][n];
                        *(f32x4*)(out + off + bj * HALF + n * 16) = o;
                        ss += (o[0] * o[0] + o[1] * o[1]) + (o[2] * o[2] + o[3] * o[3]);
                    }
                ss += __shfl_xor(ss, 16); ss += __shfl_xor(ss, 32);
                if (fq == 0) atomicAdd(sumsq + row, ss);
                asm volatile("" ::: "memory");
            }
    }
};
template <class Epi, class Sched, bool ALIGN_EPI = false, bool SP2 = false>
__device__ __forceinline__ void gemm_phase(PG8_LAS unsigned char* lds, const Gemm g, const Sched& S, const Epi& E, const int wid_in) {
    int lane_o; asm volatile("v_mbcnt_lo_u32_b32 %0, -1, 0\n\tv_mbcnt_hi_u32_b32 %0, -1, %0" : "=v"(lane_o)); const int tid_o = wid_in * 64 + lane_o;
    const int tid = tid_o, wid = wid_in, lane = tid & 63, wr = wid >> 2, wc = wid & 3, fr = lane & 15, fq = lane >> 4;
    const int K = g.K, nt = K / BK;
    unsigned voffA[2], voffB[2];
#pragma unroll
    for (int i = 0; i < 2; ++i) { int R, C; stage_rc(tid * 16 + i * 8192, R, C); const int Rb = Epi::PERM ? ((R & ~31) + perm32(R & 31)) : R;
        voffA[i] = (unsigned)(R * K + C) * 2u; voffB[i] = (unsigned)(Rb * K + C) * 2u; }
    const size_t kstep = (size_t)(BK * 2);
    const size_t hstep = (size_t)HALF * K * 2;
    const size_t tstep = 2 * hstep;
    const unsigned ldsw = (unsigned)wid * 1024u;
    const int aoff = lds_byte(wr * 64 + fr, fq * 8), boff = lds_byte(wc * 32 + fr, fq * 8);
#define PG8_SA(b, h) (((b) * 2 + (h)) * HTB)
#define PG8_SB(b, h) ((4 + (b) * 2 + (h)) * HTB)
#define PG8_STAGE(bufoff, gbase, voff) do { _Pragma("unroll") for (int _i = 0; _i < 2; ++_i) \
        __builtin_amdgcn_global_load_lds((const unsigned*)((const char*)(gbase) + (voff)[_i]), (PG8_LAS unsigned*)(lds + (bufoff) + ldsw + _i * 8192), 16, 0, 0); } while (0)
#define PG8_LDA(dst, b, h) do { _Pragma("unroll") for (int m = 0; m < 4; ++m) _Pragma("unroll") for (int k = 0; k < 2; ++k) dst[m][k] = *(const PG8_LAS bf16x8*)(lds + PG8_SA(b, h) + aoff + m * 2048 + k * 1024); } while (0)
#define PG8_LDB(dst, b, h) do { _Pragma("unroll") for (int n = 0; n < 2; ++n) _Pragma("unroll") for (int k = 0; k < 2; ++k) dst[n][k] = *(const PG8_LAS bf16x8*)(lds + PG8_SB(b, h) + boff + n * 2048 + k * 1024); } while (0)
#define PG8_MMA(ai, bj, At, Bt) do { __builtin_amdgcn_s_setprio(1); _Pragma("unroll") for (int m = 0; m < 4; ++m) _Pragma("unroll") for (int n = 0; n < 2; ++n) _Pragma("unroll") for (int k = 0; k < 2; ++k) \
        acc[ai][bj][m][n] = __builtin_amdgcn_mfma_f32_16x16x32_bf16(Bt[n][k], At[m][k], acc[ai][bj][m][n], 0, 0, 0); __builtin_amdgcn_s_setprio(0); } while (0)
#define PG8_WAIT_V(n) asm volatile("s_waitcnt vmcnt(" #n ")" ::: "memory")
#define PG8_WAIT_L(n) asm volatile("s_waitcnt lgkmcnt(" #n ")" ::: "memory")
#define PG8_BAR __builtin_amdgcn_s_barrier()
#define PG8_SCHED __builtin_amdgcn_sched_barrier(0)
    Unit cur, nxt; int ui = 0;
    if (!S.next(0, cur)) return;
    f32x4 acc[2][2][4][2];
#pragma unroll
    for (int a = 0; a < 2; ++a)
#pragma unroll
        for (int b = 0; b < 2; ++b)
#pragma unroll
            for (int m = 0; m < 4; ++m)
#pragma unroll
                for (int n = 0; n < 2; ++n) acc[a][b][m][n] = (f32x4){0.f, 0.f, 0.f, 0.f};
    bf16x8 At[4][2], B0[2][2], B1[2][2];
    const char* cA = (const char*)g.A + (size_t)cur.pm * tstep; const char* cB = (const char*)g.Bt + (size_t)cur.pn * tstep;
    S.a_ready(cur);
    if constexpr (SP2) {
        PG8_STAGE(PG8_SB(0, 0), cB, voffB); PG8_STAGE(PG8_SB(0, 1), cB + hstep, voffB); PG8_STAGE(PG8_SA(0, 0), cA, voffA); PG8_STAGE(PG8_SA(0, 1), cA + hstep, voffA);
        if (wr == 1) PG8_BAR;
        PG8_WAIT_V(2); PG8_BAR;
        PG8_STAGE(PG8_SB(1, 0), cB + kstep, voffB); PG8_STAGE(PG8_SA(1, 0), cA + kstep, voffA); PG8_STAGE(PG8_SB(1, 1), cB + hstep + kstep, voffB);
        PG8_WAIT_V(6); PG8_BAR;
    } else {
        PG8_STAGE(PG8_SB(0, 0), cB, voffB); PG8_STAGE(PG8_SA(0, 0), cA, voffA); PG8_STAGE(PG8_SB(0, 1), cB + hstep, voffB); PG8_STAGE(PG8_SA(0, 1), cA + hstep, voffA);
        if (wr == 1) PG8_BAR;
        PG8_WAIT_V(4); PG8_BAR;
        PG8_STAGE(PG8_SB(1, 0), cB + kstep, voffB); PG8_STAGE(PG8_SA(1, 0), cA + kstep, voffA); PG8_STAGE(PG8_SB(1, 1), cB + hstep + kstep, voffB);
        PG8_WAIT_V(6); PG8_BAR;
    }
    for (;;) {
        const bool has_next = S.next(ui + 1, nxt);
        const char* nA = has_next ? (const char*)g.A + (size_t)nxt.pm * tstep : cA; const char* nB = has_next ? (const char*)g.Bt + (size_t)nxt.pn * tstep : cB;
        for (int t = 0; t < nt; t += 2) {
            const bool last = (t == nt - 2);
            const char* a1 = cA + (size_t)(t + 1) * kstep;
            const char* a2 = last ? nA : cA + (size_t)(t + 2) * kstep; const char* b2 = last ? nB : cB + (size_t)(t + 2) * kstep;
            const char* a3 = a2 + kstep; const char* b3 = b2 + kstep;
            if (last && has_next) S.a_ready(nxt);
            if constexpr (SP2) {
            PG8_LDB(B0, 0, 0); PG8_LDB(B1, 0, 1); PG8_SCHED; PG8_LDA(At, 0, 0); PG8_STAGE(PG8_SA(1, 1), a1 + hstep, voffA);
            PG8_WAIT_V(8); PG8_WAIT_L(0); PG8_BAR; PG8_MMA(0, 0, At, B0); PG8_MMA(0, 1, At, B1); PG8_BAR; PG8_SCHED;
            PG8_LDA(At, 0, 1); PG8_STAGE(PG8_SB(0, 0), b2, voffB); PG8_STAGE(PG8_SB(0, 1), b2 + hstep, voffB); PG8_STAGE(PG8_SA(0, 0), a2, voffA);
            PG8_WAIT_V(8); PG8_WAIT_L(0); PG8_BAR; PG8_MMA(1, 0, At, B0); PG8_MMA(1, 1, At, B1); PG8_BAR; PG8_SCHED;
            PG8_LDB(B0, 1, 0); PG8_LDB(B1, 1, 1); PG8_SCHED; PG8_LDA(At, 1, 0); PG8_STAGE(PG8_SA(0, 1), a2 + hstep, voffA);
            PG8_WAIT_V(8); PG8_WAIT_L(0); PG8_BAR; PG8_MMA(0, 0, At, B0); PG8_MMA(0, 1, At, B1); PG8_BAR; PG8_SCHED;
            PG8_LDA(At, 1, 1); PG8_STAGE(PG8_SB(1, 0), b3, voffB); PG8_STAGE(PG8_SB(1, 1), b3 + hstep, voffB); PG8_STAGE(PG8_SA(1, 0), a3, voffA);
            PG8_WAIT_V(8); PG8_WAIT_L(0); PG8_BAR; PG8_MMA(1, 0, At, B0); PG8_MMA(1, 1, At, B1); PG8_BAR; PG8_SCHED;
            } else {
            PG8_LDB(B0, 0, 0); PG8_SCHED; PG8_LDA(At, 0, 0); PG8_STAGE(PG8_SA(1, 1), a1 + hstep, voffA);
            PG8_WAIT_L(8); PG8_BAR; PG8_WAIT_L(0); PG8_MMA(0, 0, At, B0); PG8_BAR; PG8_SCHED;
            PG8_LDB(B1, 0, 1); PG8_STAGE(PG8_SB(0, 0), b2, voffB);
            PG8_BAR; PG8_WAIT_L(0); PG8_MMA(0, 1, At, B1); PG8_BAR;
            PG8_LDA(At, 0, 1); PG8_STAGE(PG8_SA(0, 0), a2, voffA);
            PG8_BAR; PG8_WAIT_L(0); PG8_MMA(1, 0, At, B0); PG8_BAR; PG8_SCHED;
            PG8_STAGE(PG8_SB(0, 1), b2 + hstep, voffB);
            PG8_WAIT_V(6); PG8_BAR; PG8_MMA(1, 1, At, B1); PG8_BAR;
            PG8_LDB(B0, 1, 0); PG8_SCHED; PG8_LDA(At, 1, 0); PG8_STAGE(PG8_SA(0, 1), a2 + hstep, voffA);
            PG8_WAIT_L(8); PG8_BAR; PG8_WAIT_L(0); PG8_MMA(0, 0, At, B0); PG8_BAR; PG8_SCHED;
            PG8_LDB(B1, 1, 1); PG8_STAGE(PG8_SB(1, 0), b3, voffB);
            PG8_BAR; PG8_WAIT_L(0); PG8_MMA(0, 1, At, B1); PG8_BAR;
            PG8_LDA(At, 1, 1); PG8_STAGE(PG8_SA(1, 0), a3, voffA);
            PG8_BAR; PG8_WAIT_L(0); PG8_MMA(1, 0, At, B0); PG8_BAR; PG8_SCHED;
            PG8_STAGE(PG8_SB(1, 1), b3 + hstep, voffB);
            PG8_WAIT_V(6); PG8_BAR; PG8_MMA(1, 1, At, B1); PG8_BAR;
            }
        }
        if constexpr (ALIGN_EPI) { if (wr == 0) PG8_BAR; }
        if constexpr (!Epi::AFTER_DRAIN) { E(acc, cur, wr, wc, fr, fq); S.done(cur); }
        if (!has_next) break;
#pragma unroll
        for (int a = 0; a < 2; ++a)
#pragma unroll
            for (int b = 0; b < 2; ++b)
#pragma unroll
                for (int m = 0; m < 4; ++m)
#pragma unroll
                    for (int n = 0; n < 2; ++n) acc[a][b][m][n] = (f32x4){0.f, 0.f, 0.f, 0.f};
        cur = nxt; cA = nA; cB = nB; ++ui;
        if constexpr (ALIGN_EPI) { if (wr == 1) PG8_BAR; }
    }
    PG8_WAIT_V(0);
    if constexpr (!ALIGN_EPI) { if (wr == 0) PG8_BAR; }
    PG8_BAR;
    if constexpr (Epi::AFTER_DRAIN) { E.fused(acc, cur, wr, wc, fr, fq, lds, wid, lane); S.done(cur); }
#undef PG8_SA
#undef PG8_SB
#undef PG8_STAGE
#undef PG8_LDA
#undef PG8_LDB
#undef PG8_MMA
#undef PG8_WAIT_V
#undef PG8_WAIT_L
#undef PG8_BAR
#undef PG8_SCHED
}
}
#define GAS __attribute__((address_space(1)))
#define LAS __attribute__((address_space(3)))
typedef unsigned short bf16;
typedef unsigned v4u __attribute__((ext_vector_type(4)));
typedef float f32x4 __attribute__((ext_vector_type(4)));
typedef short bf16x8 __attribute__((ext_vector_type(8)));
typedef GAS unsigned gu32;
typedef GAS unsigned long long gu64;
#define RLX_AGENT __ATOMIC_RELAXED, __HIP_MEMORY_SCOPE_AGENT
#define LDS_WAIT() asm volatile("s_waitcnt lgkmcnt(0)" ::: "memory")
#define VM_WAIT() asm volatile("s_waitcnt vmcnt(0)" ::: "memory")
__device__ __forceinline__ unsigned long long rt() { return __builtin_amdgcn_s_memrealtime(); }
__device__ __forceinline__ unsigned f2bf(float f) { unsigned u = __builtin_bit_cast(unsigned, f); return (u + 0x7fffu + ((u >> 16) & 1u)) >> 16; }
__device__ __forceinline__ unsigned pk2(float lo, float hi) { return f2bf(lo) | (f2bf(hi) << 16); }

#define XB_TMO      128
#define XB_XCNT(j)  (256  + 64 * (j))
#define XB_XSUB(j)  (1280 + 64 * (j))
#define XB_XGEN(j)  (2304 + 64 * (j))
#define XB_TOP      3328
#define XB_TOPGEN   3392
#define XCD_BAR_WORDS 3456
#define XB_SPIN_CAP (1u << 18)

__device__ __forceinline__ unsigned xb_ld(unsigned* p)              { return __hip_atomic_load(p, __ATOMIC_RELAXED, __HIP_MEMORY_SCOPE_AGENT); }
__device__ __forceinline__ unsigned xb_add(unsigned* p, unsigned v) { return __hip_atomic_fetch_add(p, v, __ATOMIC_RELAXED, __HIP_MEMORY_SCOPE_AGENT); }
__device__ __forceinline__ unsigned xb_xcc_id() { return (unsigned)__builtin_amdgcn_s_getreg((3 << 11) | 20) & 0xFu; }
#define XB_SPIN(cond, bar) do { unsigned _sp = 0; while (cond) { __builtin_amdgcn_s_sleep(1); \
    if ((++_sp & 255u) == 0u) { if (xb_ld(&(bar)[XB_TMO])) break; if (_sp > XB_SPIN_CAP) { atomicAdd(&(bar)[XB_TMO], 1u); break; } } } } while (0)

struct XcdBarrier {
    unsigned* bar; unsigned x; bool t0;
    volatile LAS unsigned* st;
};

__device__ __forceinline__ XcdBarrier xcd_barrier_post(unsigned* bar, volatile LAS unsigned* st, bool t0) {
    XcdBarrier b; b.bar = bar; b.x = xb_xcc_id(); b.st = st; b.t0 = t0;
    if (b.t0) (void)xb_add(&bar[XB_XCNT(b.x)], 1u);
    return b;
}
__device__ __forceinline__ void xcd_barrier_complete(unsigned* bar, unsigned x, unsigned& nloc, unsigned& nx) {
    const unsigned G = gridDim.x * gridDim.y * gridDim.z;
    unsigned sum, cnt, mine, sp = 0u;
    for (;;) {
        sum = 0u; cnt = 0u; mine = 0u;
#pragma unroll
        for (unsigned j = 0; j < 16; ++j) { const unsigned c = xb_ld(&bar[XB_XCNT(j)]); sum += c; cnt += (c > 0u) ? 1u : 0u; mine = (j == x) ? c : mine; }
        if (sum == G) break;
        __builtin_amdgcn_s_sleep(1);
        if ((++sp & 255u) == 0u) { if (xb_ld(&bar[XB_TMO])) break; if (sp > XB_SPIN_CAP) { atomicAdd(&bar[XB_TMO], 1u); break; } }
    }
    nloc = mine > 0u ? mine : 1u; nx = cnt > 0u ? cnt : 1u;
}

__device__ __forceinline__ void xcd_barrier(const XcdBarrier& b) {
    asm volatile("s_waitcnt vmcnt(0)" ::: "memory");
    __syncthreads();
    if (b.t0) {
        unsigned* bar = b.bar;
        __builtin_amdgcn_s_waitcnt(0);
        unsigned nloc = b.st[0], nx = b.st[1];
        if (nloc == 0u) { xcd_barrier_complete(bar, b.x, nloc, nx); b.st[0] = nloc; b.st[1] = nx; }
        const unsigned old = xb_add(&bar[XB_XSUB(b.x)], 1u);
        const unsigned gen = old / nloc;
        if (old + 1u == (gen + 1u) * nloc) {
            __builtin_amdgcn_fence(__ATOMIC_RELEASE, "agent");
            asm volatile("s_waitcnt vmcnt(0)" ::: "memory");
            const unsigned og = xb_add(&bar[XB_TOP], 1u);
            const unsigned tg = og / nx;
            if (og + 1u == (tg + 1u) * nx) xb_add(&bar[XB_TOPGEN], 1u);
            else XB_SPIN(xb_ld(&bar[XB_TOPGEN]) == tg, bar);
            __builtin_amdgcn_fence(__ATOMIC_ACQUIRE, "agent");
            xb_add(&bar[XB_XGEN(b.x)], 1u);
            asm volatile("s_waitcnt vmcnt(0)" ::: "memory");
        } else {
            XB_SPIN(xb_ld(&bar[XB_XGEN(b.x)]) == gen, bar);
            __builtin_amdgcn_fence(__ATOMIC_ACQUIRE, "agent");
            asm volatile("s_waitcnt vmcnt(0)" ::: "memory");
        }
    }
    __syncthreads();
}

constexpr int NWAVES = 8;
constexpr int DM = 1024, NB = 16, SEQ = 4096, CTXL = 256, NH = 8, HD = 64;
constexpr int ML = NB * SEQ;
constexpr int MC = NB * CTXL;
constexpr int MT = ML + MC;
constexpr int PW = 3840;
constexpr int PCW = 1792;
constexpr int PC_NAK = 0, PC_RWK = 512, PC_RWV = 1024, PC_WD = 1536, PC_AD = 1664, PC_RWR = 1792, PC_NAQ = 2304, PC_NAG = 2816, PC_RWG = 3328;
constexpr float RMS_EPS = 1e-6f, GN_EPS = 64e-5f;
constexpr float LOG2E = 1.4426950408889634f;

constexpr size_t MiB = 1u << 20;
constexpr size_t WS_CTL = 0, CTL_ZERO_BYTES = 1 * MiB;
constexpr size_t WS_MOD = 256 * 1024;
constexpr size_t WS_SUMSQ = 512 * 1024;
constexpr size_t WS_WOUT = 2 * MiB;
constexpr size_t WS_WIN = 4 * MiB;
constexpr size_t WS_BONUS = 16 * MiB;
constexpr size_t WS_EDGE = 24 * MiB;
constexpr size_t WS_XN = 32 * MiB;
constexpr size_t WS_P = 168 * MiB;
constexpr size_t WS_VT = 678 * MiB;
constexpr int VTP = MT + 64;
constexpr size_t WS_MIX = 747 * MiB;
constexpr size_t WS_Y = 876 * MiB;
constexpr size_t WS_LFR = 1004 * MiB;
constexpr size_t WS_END = 1012 * MiB;
static_assert(WS_WIN + (size_t)4352 * 1024 * 2 <= WS_BONUS && WS_BONUS + (size_t)ML * 16 * 4 <= WS_XN && WS_XN + (size_t)MT * 1024 * 2 <= WS_P && WS_P + (size_t)MT * PW * 2 <= WS_VT && WS_VT + (size_t)512 * VTP * 2 <= WS_MIX && WS_MIX + (size_t)ML * 1024 * 2 <= WS_END, "ws map");
constexpr int CW_BAR = 4096;

constexpr int LDS_BYTES = 160 * 1024;
constexpr int MISC_OFF = LDS_BYTES - 256;

__device__ __forceinline__ int lane_id_() { int l; asm volatile("v_mbcnt_lo_u32_b32 %0, -1, 0\n\tv_mbcnt_hi_u32_b32 %0, -1, %0" : "=v"(l)); return l; }
struct Frame {
    LAS unsigned char* lds;
    int wave, vcu, G;
    const float *x, *c, *ctx, *c_ctx, *w_mod, *b_mod, *norm_g, *w_in, *conv_w, *decay_w0, *decay_w2, *aaa_a0, *aaa_a2, *k_k, *k_a, *r_k, *gn_w, *gn_b, *na_rpb, *w_out, *final_g;
    float* out; unsigned char* ws;
    float *mod, *sumsq, *bonus;
    bf16 *WoutT, *WinT, *XN, *P, *VT, *MIX, *Y;
};

__device__ __forceinline__ float wave_sum(float v) {
#pragma unroll
    for (int o = 1; o < 64; o <<= 1) v += __shfl_xor(v, o);
    return v;
}
__device__ __forceinline__ float bf2f(unsigned h) { return __uint_as_float(h << 16); }
__device__ __forceinline__ float sigmoidf_(float x) { return __builtin_amdgcn_rcpf(1.f + __builtin_amdgcn_exp2f(-1.4426950408889634f * x)); }
__device__ __forceinline__ float siluf_(float x) { return x * __builtin_amdgcn_rcpf(1.f + __builtin_amdgcn_exp2f(-1.4426950408889634f * x)); }
typedef float f32x16 __attribute__((ext_vector_type(16)));
typedef unsigned u32x2 __attribute__((ext_vector_type(2)));
typedef float f32x2_t __attribute__((ext_vector_type(2))); typedef __bf16 bf16x2_t __attribute__((ext_vector_type(2)));
__device__ __forceinline__ unsigned cvtpk(float lo, float hi) { f32x2_t v = {lo, hi}; bf16x2_t b = __builtin_convertvector(v, bf16x2_t); return __builtin_bit_cast(unsigned, b); }
__device__ __forceinline__ u32x2 pk4(float a, float b, float c, float d) { u32x2 r; r.x = cvtpk(a, b); r.y = cvtpk(c, d); return r; }
template <int CTRL> __device__ __forceinline__ float dpp_mov(float x) { return __builtin_bit_cast(float, __builtin_amdgcn_update_dpp(0, __builtin_bit_cast(int, x), CTRL, 0xf, 0xf, true)); }
__device__ __forceinline__ float red8(float x) { x += dpp_mov<0xB1>(x); x += dpp_mov<0x4E>(x); x += dpp_mov<0x141>(x); return x; }
__device__ __forceinline__ float red16(float x) { x = red8(x); x += dpp_mov<0x140>(x); return x; }
__device__ __forceinline__ float sum32x(float x) { auto rr = __builtin_amdgcn_permlane32_swap(__float_as_uint(x), __float_as_uint(x), false, false); return __uint_as_float(rr[0]) + __uint_as_float(rr[1]); }
__device__ __forceinline__ float max32x(float x) { auto rr = __builtin_amdgcn_permlane32_swap(__float_as_uint(x), __float_as_uint(x), false, false); return fmaxf(__uint_as_float(rr[0]), __uint_as_float(rr[1])); }
__device__ __forceinline__ float sum16x(float x) { auto rr = __builtin_amdgcn_permlane16_swap(__float_as_uint(x), __float_as_uint(x), false, false); return __uint_as_float(rr[0]) + __uint_as_float(rr[1]); }
__device__ __forceinline__ float xlane32(float x, int hh) { auto rr = __builtin_amdgcn_permlane32_swap(__float_as_uint(x), __float_as_uint(x), false, false); return __uint_as_float(hh ? rr[0] : rr[1]); }
__device__ __forceinline__ float xlane16(float x, int godd) { auto rr = __builtin_amdgcn_permlane16_swap(__float_as_uint(x), __float_as_uint(x), false, false); return __uint_as_float(godd ? rr[0] : rr[1]); }

__device__ __forceinline__ void p0_transpose_item(const float* W, int K, int N, bf16* WT, int k0, int n0, int drow0, LAS float* scr, int lane) {
#pragma unroll 8
    for (int i = 0; i < 32; ++i) { const int kk = 2 * i + (lane >> 5); scr[kk * 33 + (lane & 31)] = W[(size_t)(k0 + kk) * N + n0 + (lane & 31)]; }
    LDS_WAIT(); asm volatile("" ::: "memory");
    const int c = lane & 7;
#pragma unroll
    for (int j = 0; j < 4; ++j) { const int n = (lane >> 3) + 8 * j; const LAS float* s = scr + (8 * c) * 33 + n;
        v4u o; o.x = pk2(s[0 * 33], s[1 * 33]); o.y = pk2(s[2 * 33], s[3 * 33]); o.z = pk2(s[4 * 33], s[5 * 33]); o.w = pk2(s[6 * 33], s[7 * 33]);
        *(GAS v4u*)(WT + (size_t)(drow0 + n) * K + k0 + 8 * c) = o; }
    LDS_WAIT(); asm volatile("" ::: "memory");
}
__device__ __forceinline__ void p0_prologue(Frame& F) {
    LAS float* scr = (LAS float*)(F.lds + F.wave * 16384);
    const int gw = F.vcu * NWAVES + F.wave, NGW = F.G * NWAVES, lane = lane_id_();
    for (int it = gw; it < 48 * 32; it += NGW) {
        const int cc = it % 48, ks = it / 48, n = cc * 64 + lane, k0 = ks * 32;
        for (int e = lane; e < 17 * 32; e += 64) { const int row = e >> 5, kk = e & 31; const float cv = (row < 16) ? F.c[row * 1024 + k0 + kk] : F.c_ctx[k0 + kk]; scr[e] = siluf_(cv); }
        LDS_WAIT(); asm volatile("" ::: "memory");
        float acc[17];
#pragma unroll
        for (int r = 0; r < 17; ++r) acc[r] = 0.f;
        for (int kk = 0; kk < 32; ++kk) { const float w = F.w_mod[(size_t)(k0 + kk) * 3072 + n];
#pragma unroll
            for (int r = 0; r < 17; ++r) acc[r] += scr[r * 32 + kk] * w; }
        if (ks == 0) { const float bb = F.b_mod[n];
#pragma unroll
            for (int r = 0; r < 17; ++r) acc[r] += bb; }
#pragma unroll
        for (int r = 0; r < 17; ++r) atomicAdd(F.mod + r * 3072 + n, acc[r]);
        LDS_WAIT(); asm volatile("" ::: "memory");
    }
    constexpr int I_IN = 16 * 136, I_OUT = 16 * 32;
    for (int it = gw; it < I_IN + I_OUT; it += NGW) {
        if (it < I_IN) { const int kb = it / 136, nb = it % 136, n0 = nb * 32; const int drow0 = (n0 < 512) ? n0 : (n0 < 1024 ? n0 + 3328 : n0 - 512);
            p0_transpose_item(F.w_in, 1024, 4352, F.WinT, kb * 64, n0, drow0, scr, lane); }
        else { const int r = it - I_IN, kb = r / 32, nb = r % 32; p0_transpose_item(F.w_out, 1024, 1024, F.WoutT, kb * 64, nb * 32, nb * 32, scr, lane); }
    }
}

__device__ __forceinline__ void p1_xn(Frame& F) {
    const int gw = F.vcu * NWAVES + F.wave, NGW = F.G * NWAVES, lane = lane_id_();
    f32x4 g[4];
#pragma unroll
    for (int j = 0; j < 4; ++j) g[j] = *(const f32x4*)(F.norm_g + 4 * (lane + 64 * j));
    for (int bb = 0; bb < 17; ++bb) {
        const float* md = F.mod + bb * 3072;
        f32x4 sh[4], sc[4];
#pragma unroll
        for (int j = 0; j < 4; ++j) { sh[j] = *(const f32x4*)(md + 4 * (lane + 64 * j)); sc[j] = *(const f32x4*)(md + 1024 + 4 * (lane + 64 * j)) + 1.0f; }
        for (int r0 = 2 * gw; r0 < 4096; r0 += 2 * NGW) {
            const size_t m0 = (size_t)bb * 4096 + r0;
            const float* xbase = (bb < 16) ? F.x + m0 * DM : F.ctx + (size_t)r0 * DM;
            f32x4 v[2][4]; float ss[2] = {0.f, 0.f};
#pragma unroll
            for (int u = 0; u < 2; ++u)
#pragma unroll
                for (int j = 0; j < 4; ++j) v[u][j] = *((const GAS f32x4*)(xbase + (size_t)u * DM) + lane + 64 * j);
#pragma unroll
            for (int u = 0; u < 2; ++u) {
#pragma unroll
                for (int j = 0; j < 4; ++j) ss[u] += (v[u][j].x * v[u][j].x + v[u][j].y * v[u][j].y) + (v[u][j].z * v[u][j].z + v[u][j].w * v[u][j].w);
                ss[u] = sum32x(sum16x(red16(ss[u])));
            }
#pragma unroll
            for (int u = 0; u < 2; ++u) {
                const float rstd = rsqrtf(ss[u] * (1.f / DM) + RMS_EPS);
                GAS unsigned long long* o8 = (GAS unsigned long long*)(F.XN + (m0 + u) * DM) + lane;
#pragma unroll
                for (int j = 0; j < 4; ++j) {
                    const f32x4 y = (v[u][j] * rstd * g[j]) * sc[j] + sh[j];
                    o8[64 * j] = (unsigned long long)cvtpk(y.x, y.y) | ((unsigned long long)cvtpk(y.z, y.w) << 32);
                }
            }
        }
    }
}

constexpr int AT_SLOT = 18432, AT_VOFF = 9216, AT_NSLOT = 7, AT_WS = AT_NSLOT * AT_SLOT, AT_ROW = 72;
static_assert(AT_WS + 8 * 4096 <= MISC_OFF, "attention LDS map");
__device__ __forceinline__ void p3_attention(Frame& F) {
    LAS unsigned char* L = F.lds;
    LAS float* wsf = (LAS float*)(L + AT_WS + F.wave * 4096);
    LAS float* bt = wsf + 192;
    const int wave = F.wave, lane = lane_id_(), tid = wave * 64 + lane, q = lane & 31, hh = lane >> 5;
    const int ldk = tid >> 3, ldc = tid & 7;
    const float C2 = 0.125f * LOG2E;
    for (int bu = F.vcu * 8; bu < NB * NH * 16; bu += F.G * 8) {
        const int h = (bu >> 4) & 7, b = bu >> 7;
        for (int e = lane; e < 15 * 31; e += 64) bt[e] = F.na_rpb[h * 465 + e] * LOG2E;
        bf16x8 qf[4];
        for (int uu = 0; uu < 8; ++uu) {
            const int band = (bu + uu) & 15, i0 = 4 * band, i = i0 + (wave >> 1), J = wave & 1;
            const int r0 = min(max(i - 4, 0), 56), rmin = min(max(i0 - 4, 0), 56), dl = r0 - rmin;
            const int qc = 32 * J + q, c0 = min(max(qc - 8, 0), 48);
            const size_t qrow = (size_t)(b * SEQ + i * 64 + qc);
            if (uu == 0) {
#pragma unroll
                for (int s = 0; s < 4; ++s) qf[s] = *(const bf16x8*)(F.P + qrow * PW + PC_NAQ + h * 64 + 16 * s + 8 * hh);
            }
            float m_run = -1e30f, l_run = 0.f;
            f32x16 o0, o1;
#pragma unroll
            for (int r = 0; r < 16; ++r) { o0[r] = 0.f; o1[r] = 0.f; }
            const bf16* kgl = F.P + PC_NAK + h * 64 + 8 * ldc;
            const bf16* vgl = F.VT + (size_t)(h * 64 + ldk) * VTP + 8 * ldc;
            if (uu == 0) {
                const size_t tb0 = (size_t)ML + (size_t)b * CTXL;
                const v4u kr = *(const GAS v4u*)(kgl + (tb0 + ldk) * PW), vr = *(const GAS v4u*)(vgl + tb0);
                *(LAS v4u*)(L + 5 * AT_SLOT + (ldk * AT_ROW + 8 * ldc) * 2) = kr; *(LAS v4u*)(L + 5 * AT_SLOT + AT_VOFF + (ldk * AT_ROW + 8 * ldc) * 2) = vr;
            }
            asm volatile("" : "+v"(qf[0]), "+v"(qf[1]), "+v"(qf[2]), "+v"(qf[3]));
            if (uu == 0) __syncthreads();
            for (int ph = 0; ph < 8; ++ph) {
                v4u kreg[2], vreg[2]; int nslot[2]; bool nval[2];
#pragma unroll
                for (int x = 0; x < 2; ++x) {
                    const unsigned ktab = x == 0 ? 0xF9753FFFu : 0xFA864210u;
                    const int k = (int)((ktab >> (4 * ph)) & 15u), chunk = (ph + 1) & 7;
                    const bool cload = x == 0 && (ph < 3 || (ph == 7 && uu < 7));
                    const bool lload = k != 15 && rmin + k < 64;
                    nval[x] = cload || lload;
                    nslot[x] = cload ? 5 + (chunk & 1) : (k < 7 ? k : k - 7);
                    const size_t tb = cload ? (size_t)ML + (size_t)b * CTXL + 64 * chunk : (size_t)b * SEQ + 64 * (rmin + (k & 15));
                    if (nval[x]) { kreg[x] = *(const GAS v4u*)(kgl + (tb + ldk) * PW); vreg[x] = *(const GAS v4u*)(vgl + tb); }
                }
                const bool isctx = ph < 4;
                const int p = ph - 4;
                {
                    const int ka = dl + 2 * p;
                    const int sA = isctx ? 5 + (ph & 1) : ka % 7, sB = isctx ? sA : (ka + 1) % 7;
                    const int ntile = isctx ? 2 : 3;
                    f32x16 scs[3];
                    {
                        bf16x8 kf[3][4];
#pragma unroll
                        for (int tile = 0; tile < 3; ++tile) {
                            if (tile >= ntile) break;
                            const int cb = J + tile;
                            const LAS bf16* kp = isctx ? (const LAS bf16*)(L + sA * AT_SLOT) + (32 * tile + q) * AT_ROW + 8 * hh
                                                       : (const LAS bf16*)(L + ((q >> 4) ? sB : sA) * AT_SLOT) + (16 * cb + (q & 15)) * AT_ROW + 8 * hh;
#pragma unroll
                            for (int s = 0; s < 4; ++s) kf[tile][s] = *(const LAS bf16x8*)(kp + 16 * s);
                        }
                        __builtin_amdgcn_sched_barrier(0);
#pragma unroll
                        for (int tile = 0; tile < 3; ++tile) {
                            if (tile >= ntile) break;
#pragma unroll
                            for (int r = 0; r < 16; ++r) scs[tile][r] = 0.f;
#pragma unroll
                            for (int s = 0; s < 4; ++s) scs[tile] = __builtin_amdgcn_mfma_f32_32x32x16_bf16(kf[tile][s], qf[s], scs[tile], 0, 0, 0);
                        }
                    }
                    if (ph == 7 && uu < 7) {
                        const size_t qrow_n = (size_t)(b * SEQ + (i + 4) * 64 + qc);
#pragma unroll
                        for (int s = 0; s < 4; ++s) qf[s] = *(const bf16x8*)(F.P + qrow_n * PW + PC_NAQ + h * 64 + 16 * s + 8 * hh);
                    }
                    float tmax = -1e30f;
                    if (isctx) {
#pragma unroll
                        for (int tile = 0; tile < 2; ++tile)
#pragma unroll
                            for (int r = 0; r < 16; ++r) { scs[tile][r] *= C2; tmax = fmaxf(tmax, scs[tile][r]); }
                    } else {
                        float bvv[3][2][8];
#pragma unroll
                        for (int tile = 0; tile < 3; ++tile) {
                            const LAS float* bp = bt + (rmin + ka - i + 7) * 31 + 16 * (J + tile) - qc + 15 + 4 * hh;
#pragma unroll
                            for (int hf = 0; hf < 2; ++hf)
#pragma unroll
                                for (int r = 0; r < 8; ++r) bvv[tile][hf][r] = bp[31 * hf + (r & 3) + 8 * ((r >> 2) & 1)];
                        }
#pragma unroll
                        for (int tile = 0; tile < 3; ++tile)
#pragma unroll
                            for (int hf = 0; hf < 2; ++hf)
                                asm volatile("" : "+v"(bvv[tile][hf][0]), "+v"(bvv[tile][hf][1]), "+v"(bvv[tile][hf][2]), "+v"(bvv[tile][hf][3]), "+v"(bvv[tile][hf][4]), "+v"(bvv[tile][hf][5]), "+v"(bvv[tile][hf][6]), "+v"(bvv[tile][hf][7]));
#pragma unroll
                        for (int tile = 0; tile < 3; ++tile) {
                            const int t0 = 16 * (J + tile) - c0 + 4 * hh;
#pragma unroll
                            for (int hf = 0; hf < 2; ++hf)
#pragma unroll
                                for (int r = 0; r < 8; ++r) {
                                    const int co = (r & 3) + 8 * ((r >> 2) & 1);
                                    const bool valid = (unsigned)(t0 + co) < 16u;
                                    const float val = valid ? scs[tile][8 * hf + r] * C2 + bvv[tile][hf][r] : -1e30f;
                                    scs[tile][8 * hf + r] = val; tmax = fmaxf(tmax, val);
                                }
                        }
                    }
                    tmax = max32x(tmax);
                    {
                        const float m_new = fmaxf(m_run, tmax), alpha = __builtin_amdgcn_exp2f(m_run - m_new);
                        m_run = m_new; l_run *= alpha;
#pragma unroll
                        for (int r = 0; r < 16; ++r) { o0[r] *= alpha; o1[r] *= alpha; }
                    }
#pragma unroll
                    for (int tile = 0; tile < 3; ++tile) {
                        if (tile >= ntile) break;
                        const int cb = J + tile;
                        bf16x8 vf[2][2];
#pragma unroll
                        for (int db = 0; db < 2; ++db)
#pragma unroll
                            for (int s = 0; s < 2; ++s) {
                                const LAS bf16* vp = isctx ? (const LAS bf16*)(L + sA * AT_SLOT + AT_VOFF) + (32 * db + q) * AT_ROW + 32 * tile + 16 * s + 4 * hh
                                                           : (const LAS bf16*)(L + (s ? sB : sA) * AT_SLOT + AT_VOFF) + (32 * db + q) * AT_ROW + 16 * cb + 4 * hh;
                                const u32x2 lo = *(const LAS u32x2*)vp, hi = *(const LAS u32x2*)(vp + 8);
                                v4u w; w.x = lo.x; w.y = lo.y; w.z = hi.x; w.w = hi.y;
                                vf[db][s] = __builtin_bit_cast(bf16x8, w);
                            }
                        float psum = 0.f; f32x16 sc;
#pragma unroll
                        for (int r = 0; r < 16; ++r) { sc[r] = __builtin_amdgcn_exp2f(scs[tile][r] - m_run); psum += sc[r]; }
                        l_run += psum;
                        bf16x8 pa[2];
#pragma unroll
                        for (int s = 0; s < 2; ++s) { v4u w; w.x = cvtpk(sc[8 * s + 0], sc[8 * s + 1]); w.y = cvtpk(sc[8 * s + 2], sc[8 * s + 3]); w.z = cvtpk(sc[8 * s + 4], sc[8 * s + 5]); w.w = cvtpk(sc[8 * s + 6], sc[8 * s + 7]); pa[s] = __builtin_bit_cast(bf16x8, w); }
#pragma unroll
                        for (int s = 0; s < 2; ++s) { o0 = __builtin_amdgcn_mfma_f32_32x32x16_bf16(vf[0][s], pa[s], o0, 0, 0, 0); o1 = __builtin_amdgcn_mfma_f32_32x32x16_bf16(vf[1][s], pa[s], o1, 0, 0, 0); }
                    }
                }
#pragma unroll
                for (int x = 0; x < 2; ++x) if (nval[x]) {
                    *(LAS v4u*)(L + nslot[x] * AT_SLOT + (ldk * AT_ROW + 8 * ldc) * 2) = kreg[x]; *(LAS v4u*)(L + nslot[x] * AT_SLOT + AT_VOFF + (ldk * AT_ROW + 8 * ldc) * 2) = vreg[x]; }
                __syncthreads();
            }
            const float inv = 1.f / sum32x(l_run);
            {
                const size_t tq = (size_t)(b * SEQ + i * 64 + 32 * J + q);
                const bf16* gp = F.P + tq * PW + PC_NAG + h * 64; bf16* mp = F.MIX + tq * DM + h * 64;
#pragma unroll
                for (int db = 0; db < 2; ++db)
#pragma unroll
                    for (int gg = 0; gg < 4; ++gg) {
                        const int d0 = 32 * db + 8 * gg + 4 * hh;
                        const u32x2 gv = *(const GAS u32x2*)(gp + d0);
                        float o[4];
#pragma unroll
                        for (int e = 0; e < 4; ++e) { const float g = (e & 1) ? __uint_as_float((e < 2 ? gv.x : gv.y) & 0xffff0000u) : __uint_as_float((e < 2 ? gv.x : gv.y) << 16);
                            o[e] = (db ? o1[4 * gg + e] : o0[4 * gg + e]) * inv * siluf_(g); }
                        *(GAS u32x2*)(mp + d0) = pk4(o[0], o[1], o[2], o[3]);
                    }
            }
            LDS_WAIT(); asm volatile("" ::: "memory");
        }
    }
}

constexpr int SX_KC = 0, SX_VC = 16384, SX_RC = 24576, SX_TW = 32768, SX_AD = 41984, SX_INVN = 51200;
constexpr int SX_NBAT = 0, SX_NKA = 8192, SX_QBRT = 13312, SX_QKRT = 18432, SX_TT = 27648, SX_G = 32768, SX_M = 43008, SX_E1T = 48128, SX_ZT = 57344;
constexpr int SY0 = 62464, SY_AB = SY0, SY_BB = SY0 + 9216, SY_KB = SY0 + 18432, SY_RB = SY0 + 27648, SY_PCT = SY0;
constexpr int SZ0 = 99328, SZ_ABT = SZ0, SZ_BCT = SZ0 + 10240, SZ_KCT = SZ0 + 20480, SZ_VT = SZ0 + 30720, SZ_DCT = SZ0;
constexpr int SS_ST = 140288  , SM_GC = 158720, SM_BON = SM_GC + 512, SCAN_LDS_END = SM_BON + 256;
constexpr int SC_CW = SCAN_LDS_END;
constexpr int SC_RAW = 52224;
static_assert(SC_CW + 4096 <= MISC_OFF, "scan LDS map");
constexpr int TS = 72, CS = 40;

template <int NK> __device__ __forceinline__ f32x16 tile_mm(const LAS bf16* xrow, const LAS bf16* yrow) {
    f32x16 acc;
#pragma unroll
    for (int r = 0; r < 16; ++r) acc[r] = 0.f;
#pragma unroll
    for (int s = 0; s < NK; ++s) acc = __builtin_amdgcn_mfma_f32_32x32x16_bf16(*(const LAS bf16x8*)(xrow + 16 * s), *(const LAS bf16x8*)(yrow + 16 * s), acc, 0, 0, 0);
    return acc;
}

typedef short bf16x4 __attribute__((ext_vector_type(4)));

template <bool ISP> __device__ __forceinline__ void f_tile(const LAS bf16* X, const LAS bf16* Y, const LAS bf16* Bp, LAS bf16* Op, const float gcv, const int dj, const int hh) {
    bf16x4 bvv[4];
    if (!ISP) {
#pragma unroll
        for (int gg = 0; gg < 4; ++gg) bvv[gg] = *(const LAS bf16x4*)(Bp + 8 * gg);
    }
    const f32x16 acc = tile_mm<2>(X, Y);
#pragma unroll
    for (int gg = 0; gg < 4; ++gg) {
        const int r0 = 8 * gg + 4 * hh;
        float o[4];
#pragma unroll
        for (int e = 0; e < 4; ++e) { const float base = ISP ? ((r0 + e) == dj ? gcv : 0.f) : bf2f((unsigned short)bvv[gg][e]); o[e] = base - acc[4 * gg + e]; }
        *(LAS u32x2*)(Op + r0) = pk4(o[0], o[1], o[2], o[3]);
    }
}
__device__ __forceinline__ v4u patch8(const v4u c, const v4u e, const LAS float* w) {
    const f32x4 wa = *(const LAS f32x4*)w, wb = *(const LAS f32x4*)(w + 4);
    v4u o;
#pragma unroll
    for (int e2 = 0; e2 < 4; ++e2) {
        const float wl = e2 < 2 ? wa[2 * e2] : wb[2 * e2 - 4], wh = e2 < 2 ? wa[2 * e2 + 1] : wb[2 * e2 - 3];
        o[e2] = cvtpk(__uint_as_float(c[e2] << 16) + wl * __uint_as_float(e[e2] << 16), __uint_as_float(c[e2] & 0xffff0000u) + wh * __uint_as_float(e[e2] & 0xffff0000u));
    }
    return o;
}
__device__ __forceinline__ void scan_a2(LAS unsigned char* L, const int wave, const int d, const bool lat_, const int p0_, v4u c0, v4u c1, v4u c2, v4u c3, v4u c4, const v4u prh) {
    const int lane_ = lane_id_(); const int tt = 8 * wave + (lane_ >> 3), nn = lane_ & 7;
    LAS float* KC = (LAS float*)(L + SX_KC); LAS bf16* VC = (LAS bf16*)(L + SX_VC); LAS bf16* RC = (LAS bf16*)(L + SX_RC);
    LAS bf16* TW = (LAS bf16*)(L + SX_TW); LAS bf16* AD = (LAS bf16*)(L + SX_AD); LAS float* INVN = (LAS float*)(L + SX_INVN); LAS float* BON = (LAS float*)(L + SM_BON);
    const LAS float* CW = (const LAS float*)(L + SC_CW);
    if ((wave == 0 || wave == 7) && lat_) {
        const int ttp = wave ? 63 : 0, idxp = d ? (SEQ - 1 - p0_ - ttp) : p0_ + ttp, em = idxp & 255;
        const bool np = em == 0 && idxp > 0, nx = em == 255 && idxp < SEQ - 1;
        if (np || nx) {
            LAS bf16* PT = (LAS bf16*)(L + SC_RAW) + (wave ? 320 : 0);
            if (lane_ < 40) *(LAS v4u*)(PT + lane_ * 8) = prh;
            asm volatile("s_waitcnt lgkmcnt(0)" ::: "memory");
            if (tt == ttp) {
                const LAS float* cw = CW + (np ? 0 : 640) + 8 * nn;
                c0 = patch8(c0, *(const LAS v4u*)(PT + 0 * 64 + 8 * nn), cw + 0 * 64); c1 = patch8(c1, *(const LAS v4u*)(PT + 1 * 64 + 8 * nn), cw + 1 * 64); c2 = patch8(c2, *(const LAS v4u*)(PT + 2 * 64 + 8 * nn), cw + 2 * 64);
                c3 = patch8(c3, *(const LAS v4u*)(PT + 3 * 64 + 8 * nn), cw + 3 * 64); c4 = patch8(c4, *(const LAS v4u*)(PT + 4 * 64 + 8 * nn), cw + 4 * 64);
            }
        }
    }
    {
        const f32x4 ka = *(const LAS f32x4*)(CW + 960 + 8 * nn), kb = *(const LAS f32x4*)(CW + 960 + 8 * nn + 4);
        float u[8]; float ss = 0.f;
#pragma unroll
        for (int e2 = 0; e2 < 4; ++e2) { u[2 * e2] = __uint_as_float(c0[e2] << 16); u[2 * e2 + 1] = __uint_as_float(c0[e2] & 0xffff0000u); }
#pragma unroll
        for (int e = 0; e < 8; ++e) { const float kq = u[e] * (e < 4 ? ka[e] : kb[e - 4]); ss += kq * kq; }
        *(LAS f32x4*)(KC + tt * 64 + 8 * nn) = (f32x4){u[0], u[1], u[2], u[3]}; *(LAS f32x4*)(KC + tt * 64 + 8 * nn + 4) = (f32x4){u[4], u[5], u[6], u[7]};
        ss = red8(ss);
        if (nn == 0) INVN[tt] = rsqrtf(fmaxf(ss, 1e-24f));
    }
    *(LAS v4u*)(VC + tt * 64 + 8 * nn) = c1;
    *(LAS v4u*)(RC + tt * 64 + 8 * nn) = c2;
    if (wave == 0 || wave == 7) {
        const int pos_ = p0_ + tt, idx_ = d ? ((lat_ ? SEQ : CTXL) - 1 - pos_) : pos_, em = idx_ & 255;
        if (em == 0 || em == 255) {
#pragma unroll
            for (int e2 = 0; e2 < 4; ++e2) {
                const float ta = __builtin_amdgcn_exp2f(__uint_as_float(c3[e2] << 16) * (2.f * LOG2E)), tb = __builtin_amdgcn_exp2f(__uint_as_float(c3[e2] & 0xffff0000u) * (2.f * LOG2E));
                c3[e2] = cvtpk(1.f - 2.f * __builtin_amdgcn_rcpf(ta + 1.f), 1.f - 2.f * __builtin_amdgcn_rcpf(tb + 1.f));
            }
        }
    }
    *(LAS v4u*)(TW + tt * TS + 8 * nn) = c3;
    *(LAS v4u*)(AD + tt * TS + 8 * nn) = c4;
}
__device__ __forceinline__ void p4_scan(Frame& F) {
    if (F.vcu >= NB * NH * 2) return;
    const int chain = F.vcu, d = chain & 1, h = (chain >> 1) & 7, b = chain >> 4;
    const int wave = F.wave, lane = lane_id_(), tid = wave * 64 + lane;
    LAS unsigned char* L = F.lds;
    LAS float* KC = (LAS float*)(L + SX_KC); LAS bf16* VC = (LAS bf16*)(L + SX_VC); LAS bf16* RC = (LAS bf16*)(L + SX_RC);
    LAS bf16* TW = (LAS bf16*)(L + SX_TW); LAS bf16* AD = (LAS bf16*)(L + SX_AD); LAS float* INVN = (LAS float*)(L + SX_INVN);
    LAS float* NBAT = (LAS float*)(L + SX_NBAT); LAS bf16* NKA = (LAS bf16*)(L + SX_NKA); LAS bf16* QBRT = (LAS bf16*)(L + SX_QBRT); LAS bf16* QKRT = (LAS bf16*)(L + SX_QKRT);
    LAS bf16* TT = (LAS bf16*)(L + SX_TT); LAS bf16* GG = (LAS bf16*)(L + SX_G); LAS bf16* MM = (LAS bf16*)(L + SX_M); LAS bf16* E1T = (LAS bf16*)(L + SY_KB);       LAS bf16* ZT = (LAS bf16*)(L + SX_ZT);
    LAS bf16* AB = (LAS bf16*)(L + SY_AB); LAS bf16* BB = (LAS bf16*)(L + SY_BB); LAS bf16* KB = (LAS bf16*)(L + SY_KB); LAS bf16* RB = (LAS bf16*)(L + SY_RB); LAS bf16* PCT = (LAS bf16*)(L + SY_PCT);
    LAS bf16* ABT = (LAS bf16*)(L + SZ_ABT); LAS bf16* BCT = (LAS bf16*)(L + SZ_BCT); LAS bf16* KCT = (LAS bf16*)(L + SZ_KCT); LAS bf16* VT = (LAS bf16*)(L + SZ_VT); LAS bf16* DCT = (LAS bf16*)(L + SZ_DCT);
    LAS bf16* SST = (LAS bf16*)(L + SS_ST); LAS float* GC = (LAS float*)(L + SM_GC); LAS float* BON = (LAS float*)(L + SM_BON);
    LAS float* CW = (LAS float*)(L + SC_CW);
    if (tid < 64) CW[960 + tid] = F.k_k[h * 64 + tid];
    for (int e = tid; e < 960; e += 512) { const int tap = e / 320, g = (e % 320) >> 6, c = e & 63;
        const int col = (g == 0 ? PC_RWK + h * 64 : g == 1 ? PC_RWV + h * 64 : g == 2 ? PC_RWR + h * 64 : g == 3 ? PC_WD + d * 64 : PC_AD + d * 64) + c;
        CW[e] = F.conv_w[tap * 1792 + col - 512]; }
    bf16x8 bwf[2], baf[2];
    { const int n_ = lane & 15, g_ = lane >> 4, cj_ = h * 64 + 16 * (wave & 3) + n_;
#pragma unroll
      for (int s2 = 0; s2 < 2; ++s2) { v4u ww, wa;
#pragma unroll
        for (int e2 = 0; e2 < 4; ++e2) { const int r0_ = 32 * s2 + 8 * g_ + 2 * e2;
            ww[e2] = cvtpk(F.decay_w2[((size_t)d * 64 + r0_) * 512 + cj_], F.decay_w2[((size_t)d * 64 + r0_ + 1) * 512 + cj_]);
            wa[e2] = cvtpk(F.aaa_a2[((size_t)d * 64 + r0_) * 512 + cj_], F.aaa_a2[((size_t)d * 64 + r0_ + 1) * 512 + cj_]); }
        bwf[s2] = __builtin_bit_cast(bf16x8, ww); baf[s2] = __builtin_bit_cast(bf16x8, wa); } }
    GAS v4u* lfr = (GAS v4u*)(F.ws + WS_LFR) + ((size_t)chain * 512 + tid) * 4;
    lfr[0] = __builtin_bit_cast(v4u, bwf[0]); lfr[1] = __builtin_bit_cast(v4u, bwf[1]); lfr[2] = __builtin_bit_cast(v4u, baf[0]); lfr[3] = __builtin_bit_cast(v4u, baf[1]);
    v4u lfrv[4] = {__builtin_bit_cast(v4u, bwf[0]), __builtin_bit_cast(v4u, bwf[1]), __builtin_bit_cast(v4u, baf[0]), __builtin_bit_cast(v4u, baf[1])};
    const int cjp_ = h * 64 + 16 * (wave & 3) + (lane & 15);
    const float w0 = F.decay_w0[d * 512 + cjp_], a0v = F.aaa_a0[d * 512 + cjp_], kkc = F.k_k[cjp_], kac = F.k_a[cjp_], rkc = F.r_k[cjp_];
    for (int e = tid; e < 2 * 64 * TS / 2; e += 512) ((LAS unsigned*)SST)[e] = 0u;
    if (tid < 64) BON[tid] = 0.f;
    int scur = 0;
#define SCAN_A_GEOM(SCN) const int sn_ = (SCN); const bool lat_ = sn_ >= 4; const int Lq_ = lat_ ? SEQ : CTXL; \
        const size_t rb_ = lat_ ? (size_t)b * SEQ : (size_t)ML + (size_t)b * CTXL; const int p0_ = lat_ ? sn_ * 64 - 256 : sn_ * 64; \
        const int tid_ = wave * 64 + lane_id_(); const int tt = tid_ >> 3, nn = tid_ & 7; \
        const int pos_ = p0_ + tt, idx_ = d ? (Lq_ - 1 - pos_) : pos_, lo_ = d ? (Lq_ - 64 - p0_) : p0_;
#define SCAN_COL(g) ((g) == 0 ? PC_RWK + hc_ : (g) == 1 ? PC_RWV + hc_ : (g) == 2 ? PC_RWR + hc_ : (g) == 3 ? PC_WD + dc_ : PC_AD + dc_)
#define SCAN_A_LOAD(SCN) do { SCAN_A_GEOM(SCN) int hc_ = h * 64, dc_ = d * 64; asm volatile("" : "+v"(hc_), "+v"(dc_));     \
        const bf16* prow = F.P + (rb_ + idx_) * PW; const v4u z = {0u, 0u, 0u, 0u}; \
        _Pragma("unroll") for (int g = 0; g < 5; ++g) { if (g == 2 && !lat_) prc[g] = z; else prc[g] = *(const GAS v4u*)(prow + SCAN_COL(g) + 8 * nn); } \
        prh = z; if ((wave == 0 || wave == 7) && lat_) { const int l_ = tid_ & 63, idxp_ = d ? (Lq_ - 1 - p0_ - (wave ? 63 : 0)) : p0_ + (wave ? 63 : 0), em_ = idxp_ & 255;        \
            const bool np_ = em_ == 0 && idxp_ > 0, nx_ = em_ == 255 && idxp_ < SEQ - 1; \
            if (l_ < 40 && (np_ || nx_)) { const int tl_ = (int)((rb_ + idxp_) >> 8), hg_ = l_ >> 3; \
                int colh_ = ((hg_ == 0) ? 0 : (hg_ == 1) ? 512 : (hg_ == 2) ? 1280 : (hg_ == 3) ? 1024 : 1152) + ((hg_ < 3) ? h : d) * 64 + 8 * nn; asm volatile("" : "+v"(colh_)); \
                prh = *(const GAS v4u*)((const bf16*)(F.ws + WS_EDGE) + (size_t)((np_ ? tl_ - 1 : tl_ + 1) * 2 + (np_ ? 1 : 0)) * 1792 + colh_); } } } while (0)
    { v4u prc[5], prh;
    SCAN_A_LOAD(0);
    __syncthreads();
    scan_a2(L, wave, d, false, 0, prc[0], prc[1], prc[2], prc[3], prc[4], prh); }
    __syncthreads();
    for (int sc = 0; sc < 68; ++sc) {
        const bool lat = sc >= 4;
        const int Lq = lat ? SEQ : CTXL;
        const size_t rbase = lat ? (size_t)b * SEQ : (size_t)ML + (size_t)b * CTXL;
        const int pos0 = lat ? sc * 64 - 256 : sc * 64;
        {
            const int lane_ = lane_id_();
            const int q = wave >> 2, cb = wave & 3, n = lane_ & 15, g = lane_ >> 4, j = 16 * cb + n, cj = h * 64 + j;
            int bo64 = (32 * q + 4 * g) * 64 + j, boTS = (32 * q + 4 * g) * TS + j; asm volatile("" : "+v"(bo64), "+v"(boTS));
            const LAS float* KCb = KC + bo64; const LAS unsigned short* VCu = (const LAS unsigned short*)VC + bo64; const LAS unsigned short* RCu = (const LAS unsigned short*)RC + bo64; const LAS float* INb = INVN + 32 * q + 4 * g;
            f32x2_t kq_[2][2], iq_[2][2]; unsigned vr_[2][4], rr_[2][4];
#pragma unroll
            for (int tb = 0; tb < 2; ++tb)
#pragma unroll
                for (int ep = 0; ep < 2; ++ep) { const int so = 16 * tb + 2 * ep;
                    kq_[tb][ep] = (f32x2_t){KCb[so * 64], KCb[(so + 1) * 64]};
                    vr_[tb][2 * ep] = VCu[so * 64]; vr_[tb][2 * ep + 1] = VCu[(so + 1) * 64];
                    rr_[tb][2 * ep] = RCu[so * 64]; rr_[tb][2 * ep + 1] = RCu[(so + 1) * 64];
                    iq_[tb][ep] = *(const LAS f32x2_t*)(INb + so); }
            f32x4 accW[2], accA[2];
#pragma unroll
            for (int tb = 0; tb < 2; ++tb) {
                accW[tb] = (f32x4){0.f, 0.f, 0.f, 0.f}; accA[tb] = (f32x4){0.f, 0.f, 0.f, 0.f};
#pragma unroll
                for (int s = 0; s < 2; ++s) {
                    const bf16x8 atw = *(const LAS bf16x8*)(TW + (32 * q + 16 * tb + n) * TS + 32 * s + 8 * g), aad = *(const LAS bf16x8*)(AD + (32 * q + 16 * tb + n) * TS + 32 * s + 8 * g);
                    const bf16x8 bw = __builtin_bit_cast(bf16x8, lfrv[s]), ba = __builtin_bit_cast(bf16x8, lfrv[2 + s]);
                    accW[tb] = __builtin_amdgcn_mfma_f32_16x16x32_bf16(atw, bw, accW[tb], 0, 0, 0);
                    accA[tb] = __builtin_amdgcn_mfma_f32_16x16x32_bf16(aad, ba, accA[tb], 0, 0, 0);
                }
            }
            float w0_ = w0, a0v_ = a0v, kkc_ = kkc, kac_ = kac, rkc_ = rkc; asm volatile("" : "+v"(w0_), "+v"(a0v_), "+v"(kkc_), "+v"(kac_), "+v"(rkc_));
            float lw[2][4], cl[2][4];
            float sA = 0.f, sB = 0.f;
#pragma unroll
            for (int tb = 0; tb < 2; ++tb)
#pragma unroll
                for (int ep = 0; ep < 2; ++ep) {
                    const f32x2_t aw = {accW[tb][2 * ep], accW[tb][2 * ep + 1]};
                    const f32x2_t arg = aw * (-LOG2E) + (-LOG2E * w0_);
                    f32x2_t den; den.x = __builtin_amdgcn_exp2f(arg.x); den.y = __builtin_amdgcn_exp2f(arg.y); den = den + 1.f;
                    lw[tb][2 * ep] = (-0.6065306597126334f * LOG2E) * __builtin_amdgcn_rcpf(den.x); lw[tb][2 * ep + 1] = (-0.6065306597126334f * LOG2E) * __builtin_amdgcn_rcpf(den.y);
                }
#pragma unroll
            for (int e = 0; e < 4; ++e) { sA += lw[0][e]; cl[0][e] = sA; sB += lw[1][e]; cl[1][e] = sB; }
            float pairA, pairB, totA, totB;
            { auto s1 = __builtin_amdgcn_permlane16_swap(__float_as_uint(sA), __float_as_uint(sA), false, false); pairA = __uint_as_float(s1[0]) + __uint_as_float(s1[1]);
              auto s2 = __builtin_amdgcn_permlane32_swap(__float_as_uint(pairA), __float_as_uint(pairA), false, false); totA = __uint_as_float(s2[0]) + __uint_as_float(s2[1]);
              auto s3 = __builtin_amdgcn_permlane16_swap(__float_as_uint(sB), __float_as_uint(sB), false, false); pairB = __uint_as_float(s3[0]) + __uint_as_float(s3[1]);
              auto s4 = __builtin_amdgcn_permlane32_swap(__float_as_uint(pairB), __float_as_uint(pairB), false, false); totB = __uint_as_float(s4[0]) + __uint_as_float(s4[1]); }
            const float m1 = (float)(g & 1), m2 = (float)(g >> 1);
            const float offA = m1 * (pairA - sA) + m2 * (totA - pairA);
            const float offB = totA + m1 * (pairB - sB) + m2 * (totB - pairB);
            const float clC = totA + totB, gC = __builtin_amdgcn_exp2f(clC);
            if (g == 0) GC[q * 64 + j] = gC;
            LAS unsigned short* ABu = (LAS unsigned short*)AB + boTS; LAS unsigned short* BBu = (LAS unsigned short*)BB + boTS; LAS unsigned short* KBu = (LAS unsigned short*)KB + boTS; LAS unsigned short* RBu = (LAS unsigned short*)RB + boTS;
#pragma unroll
            for (int tb = 0; tb < 2; ++tb) {
                const float offT = tb ? offB : offA;
                u32x2 alp, bcp, kcp, vtp; float bon[4];
                float gprev = 0.f;
#pragma unroll
                for (int ep = 0; ep < 2; ++ep) {
                    const int e0 = 2 * ep, so = 16 * tb + e0;
                    const f32x2_t c = (f32x2_t){cl[tb][e0], cl[tb][e0 + 1]} + offT;
                    f32x2_t gt; gt.x = __builtin_amdgcn_exp2f(c.x); gt.y = __builtin_amdgcn_exp2f(c.y);
                    f32x2_t gm1; gm1.x = ep ? gprev : __builtin_amdgcn_exp2f(c.x - lw[tb][0]); gm1.y = gt.x; gprev = gt.y;
                    f32x2_t ig; ig.x = __builtin_amdgcn_rcpf(gt.x); ig.y = __builtin_amdgcn_rcpf(gt.y);
                    const f32x2_t gce = ig * gC;
                    const f32x2_t k = kq_[tb][ep];
                    const f32x2_t r = {__uint_as_float(rr_[tb][e0] << 16), __uint_as_float(rr_[tb][e0 + 1] << 16)};
                    const f32x2_t invn = iq_[tb][ep];
                    const f32x2_t aarg = (f32x2_t){accA[tb][e0], accA[tb][e0 + 1]} * (-LOG2E) + (-LOG2E * a0v_);
                    f32x2_t ad_; ad_.x = __builtin_amdgcn_exp2f(aarg.x); ad_.y = __builtin_amdgcn_exp2f(aarg.y); ad_ = ad_ + 1.f;
                    f32x2_t a; a.x = __builtin_amdgcn_rcpf(ad_.x); a.y = __builtin_amdgcn_rcpf(ad_.y);
                    const f32x2_t kkv = k * kkc_ * invn, kdv = k * ((a - 1.f) * kac_ + 1.f), bv = kkv * a;
                    const f32x2_t al = kkv * gm1, be = bv * ig, ka = kdv * ig, rh = r * gt, bc = bv * gce, kc = kdv * gce, bn = r * kdv * rkc_;
                    const unsigned alq = cvtpk(al.x, al.y), beq = cvtpk(be.x, be.y), kaq = cvtpk(ka.x, ka.y), rhq = cvtpk(rh.x, rh.y);
                    ABu[so * TS] = (unsigned short)alq; ABu[(so + 1) * TS] = (unsigned short)(alq >> 16);
                    BBu[so * TS] = (unsigned short)beq; BBu[(so + 1) * TS] = (unsigned short)(beq >> 16);
                    KBu[so * TS] = (unsigned short)kaq; KBu[(so + 1) * TS] = (unsigned short)(kaq >> 16);
                    RBu[so * TS] = (unsigned short)rhq; RBu[(so + 1) * TS] = (unsigned short)(rhq >> 16);
                    alp[ep] = alq; bcp[ep] = cvtpk(bc.x, bc.y); kcp[ep] = cvtpk(kc.x, kc.y); vtp[ep] = vr_[tb][e0] | (vr_[tb][e0 + 1] << 16);
                    bon[e0] = bn.x; bon[e0 + 1] = bn.y;
                }
                const int to = (q * 64 + j) * CS + 16 * tb + 4 * g;
                *(LAS u32x2*)(ABT + to) = alp; *(LAS u32x2*)(BCT + to) = bcp; *(LAS u32x2*)(KCT + to) = kcp; *(LAS u32x2*)(VT + to) = vtp;
                if (lat) {
                    float xs[4];
#pragma unroll
                    for (int e = 0; e < 4; ++e) xs[e] = red16(bon[e]);
                    if (n == 0) {
#pragma unroll
                        for (int e = 0; e < 4; ++e) __hip_atomic_fetch_add(BON + 32 * q + 16 * tb + 4 * g + e, xs[e], __ATOMIC_RELAXED, __HIP_MEMORY_SCOPE_WORKGROUP);
                    }
                }
            }
        }
        __syncthreads();
        {
            const int lane_ = lane_id_(); const int l31 = lane_ & 31, hh = lane_ >> 5;
            const int q = wave >> 2, pi = wave & 3;
            if (lat || pi < 2) {
            const LAS bf16* X = (pi == 0 ? AB : pi == 1 ? AB : pi == 2 ? BB : KB) + (32 * q + l31) * TS + 8 * hh;
            const LAS bf16* Y = (pi == 0 ? BB : pi == 1 ? KB : RB) + (32 * q + l31) * TS + 8 * hh;
            const f32x16 acc = tile_mm<4>(X, Y);
            const int c = l31;
            const bool low = pi < 2;
            f32x4 o[4];
#pragma unroll
            for (int gg = 0; gg < 4; ++gg)
#pragma unroll
                for (int e = 0; e < 4; ++e) { const int r = 8 * gg + 4 * hh + e; const bool keep = low ? (c < r) : (r <= c); o[gg][e] = keep ? acc[4 * gg + e] : 0.f; }
            if (pi == 0) {
                LAS float* op = NBAT + (q * 32 + c) * 32 + 2 * hh;
#pragma unroll
                for (int gg = 0; gg < 4; ++gg) { *(LAS f32x2_t*)(op + 4 * gg) = (f32x2_t){o[gg][0], o[gg][1]}; *(LAS f32x2_t*)(op + 16 + 4 * gg) = (f32x2_t){o[gg][2], o[gg][3]}; }
            } else {
                LAS bf16* op = (pi == 1 ? NKA : pi == 2 ? QBRT : QKRT) + (q * 32 + c) * CS + 4 * hh;
#pragma unroll
                for (int gg = 0; gg < 4; ++gg) *(LAS u32x2*)(op + 8 * gg) = pk4(o[gg][0], o[gg][1], o[gg][2], o[gg][3]);
            }
            }
        }
        __syncthreads();
        if (wave < 6) {
            const int lane_ = lane_id_(); const int p = lane_ & 1, cidx = lane_ >> 1;
            const int q = (wave < 4) ? (wave >> 1) : (wave - 4);
            const LAS bf16* src = (wave < 4) ? ABT + (q * 64 + 32 * (wave & 1) + cidx) * CS : NKA + (q * 32 + cidx) * CS;
            LAS bf16* dst = (wave < 4) ? GG + (q * 64 + 32 * (wave & 1) + cidx) * CS : MM + (q * 32 + cidx) * CS;
            float x[16];
#pragma unroll
            for (int c4 = 0; c4 < 4; ++c4) { const v4u rv = *(const LAS v4u*)(src + 8 * c4); const unsigned dA = p ? rv.y : rv.x, dB = p ? rv.w : rv.z;
                x[4 * c4] = __uint_as_float(dA << 16); x[4 * c4 + 1] = __uint_as_float(dA & 0xffff0000u); x[4 * c4 + 2] = __uint_as_float(dB << 16); x[4 * c4 + 3] = __uint_as_float(dB & 0xffff0000u); }
            const LAS float* nb_ = NBAT + q * 1024 + 16 * p;
            f32x4 rr[4][4];
            rr[0][0] = *(const LAS f32x4*)(nb_ + 0);
            rr[0][1] = *(const LAS f32x4*)(nb_ + 4);
            rr[0][2] = *(const LAS f32x4*)(nb_ + 8);
            rr[0][3] = *(const LAS f32x4*)(nb_ + 12);
            rr[1][0] = *(const LAS f32x4*)(nb_ + 32);
            rr[1][1] = *(const LAS f32x4*)(nb_ + 36);
            rr[1][2] = *(const LAS f32x4*)(nb_ + 40);
            rr[1][3] = *(const LAS f32x4*)(nb_ + 44);
            rr[2][0] = *(const LAS f32x4*)(nb_ + 64);
            rr[2][1] = *(const LAS f32x4*)(nb_ + 68);
            rr[2][2] = *(const LAS f32x4*)(nb_ + 72);
            rr[2][3] = *(const LAS f32x4*)(nb_ + 76);
            rr[3][0] = *(const LAS f32x4*)(nb_ + 96);
            rr[3][1] = *(const LAS f32x4*)(nb_ + 100);
            rr[3][2] = *(const LAS f32x4*)(nb_ + 104);
            rr[3][3] = *(const LAS f32x4*)(nb_ + 108);
            { const float xa = dpp_mov<0xA0>(x[0]);
              asm("v_fma_f32 %0, -%1, %2, %0" : "+v"(x[0]) : "v"(rr[0][0][0]), "v"(xa));
              asm("v_fma_f32 %0, -%1, %2, %0" : "+v"(x[1]) : "v"(rr[0][0][1]), "v"(xa));
              asm("v_fma_f32 %0, -%1, %2, %0" : "+v"(x[2]) : "v"(rr[0][0][2]), "v"(xa));
              asm("v_fma_f32 %0, -%1, %2, %0" : "+v"(x[3]) : "v"(rr[0][0][3]), "v"(xa));
              asm("v_fma_f32 %0, -%1, %2, %0" : "+v"(x[4]) : "v"(rr[0][1][0]), "v"(xa));
              asm("v_fma_f32 %0, -%1, %2, %0" : "+v"(x[5]) : "v"(rr[0][1][1]), "v"(xa));
              asm("v_fma_f32 %0, -%1, %2, %0" : "+v"(x[6]) : "v"(rr[0][1][2]), "v"(xa));
              asm("v_fma_f32 %0, -%1, %2, %0" : "+v"(x[7]) : "v"(rr[0][1][3]), "v"(xa));
              asm("v_fma_f32 %0, -%1, %2, %0" : "+v"(x[8]) : "v"(rr[0][2][0]), "v"(xa));
              asm("v_fma_f32 %0, -%1, %2, %0" : "+v"(x[9]) : "v"(rr[0][2][1]), "v"(xa));
              asm("v_fma_f32 %0, -%1, %2, %0" : "+v"(x[10]) : "v"(rr[0][2][2]), "v"(xa));
              asm("v_fma_f32 %0, -%1, %2, %0" : "+v"(x[11]) : "v"(rr[0][2][3]), "v"(xa));
              asm("v_fma_f32 %0, -%1, %2, %0" : "+v"(x[12]) : "v"(rr[0][3][0]), "v"(xa));
              asm("v_fma_f32 %0, -%1, %2, %0" : "+v"(x[13]) : "v"(rr[0][3][1]), "v"(xa));
              asm("v_fma_f32 %0, -%1, %2, %0" : "+v"(x[14]) : "v"(rr[0][3][2]), "v"(xa));
              asm("v_fma_f32 %0, -%1, %2, %0" : "+v"(x[15]) : "v"(rr[0][3][3]), "v"(xa));
            }
            __builtin_amdgcn_sched_barrier(0);
            rr[0][0] = *(const LAS f32x4*)(nb_ + 128);
            rr[0][1] = *(const LAS f32x4*)(nb_ + 132);
            rr[0][2] = *(const LAS f32x4*)(nb_ + 136);
            rr[0][3] = *(const LAS f32x4*)(nb_ + 140);
            { const float xa = dpp_mov<0xA0>(x[1]);
              asm("v_fma_f32 %0, -%1, %2, %0" : "+v"(x[0]) : "v"(rr[1][0][0]), "v"(xa));
              asm("v_fma_f32 %0, -%1, %2, %0" : "+v"(x[1]) : "v"(rr[1][0][1]), "v"(xa));
              asm("v_fma_f32 %0, -%1, %2, %0" : "+v"(x[2]) : "v"(rr[1][0][2]), "v"(xa));
              asm("v_fma_f32 %0, -%1, %2, %0" : "+v"(x[3]) : "v"(rr[1][0][3]), "v"(xa));
              asm("v_fma_f32 %0, -%1, %2, %0" : "+v"(x[4]) : "v"(rr[1][1][0]), "v"(xa));
              asm("v_fma_f32 %0, -%1, %2, %0" : "+v"(x[5]) : "v"(rr[1][1][1]), "v"(xa));
              asm("v_fma_f32 %0, -%1, %2, %0" : "+v"(x[6]) : "v"(rr[1][1][2]), "v"(xa));
              asm("v_fma_f32 %0, -%1, %2, %0" : "+v"(x[7]) : "v"(rr[1][1][3]), "v"(xa));
              asm("v_fma_f32 %0, -%1, %2, %0" : "+v"(x[8]) : "v"(rr[1][2][0]), "v"(xa));
              asm("v_fma_f32 %0, -%1, %2, %0" : "+v"(x[9]) : "v"(rr[1][2][1]), "v"(xa));
              asm("v_fma_f32 %0, -%1, %2, %0" : "+v"(x[10]) : "v"(rr[1][2][2]), "v"(xa));
              asm("v_fma_f32 %0, -%1, %2, %0" : "+v"(x[11]) : "v"(rr[1][2][3]), "v"(xa));
              asm("v_fma_f32 %0, -%1, %2, %0" : "+v"(x[12]) : "v"(rr[1][3][0]), "v"(xa));
              asm("v_fma_f32 %0, -%1, %2, %0" : "+v"(x[13]) : "v"(rr[1][3][1]), "v"(xa));
              asm("v_fma_f32 %0, -%1, %2, %0" : "+v"(x[14]) : "v"(rr[1][3][2]), "v"(xa));
              asm("v_fma_f32 %0, -%1, %2, %0" : "+v"(x[15]) : "v"(rr[1][3][3]), "v"(xa));
            }
            __builtin_amdgcn_sched_barrier(0);
            rr[1][0] = *(const LAS f32x4*)(nb_ + 160);
            rr[1][1] = *(const LAS f32x4*)(nb_ + 164);
            rr[1][2] = *(const LAS f32x4*)(nb_ + 168);
            rr[1][3] = *(const LAS f32x4*)(nb_ + 172);
            { const float xa = dpp_mov<0xF5>(x[0]);
              asm("v_fma_f32 %0, -%1, %2, %0" : "+v"(x[1]) : "v"(rr[2][0][1]), "v"(xa));
              asm("v_fma_f32 %0, -%1, %2, %0" : "+v"(x[2]) : "v"(rr[2][0][2]), "v"(xa));
              asm("v_fma_f32 %0, -%1, %2, %0" : "+v"(x[3]) : "v"(rr[2][0][3]), "v"(xa));
              asm("v_fma_f32 %0, -%1, %2, %0" : "+v"(x[4]) : "v"(rr[2][1][0]), "v"(xa));
              asm("v_fma_f32 %0, -%1, %2, %0" : "+v"(x[5]) : "v"(rr[2][1][1]), "v"(xa));
              asm("v_fma_f32 %0, -%1, %2, %0" : "+v"(x[6]) : "v"(rr[2][1][2]), "v"(xa));
              asm("v_fma_f32 %0, -%1, %2, %0" : "+v"(x[7]) : "v"(rr[2][1][3]), "v"(xa));
              asm("v_fma_f32 %0, -%1, %2, %0" : "+v"(x[8]) : "v"(rr[2][2][0]), "v"(xa));
              asm("v_fma_f32 %0, -%1, %2, %0" : "+v"(x[9]) : "v"(rr[2][2][1]), "v"(xa));
              asm("v_fma_f32 %0, -%1, %2, %0" : "+v"(x[10]) : "v"(rr[2][2][2]), "v"(xa));
              asm("v_fma_f32 %0, -%1, %2, %0" : "+v"(x[11]) : "v"(rr[2][2][3]), "v"(xa));
              asm("v_fma_f32 %0, -%1, %2, %0" : "+v"(x[12]) : "v"(rr[2][3][0]), "v"(xa));
              asm("v_fma_f32 %0, -%1, %2, %0" : "+v"(x[13]) : "v"(rr[2][3][1]), "v"(xa));
              asm("v_fma_f32 %0, -%1, %2, %0" : "+v"(x[14]) : "v"(rr[2][3][2]), "v"(xa));
              asm("v_fma_f32 %0, -%1, %2, %0" : "+v"(x[15]) : "v"(rr[2][3][3]), "v"(xa));
            }
            __builtin_amdgcn_sched_barrier(0);
            rr[2][0] = *(const LAS f32x4*)(nb_ + 192);
            rr[2][1] = *(const LAS f32x4*)(nb_ + 196);
            rr[2][2] = *(const LAS f32x4*)(nb_ + 200);
            rr[2][3] = *(const LAS f32x4*)(nb_ + 204);
            { const float xa = dpp_mov<0xF5>(x[1]);
              asm("v_fma_f32 %0, -%1, %2, %0" : "+v"(x[2]) : "v"(rr[3][0][2]), "v"(xa));
              asm("v_fma_f32 %0, -%1, %2, %0" : "+v"(x[3]) : "v"(rr[3][0][3]), "v"(xa));
              asm("v_fma_f32 %0, -%1, %2, %0" : "+v"(x[4]) : "v"(rr[3][1][0]), "v"(xa));
              asm("v_fma_f32 %0, -%1, %2, %0" : "+v"(x[5]) : "v"(rr[3][1][1]), "v"(xa));
              asm("v_fma_f32 %0, -%1, %2, %0" : "+v"(x[6]) : "v"(rr[3][1][2]), "v"(xa));
              asm("v_fma_f32 %0, -%1, %2, %0" : "+v"(x[7]) : "v"(rr[3][1][3]), "v"(xa));
              asm("v_fma_f32 %0, -%1, %2, %0" : "+v"(x[8]) : "v"(rr[3][2][0]), "v"(xa));
              asm("v_fma_f32 %0, -%1, %2, %0" : "+v"(x[9]) : "v"(rr[3][2][1]), "v"(xa));
              asm("v_fma_f32 %0, -%1, %2, %0" : "+v"(x[10]) : "v"(rr[3][2][2]), "v"(xa));
              asm("v_fma_f32 %0, -%1, %2, %0" : "+v"(x[11]) : "v"(rr[3][2][3]), "v"(xa));
              asm("v_fma_f32 %0, -%1, %2, %0" : "+v"(x[12]) : "v"(rr[3][3][0]), "v"(xa));
              asm("v_fma_f32 %0, -%1, %2, %0" : "+v"(x[13]) : "v"(rr[3][3][1]), "v"(xa));
              asm("v_fma_f32 %0, -%1, %2, %0" : "+v"(x[14]) : "v"(rr[3][3][2]), "v"(xa));
              asm("v_fma_f32 %0, -%1, %2, %0" : "+v"(x[15]) : "v"(rr[3][3][3]), "v"(xa));
            }
            __builtin_amdgcn_sched_barrier(0);
            rr[3][1] = *(const LAS f32x4*)(nb_ + 228);
            rr[3][2] = *(const LAS f32x4*)(nb_ + 232);
            rr[3][3] = *(const LAS f32x4*)(nb_ + 236);
            { const float xa = dpp_mov<0xA0>(x[2]);
              asm("v_fma_f32 %0, -%1, %2, %0" : "+v"(x[2]) : "v"(rr[0][0][2]), "v"(xa));
              asm("v_fma_f32 %0, -%1, %2, %0" : "+v"(x[3]) : "v"(rr[0][0][3]), "v"(xa));
              asm("v_fma_f32 %0, -%1, %2, %0" : "+v"(x[4]) : "v"(rr[0][1][0]), "v"(xa));
              asm("v_fma_f32 %0, -%1, %2, %0" : "+v"(x[5]) : "v"(rr[0][1][1]), "v"(xa));
              asm("v_fma_f32 %0, -%1, %2, %0" : "+v"(x[6]) : "v"(rr[0][1][2]), "v"(xa));
              asm("v_fma_f32 %0, -%1, %2, %0" : "+v"(x[7]) : "v"(rr[0][1][3]), "v"(xa));
              asm("v_fma_f32 %0, -%1, %2, %0" : "+v"(x[8]) : "v"(rr[0][2][0]), "v"(xa));
              asm("v_fma_f32 %0, -%1, %2, %0" : "+v"(x[9]) : "v"(rr[0][2][1]), "v"(xa));
              asm("v_fma_f32 %0, -%1, %2, %0" : "+v"(x[10]) : "v"(rr[0][2][2]), "v"(xa));
              asm("v_fma_f32 %0, -%1, %2, %0" : "+v"(x[11]) : "v"(rr[0][2][3]), "v"(xa));
              asm("v_fma_f32 %0, -%1, %2, %0" : "+v"(x[12]) : "v"(rr[0][3][0]), "v"(xa));
              asm("v_fma_f32 %0, -%1, %2, %0" : "+v"(x[13]) : "v"(rr[0][3][1]), "v"(xa));
              asm("v_fma_f32 %0, -%1, %2, %0" : "+v"(x[14]) : "v"(rr[0][3][2]), "v"(xa));
              asm("v_fma_f32 %0, -%1, %2, %0" : "+v"(x[15]) : "v"(rr[0][3][3]), "v"(xa));
            }
            __builtin_amdgcn_sched_barrier(0);
            rr[0][1] = *(const LAS f32x4*)(nb_ + 260);
            rr[0][2] = *(const LAS f32x4*)(nb_ + 264);
            rr[0][3] = *(const LAS f32x4*)(nb_ + 268);
            { const float xa = dpp_mov<0xA0>(x[3]);
              asm("v_fma_f32 %0, -%1, %2, %0" : "+v"(x[2]) : "v"(rr[1][0][2]), "v"(xa));
              asm("v_fma_f32 %0, -%1, %2, %0" : "+v"(x[3]) : "v"(rr[1][0][3]), "v"(xa));
              asm("v_fma_f32 %0, -%1, %2, %0" : "+v"(x[4]) : "v"(rr[1][1][0]), "v"(xa));
              asm("v_fma_f32 %0, -%1, %2, %0" : "+v"(x[5]) : "v"(rr[1][1][1]), "v"(xa));
              asm("v_fma_f32 %0, -%1, %2, %0" : "+v"(x[6]) : "v"(rr[1][1][2]), "v"(xa));
              asm("v_fma_f32 %0, -%1, %2, %0" : "+v"(x[7]) : "v"(rr[1][1][3]), "v"(xa));
              asm("v_fma_f32 %0, -%1, %2, %0" : "+v"(x[8]) : "v"(rr[1][2][0]), "v"(xa));
              asm("v_fma_f32 %0, -%1, %2, %0" : "+v"(x[9]) : "v"(rr[1][2][1]), "v"(xa));
              asm("v_fma_f32 %0, -%1, %2, %0" : "+v"(x[10]) : "v"(rr[1][2][2]), "v"(xa));
              asm("v_fma_f32 %0, -%1, %2, %0" : "+v"(x[11]) : "v"(rr[1][2][3]), "v"(xa));
              asm("v_fma_f32 %0, -%1, %2, %0" : "+v"(x[12]) : "v"(rr[1][3][0]), "v"(xa));
              asm("v_fma_f32 %0, -%1, %2, %0" : "+v"(x[13]) : "v"(rr[1][3][1]), "v"(xa));
              asm("v_fma_f32 %0, -%1, %2, %0" : "+v"(x[14]) : "v"(rr[1][3][2]), "v"(xa));
              asm("v_fma_f32 %0, -%1, %2, %0" : "+v"(x[15]) : "v"(rr[1][3][3]), "v"(xa));
            }
            __builtin_amdgcn_sched_barrier(0);
            rr[1][1] = *(const LAS f32x4*)(nb_ + 292);
            rr[1][2] = *(const LAS f32x4*)(nb_ + 296);
            rr[1][3] = *(const LAS f32x4*)(nb_ + 300);
            { const float xa = dpp_mov<0xF5>(x[2]);
              asm("v_fma_f32 %0, -%1, %2, %0" : "+v"(x[3]) : "v"(rr[2][0][3]), "v"(xa));
              asm("v_fma_f32 %0, -%1, %2, %0" : "+v"(x[4]) : "v"(rr[2][1][0]), "v"(xa));
              asm("v_fma_f32 %0, -%1, %2, %0" : "+v"(x[5]) : "v"(rr[2][1][1]), "v"(xa));
              asm("v_fma_f32 %0, -%1, %2, %0" : "+v"(x[6]) : "v"(rr[2][1][2]), "v"(xa));
              asm("v_fma_f32 %0, -%1, %2, %0" : "+v"(x[7]) : "v"(rr[2][1][3]), "v"(xa));
              asm("v_fma_f32 %0, -%1, %2, %0" : "+v"(x[8]) : "v"(rr[2][2][0]), "v"(xa));
              asm("v_fma_f32 %0, -%1, %2, %0" : "+v"(x[9]) : "v"(rr[2][2][1]), "v"(xa));
              asm("v_fma_f32 %0, -%1, %2, %0" : "+v"(x[10]) : "v"(rr[2][2][2]), "v"(xa));
              asm("v_fma_f32 %0, -%1, %2, %0" : "+v"(x[11]) : "v"(rr[2][2][3]), "v"(xa));
              asm("v_fma_f32 %0, -%1, %2, %0" : "+v"(x[12]) : "v"(rr[2][3][0]), "v"(xa));
              asm("v_fma_f32 %0, -%1, %2, %0" : "+v"(x[13]) : "v"(rr[2][3][1]), "v"(xa));
              asm("v_fma_f32 %0, -%1, %2, %0" : "+v"(x[14]) : "v"(rr[2][3][2]), "v"(xa));
              asm("v_fma_f32 %0, -%1, %2, %0" : "+v"(x[15]) : "v"(rr[2][3][3]), "v"(xa));
            }
            __builtin_amdgcn_sched_barrier(0);
            rr[2][1] = *(const LAS f32x4*)(nb_ + 324);
            rr[2][2] = *(const LAS f32x4*)(nb_ + 328);
            rr[2][3] = *(const LAS f32x4*)(nb_ + 332);
            { const float xa = dpp_mov<0xF5>(x[3]);
              asm("v_fma_f32 %0, -%1, %2, %0" : "+v"(x[4]) : "v"(rr[3][1][0]), "v"(xa));
              asm("v_fma_f32 %0, -%1, %2, %0" : "+v"(x[5]) : "v"(rr[3][1][1]), "v"(xa));
              asm("v_fma_f32 %0, -%1, %2, %0" : "+v"(x[6]) : "v"(rr[3][1][2]), "v"(xa));
              asm("v_fma_f32 %0, -%1, %2, %0" : "+v"(x[7]) : "v"(rr[3][1][3]), "v"(xa));
              asm("v_fma_f32 %0, -%1, %2, %0" : "+v"(x[8]) : "v"(rr[3][2][0]), "v"(xa));
              asm("v_fma_f32 %0, -%1, %2, %0" : "+v"(x[9]) : "v"(rr[3][2][1]), "v"(xa));
              asm("v_fma_f32 %0, -%1, %2, %0" : "+v"(x[10]) : "v"(rr[3][2][2]), "v"(xa));
              asm("v_fma_f32 %0, -%1, %2, %0" : "+v"(x[11]) : "v"(rr[3][2][3]), "v"(xa));
              asm("v_fma_f32 %0, -%1, %2, %0" : "+v"(x[12]) : "v"(rr[3][3][0]), "v"(xa));
              asm("v_fma_f32 %0, -%1, %2, %0" : "+v"(x[13]) : "v"(rr[3][3][1]), "v"(xa));
              asm("v_fma_f32 %0, -%1, %2, %0" : "+v"(x[14]) : "v"(rr[3][3][2]), "v"(xa));
              asm("v_fma_f32 %0, -%1, %2, %0" : "+v"(x[15]) : "v"(rr[3][3][3]), "v"(xa));
            }
            __builtin_amdgcn_sched_barrier(0);
            rr[3][1] = *(const LAS f32x4*)(nb_ + 356);
            rr[3][2] = *(const LAS f32x4*)(nb_ + 360);
            rr[3][3] = *(const LAS f32x4*)(nb_ + 364);
            { const float xa = dpp_mov<0xA0>(x[4]);
              asm("v_fma_f32 %0, -%1, %2, %0" : "+v"(x[4]) : "v"(rr[0][1][0]), "v"(xa));
              asm("v_fma_f32 %0, -%1, %2, %0" : "+v"(x[5]) : "v"(rr[0][1][1]), "v"(xa));
              asm("v_fma_f32 %0, -%1, %2, %0" : "+v"(x[6]) : "v"(rr[0][1][2]), "v"(xa));
              asm("v_fma_f32 %0, -%1, %2, %0" : "+v"(x[7]) : "v"(rr[0][1][3]), "v"(xa));
              asm("v_fma_f32 %0, -%1, %2, %0" : "+v"(x[8]) : "v"(rr[0][2][0]), "v"(xa));
              asm("v_fma_f32 %0, -%1, %2, %0" : "+v"(x[9]) : "v"(rr[0][2][1]), "v"(xa));
              asm("v_fma_f32 %0, -%1, %2, %0" : "+v"(x[10]) : "v"(rr[0][2][2]), "v"(xa));
              asm("v_fma_f32 %0, -%1, %2, %0" : "+v"(x[11]) : "v"(rr[0][2][3]), "v"(xa));
              asm("v_fma_f32 %0, -%1, %2, %0" : "+v"(x[12]) : "v"(rr[0][3][0]), "v"(xa));
              asm("v_fma_f32 %0, -%1, %2, %0" : "+v"(x[13]) : "v"(rr[0][3][1]), "v"(xa));
              asm("v_fma_f32 %0, -%1, %2, %0" : "+v"(x[14]) : "v"(rr[0][3][2]), "v"(xa));
              asm("v_fma_f32 %0, -%1, %2, %0" : "+v"(x[15]) : "v"(rr[0][3][3]), "v"(xa));
            }
            __builtin_amdgcn_sched_barrier(0);
            rr[0][1] = *(const LAS f32x4*)(nb_ + 388);
            rr[0][2] = *(const LAS f32x4*)(nb_ + 392);
            rr[0][3] = *(const LAS f32x4*)(nb_ + 396);
            { const float xa = dpp_mov<0xA0>(x[5]);
              asm("v_fma_f32 %0, -%1, %2, %0" : "+v"(x[4]) : "v"(rr[1][1][0]), "v"(xa));
              asm("v_fma_f32 %0, -%1, %2, %0" : "+v"(x[5]) : "v"(rr[1][1][1]), "v"(xa));
              asm("v_fma_f32 %0, -%1, %2, %0" : "+v"(x[6]) : "v"(rr[1][1][2]), "v"(xa));
              asm("v_fma_f32 %0, -%1, %2, %0" : "+v"(x[7]) : "v"(rr[1][1][3]), "v"(xa));
              asm("v_fma_f32 %0, -%1, %2, %0" : "+v"(x[8]) : "v"(rr[1][2][0]), "v"(xa));
              asm("v_fma_f32 %0, -%1, %2, %0" : "+v"(x[9]) : "v"(rr[1][2][1]), "v"(xa));
              asm("v_fma_f32 %0, -%1, %2, %0" : "+v"(x[10]) : "v"(rr[1][2][2]), "v"(xa));
              asm("v_fma_f32 %0, -%1, %2, %0" : "+v"(x[11]) : "v"(rr[1][2][3]), "v"(xa));
              asm("v_fma_f32 %0, -%1, %2, %0" : "+v"(x[12]) : "v"(rr[1][3][0]), "v"(xa));
              asm("v_fma_f32 %0, -%1, %2, %0" : "+v"(x[13]) : "v"(rr[1][3][1]), "v"(xa));
              asm("v_fma_f32 %0, -%1, %2, %0" : "+v"(x[14]) : "v"(rr[1][3][2]), "v"(xa));
              asm("v_fma_f32 %0, -%1, %2, %0" : "+v"(x[15]) : "v"(rr[1][3][3]), "v"(xa));
            }
            __builtin_amdgcn_sched_barrier(0);
            rr[1][1] = *(const LAS f32x4*)(nb_ + 420);
            rr[1][2] = *(const LAS f32x4*)(nb_ + 424);
            rr[1][3] = *(const LAS f32x4*)(nb_ + 428);
            { const float xa = dpp_mov<0xF5>(x[4]);
              asm("v_fma_f32 %0, -%1, %2, %0" : "+v"(x[5]) : "v"(rr[2][1][1]), "v"(xa));
              asm("v_fma_f32 %0, -%1, %2, %0" : "+v"(x[6]) : "v"(rr[2][1][2]), "v"(xa));
              asm("v_fma_f32 %0, -%1, %2, %0" : "+v"(x[7]) : "v"(rr[2][1][3]), "v"(xa));
              asm("v_fma_f32 %0, -%1, %2, %0" : "+v"(x[8]) : "v"(rr[2][2][0]), "v"(xa));
              asm("v_fma_f32 %0, -%1, %2, %0" : "+v"(x[9]) : "v"(rr[2][2][1]), "v"(xa));
              asm("v_fma_f32 %0, -%1, %2, %0" : "+v"(x[10]) : "v"(rr[2][2][2]), "v"(xa));
              asm("v_fma_f32 %0, -%1, %2, %0" : "+v"(x[11]) : "v"(rr[2][2][3]), "v"(xa));
              asm("v_fma_f32 %0, -%1, %2, %0" : "+v"(x[12]) : "v"(rr[2][3][0]), "v"(xa));
              asm("v_fma_f32 %0, -%1, %2, %0" : "+v"(x[13]) : "v"(rr[2][3][1]), "v"(xa));
              asm("v_fma_f32 %0, -%1, %2, %0" : "+v"(x[14]) : "v"(rr[2][3][2]), "v"(xa));
              asm("v_fma_f32 %0, -%1, %2, %0" : "+v"(x[15]) : "v"(rr[2][3][3]), "v"(xa));
            }
            __builtin_amdgcn_sched_barrier(0);
            rr[2][1] = *(const LAS f32x4*)(nb_ + 452);
            rr[2][2] = *(const LAS f32x4*)(nb_ + 456);
            rr[2][3] = *(const LAS f32x4*)(nb_ + 460);
            { const float xa = dpp_mov<0xF5>(x[5]);
              asm("v_fma_f32 %0, -%1, %2, %0" : "+v"(x[6]) : "v"(rr[3][1][2]), "v"(xa));
              asm("v_fma_f32 %0, -%1, %2, %0" : "+v"(x[7]) : "v"(rr[3][1][3]), "v"(xa));
              asm("v_fma_f32 %0, -%1, %2, %0" : "+v"(x[8]) : "v"(rr[3][2][0]), "v"(xa));
              asm("v_fma_f32 %0, -%1, %2, %0" : "+v"(x[9]) : "v"(rr[3][2][1]), "v"(xa));
              asm("v_fma_f32 %0, -%1, %2, %0" : "+v"(x[10]) : "v"(rr[3][2][2]), "v"(xa));
              asm("v_fma_f32 %0, -%1, %2, %0" : "+v"(x[11]) : "v"(rr[3][2][3]), "v"(xa));
              asm("v_fma_f32 %0, -%1, %2, %0" : "+v"(x[12]) : "v"(rr[3][3][0]), "v"(xa));
              asm("v_fma_f32 %0, -%1, %2, %0" : "+v"(x[13]) : "v"(rr[3][3][1]), "v"(xa));
              asm("v_fma_f32 %0, -%1, %2, %0" : "+v"(x[14]) : "v"(rr[3][3][2]), "v"(xa));
              asm("v_fma_f32 %0, -%1, %2, %0" : "+v"(x[15]) : "v"(rr[3][3][3]), "v"(xa));
            }
            __builtin_amdgcn_sched_barrier(0);
            rr[3][2] = *(const LAS f32x4*)(nb_ + 488);
            rr[3][3] = *(const LAS f32x4*)(nb_ + 492);
            { const float xa = dpp_mov<0xA0>(x[6]);
              asm("v_fma_f32 %0, -%1, %2, %0" : "+v"(x[6]) : "v"(rr[0][1][2]), "v"(xa));
              asm("v_fma_f32 %0, -%1, %2, %0" : "+v"(x[7]) : "v"(rr[0][1][3]), "v"(xa));
              asm("v_fma_f32 %0, -%1, %2, %0" : "+v"(x[8]) : "v"(rr[0][2][0]), "v"(xa));
              asm("v_fma_f32 %0, -%1, %2, %0" : "+v"(x[9]) : "v"(rr[0][2][1]), "v"(xa));
              asm("v_fma_f32 %0, -%1, %2, %0" : "+v"(x[10]) : "v"(rr[0][2][2]), "v"(xa));
              asm("v_fma_f32 %0, -%1, %2, %0" : "+v"(x[11]) : "v"(rr[0][2][3]), "v"(xa));
              asm("v_fma_f32 %0, -%1, %2, %0" : "+v"(x[12]) : "v"(rr[0][3][0]), "v"(xa));
              asm("v_fma_f32 %0, -%1, %2, %0" : "+v"(x[13]) : "v"(rr[0][3][1]), "v"(xa));
              asm("v_fma_f32 %0, -%1, %2, %0" : "+v"(x[14]) : "v"(rr[0][3][2]), "v"(xa));
              asm("v_fma_f32 %0, -%1, %2, %0" : "+v"(x[15]) : "v"(rr[0][3][3]), "v"(xa));
            }
            __builtin_amdgcn_sched_barrier(0);
            rr[0][2] = *(const LAS f32x4*)(nb_ + 520);
            rr[0][3] = *(const LAS f32x4*)(nb_ + 524);
            { const float xa = dpp_mov<0xA0>(x[7]);
              asm("v_fma_f32 %0, -%1, %2, %0" : "+v"(x[6]) : "v"(rr[1][1][2]), "v"(xa));
              asm("v_fma_f32 %0, -%1, %2, %0" : "+v"(x[7]) : "v"(rr[1][1][3]), "v"(xa));
              asm("v_fma_f32 %0, -%1, %2, %0" : "+v"(x[8]) : "v"(rr[1][2][0]), "v"(xa));
              asm("v_fma_f32 %0, -%1, %2, %0" : "+v"(x[9]) : "v"(rr[1][2][1]), "v"(xa));
              asm("v_fma_f32 %0, -%1, %2, %0" : "+v"(x[10]) : "v"(rr[1][2][2]), "v"(xa));
              asm("v_fma_f32 %0, -%1, %2, %0" : "+v"(x[11]) : "v"(rr[1][2][3]), "v"(xa));
              asm("v_fma_f32 %0, -%1, %2, %0" : "+v"(x[12]) : "v"(rr[1][3][0]), "v"(xa));
              asm("v_fma_f32 %0, -%1, %2, %0" : "+v"(x[13]) : "v"(rr[1][3][1]), "v"(xa));
              asm("v_fma_f32 %0, -%1, %2, %0" : "+v"(x[14]) : "v"(rr[1][3][2]), "v"(xa));
              asm("v_fma_f32 %0, -%1, %2, %0" : "+v"(x[15]) : "v"(rr[1][3][3]), "v"(xa));
            }
            __builtin_amdgcn_sched_barrier(0);
            rr[1][2] = *(const LAS f32x4*)(nb_ + 552);
            rr[1][3] = *(const LAS f32x4*)(nb_ + 556);
            { const float xa = dpp_mov<0xF5>(x[6]);
              asm("v_fma_f32 %0, -%1, %2, %0" : "+v"(x[7]) : "v"(rr[2][1][3]), "v"(xa));
              asm("v_fma_f32 %0, -%1, %2, %0" : "+v"(x[8]) : "v"(rr[2][2][0]), "v"(xa));
              asm("v_fma_f32 %0, -%1, %2, %0" : "+v"(x[9]) : "v"(rr[2][2][1]), "v"(xa));
              asm("v_fma_f32 %0, -%1, %2, %0" : "+v"(x[10]) : "v"(rr[2][2][2]), "v"(xa));
              asm("v_fma_f32 %0, -%1, %2, %0" : "+v"(x[11]) : "v"(rr[2][2][3]), "v"(xa));
              asm("v_fma_f32 %0, -%1, %2, %0" : "+v"(x[12]) : "v"(rr[2][3][0]), "v"(xa));
              asm("v_fma_f32 %0, -%1, %2, %0" : "+v"(x[13]) : "v"(rr[2][3][1]), "v"(xa));
              asm("v_fma_f32 %0, -%1, %2, %0" : "+v"(x[14]) : "v"(rr[2][3][2]), "v"(xa));
              asm("v_fma_f32 %0, -%1, %2, %0" : "+v"(x[15]) : "v"(rr[2][3][3]), "v"(xa));
            }
            __builtin_amdgcn_sched_barrier(0);
            rr[2][2] = *(const LAS f32x4*)(nb_ + 584);
            rr[2][3] = *(const LAS f32x4*)(nb_ + 588);
            { const float xa = dpp_mov<0xF5>(x[7]);
              asm("v_fma_f32 %0, -%1, %2, %0" : "+v"(x[8]) : "v"(rr[3][2][0]), "v"(xa));
              asm("v_fma_f32 %0, -%1, %2, %0" : "+v"(x[9]) : "v"(rr[3][2][1]), "v"(xa));
              asm("v_fma_f32 %0, -%1, %2, %0" : "+v"(x[10]) : "v"(rr[3][2][2]), "v"(xa));
              asm("v_fma_f32 %0, -%1, %2, %0" : "+v"(x[11]) : "v"(rr[3][2][3]), "v"(xa));
              asm("v_fma_f32 %0, -%1, %2, %0" : "+v"(x[12]) : "v"(rr[3][3][0]), "v"(xa));
              asm("v_fma_f32 %0, -%1, %2, %0" : "+v"(x[13]) : "v"(rr[3][3][1]), "v"(xa));
              asm("v_fma_f32 %0, -%1, %2, %0" : "+v"(x[14]) : "v"(rr[3][3][2]), "v"(xa));
              asm("v_fma_f32 %0, -%1, %2, %0" : "+v"(x[15]) : "v"(rr[3][3][3]), "v"(xa));
            }
            __builtin_amdgcn_sched_barrier(0);
            rr[3][2] = *(const LAS f32x4*)(nb_ + 616);
            rr[3][3] = *(const LAS f32x4*)(nb_ + 620);
            { const float xa = dpp_mov<0xA0>(x[8]);
              asm("v_fma_f32 %0, -%1, %2, %0" : "+v"(x[8]) : "v"(rr[0][2][0]), "v"(xa));
              asm("v_fma_f32 %0, -%1, %2, %0" : "+v"(x[9]) : "v"(rr[0][2][1]), "v"(xa));
              asm("v_fma_f32 %0, -%1, %2, %0" : "+v"(x[10]) : "v"(rr[0][2][2]), "v"(xa));
              asm("v_fma_f32 %0, -%1, %2, %0" : "+v"(x[11]) : "v"(rr[0][2][3]), "v"(xa));
              asm("v_fma_f32 %0, -%1, %2, %0" : "+v"(x[12]) : "v"(rr[0][3][0]), "v"(xa));
              asm("v_fma_f32 %0, -%1, %2, %0" : "+v"(x[13]) : "v"(rr[0][3][1]), "v"(xa));
              asm("v_fma_f32 %0, -%1, %2, %0" : "+v"(x[14]) : "v"(rr[0][3][2]), "v"(xa));
              asm("v_fma_f32 %0, -%1, %2, %0" : "+v"(x[15]) : "v"(rr[0][3][3]), "v"(xa));
            }
            __builtin_amdgcn_sched_barrier(0);
            rr[0][2] = *(const LAS f32x4*)(nb_ + 648);
            rr[0][3] = *(const LAS f32x4*)(nb_ + 652);
            { const float xa = dpp_mov<0xA0>(x[9]);
              asm("v_fma_f32 %0, -%1, %2, %0" : "+v"(x[8]) : "v"(rr[1][2][0]), "v"(xa));
              asm("v_fma_f32 %0, -%1, %2, %0" : "+v"(x[9]) : "v"(rr[1][2][1]), "v"(xa));
              asm("v_fma_f32 %0, -%1, %2, %0" : "+v"(x[10]) : "v"(rr[1][2][2]), "v"(xa));
              asm("v_fma_f32 %0, -%1, %2, %0" : "+v"(x[11]) : "v"(rr[1][2][3]), "v"(xa));
              asm("v_fma_f32 %0, -%1, %2, %0" : "+v"(x[12]) : "v"(rr[1][3][0]), "v"(xa));
              asm("v_fma_f32 %0, -%1, %2, %0" : "+v"(x[13]) : "v"(rr[1][3][1]), "v"(xa));
              asm("v_fma_f32 %0, -%1, %2, %0" : "+v"(x[14]) : "v"(rr[1][3][2]), "v"(xa));
              asm("v_fma_f32 %0, -%1, %2, %0" : "+v"(x[15]) : "v"(rr[1][3][3]), "v"(xa));
            }
            __builtin_amdgcn_sched_barrier(0);
            rr[1][2] = *(const LAS f32x4*)(nb_ + 680);
            rr[1][3] = *(const LAS f32x4*)(nb_ + 684);
            { const float xa = dpp_mov<0xF5>(x[8]);
              asm("v_fma_f32 %0, -%1, %2, %0" : "+v"(x[9]) : "v"(rr[2][2][1]), "v"(xa));
              asm("v_fma_f32 %0, -%1, %2, %0" : "+v"(x[10]) : "v"(rr[2][2][2]), "v"(xa));
              asm("v_fma_f32 %0, -%1, %2, %0" : "+v"(x[11]) : "v"(rr[2][2][3]), "v"(xa));
              asm("v_fma_f32 %0, -%1, %2, %0" : "+v"(x[12]) : "v"(rr[2][3][0]), "v"(xa));
              asm("v_fma_f32 %0, -%1, %2, %0" : "+v"(x[13]) : "v"(rr[2][3][1]), "v"(xa));
              asm("v_fma_f32 %0, -%1, %2, %0" : "+v"(x[14]) : "v"(rr[2][3][2]), "v"(xa));
              asm("v_fma_f32 %0, -%1, %2, %0" : "+v"(x[15]) : "v"(rr[2][3][3]), "v"(xa));
            }
            __builtin_amdgcn_sched_barrier(0);
            rr[2][2] = *(const LAS f32x4*)(nb_ + 712);
            rr[2][3] = *(const LAS f32x4*)(nb_ + 716);
            { const float xa = dpp_mov<0xF5>(x[9]);
              asm("v_fma_f32 %0, -%1, %2, %0" : "+v"(x[10]) : "v"(rr[3][2][2]), "v"(xa));
              asm("v_fma_f32 %0, -%1, %2, %0" : "+v"(x[11]) : "v"(rr[3][2][3]), "v"(xa));
              asm("v_fma_f32 %0, -%1, %2, %0" : "+v"(x[12]) : "v"(rr[3][3][0]), "v"(xa));
              asm("v_fma_f32 %0, -%1, %2, %0" : "+v"(x[13]) : "v"(rr[3][3][1]), "v"(xa));
              asm("v_fma_f32 %0, -%1, %2, %0" : "+v"(x[14]) : "v"(rr[3][3][2]), "v"(xa));
              asm("v_fma_f32 %0, -%1, %2, %0" : "+v"(x[15]) : "v"(rr[3][3][3]), "v"(xa));
            }
            __builtin_amdgcn_sched_barrier(0);
            rr[3][3] = *(const LAS f32x4*)(nb_ + 748);
            { const float xa = dpp_mov<0xA0>(x[10]);
              asm("v_fma_f32 %0, -%1, %2, %0" : "+v"(x[10]) : "v"(rr[0][2][2]), "v"(xa));
              asm("v_fma_f32 %0, -%1, %2, %0" : "+v"(x[11]) : "v"(rr[0][2][3]), "v"(xa));
              asm("v_fma_f32 %0, -%1, %2, %0" : "+v"(x[12]) : "v"(rr[0][3][0]), "v"(xa));
              asm("v_fma_f32 %0, -%1, %2, %0" : "+v"(x[13]) : "v"(rr[0][3][1]), "v"(xa));
              asm("v_fma_f32 %0, -%1, %2, %0" : "+v"(x[14]) : "v"(rr[0][3][2]), "v"(xa));
              asm("v_fma_f32 %0, -%1, %2, %0" : "+v"(x[15]) : "v"(rr[0][3][3]), "v"(xa));
            }
            __builtin_amdgcn_sched_barrier(0);
            rr[0][3] = *(const LAS f32x4*)(nb_ + 780);
            { const float xa = dpp_mov<0xA0>(x[11]);
              asm("v_fma_f32 %0, -%1, %2, %0" : "+v"(x[10]) : "v"(rr[1][2][2]), "v"(xa));
              asm("v_fma_f32 %0, -%1, %2, %0" : "+v"(x[11]) : "v"(rr[1][2][3]), "v"(xa));
              asm("v_fma_f32 %0, -%1, %2, %0" : "+v"(x[12]) : "v"(rr[1][3][0]), "v"(xa));
              asm("v_fma_f32 %0, -%1, %2, %0" : "+v"(x[13]) : "v"(rr[1][3][1]), "v"(xa));
              asm("v_fma_f32 %0, -%1, %2, %0" : "+v"(x[14]) : "v"(rr[1][3][2]), "v"(xa));
              asm("v_fma_f32 %0, -%1, %2, %0" : "+v"(x[15]) : "v"(rr[1][3][3]), "v"(xa));
            }
            __builtin_amdgcn_sched_barrier(0);
            rr[1][3] = *(const LAS f32x4*)(nb_ + 812);
            { const float xa = dpp_mov<0xF5>(x[10]);
              asm("v_fma_f32 %0, -%1, %2, %0" : "+v"(x[11]) : "v"(rr[2][2][3]), "v"(xa));
              asm("v_fma_f32 %0, -%1, %2, %0" : "+v"(x[12]) : "v"(rr[2][3][0]), "v"(xa));
              asm("v_fma_f32 %0, -%1, %2, %0" : "+v"(x[13]) : "v"(rr[2][3][1]), "v"(xa));
              asm("v_fma_f32 %0, -%1, %2, %0" : "+v"(x[14]) : "v"(rr[2][3][2]), "v"(xa));
              asm("v_fma_f32 %0, -%1, %2, %0" : "+v"(x[15]) : "v"(rr[2][3][3]), "v"(xa));
            }
            __builtin_amdgcn_sched_barrier(0);
            rr[2][3] = *(const LAS f32x4*)(nb_ + 844);
            { const float xa = dpp_mov<0xF5>(x[11]);
              asm("v_fma_f32 %0, -%1, %2, %0" : "+v"(x[12]) : "v"(rr[3][3][0]), "v"(xa));
              asm("v_fma_f32 %0, -%1, %2, %0" : "+v"(x[13]) : "v"(rr[3][3][1]), "v"(xa));
              asm("v_fma_f32 %0, -%1, %2, %0" : "+v"(x[14]) : "v"(rr[3][3][2]), "v"(xa));
              asm("v_fma_f32 %0, -%1, %2, %0" : "+v"(x[15]) : "v"(rr[3][3][3]), "v"(xa));
            }
            __builtin_amdgcn_sched_barrier(0);
            rr[3][3] = *(const LAS f32x4*)(nb_ + 876);
            { const float xa = dpp_mov<0xA0>(x[12]);
              asm("v_fma_f32 %0, -%1, %2, %0" : "+v"(x[12]) : "v"(rr[0][3][0]), "v"(xa));
              asm("v_fma_f32 %0, -%1, %2, %0" : "+v"(x[13]) : "v"(rr[0][3][1]), "v"(xa));
              asm("v_fma_f32 %0, -%1, %2, %0" : "+v"(x[14]) : "v"(rr[0][3][2]), "v"(xa));
              asm("v_fma_f32 %0, -%1, %2, %0" : "+v"(x[15]) : "v"(rr[0][3][3]), "v"(xa));
            }
            __builtin_amdgcn_sched_barrier(0);
            rr[0][3] = *(const LAS f32x4*)(nb_ + 908);
            { const float xa = dpp_mov<0xA0>(x[13]);
              asm("v_fma_f32 %0, -%1, %2, %0" : "+v"(x[12]) : "v"(rr[1][3][0]), "v"(xa));
              asm("v_fma_f32 %0, -%1, %2, %0" : "+v"(x[13]) : "v"(rr[1][3][1]), "v"(xa));
              asm("v_fma_f32 %0, -%1, %2, %0" : "+v"(x[14]) : "v"(rr[1][3][2]), "v"(xa));
              asm("v_fma_f32 %0, -%1, %2, %0" : "+v"(x[15]) : "v"(rr[1][3][3]), "v"(xa));
            }
            __builtin_amdgcn_sched_barrier(0);
            rr[1][3] = *(const LAS f32x4*)(nb_ + 940);
            { const float xa = dpp_mov<0xF5>(x[12]);
              asm("v_fma_f32 %0, -%1, %2, %0" : "+v"(x[13]) : "v"(rr[2][3][1]), "v"(xa));
              asm("v_fma_f32 %0, -%1, %2, %0" : "+v"(x[14]) : "v"(rr[2][3][2]), "v"(xa));
              asm("v_fma_f32 %0, -%1, %2, %0" : "+v"(x[15]) : "v"(rr[2][3][3]), "v"(xa));
            }
            __builtin_amdgcn_sched_barrier(0);
            rr[2][3] = *(const LAS f32x4*)(nb_ + 972);
            { const float xa = dpp_mov<0xF5>(x[13]);
              asm("v_fma_f32 %0, -%1, %2, %0" : "+v"(x[14]) : "v"(rr[3][3][2]), "v"(xa));
              asm("v_fma_f32 %0, -%1, %2, %0" : "+v"(x[15]) : "v"(rr[3][3][3]), "v"(xa));
            }
            __builtin_amdgcn_sched_barrier(0);
            { const float xa = dpp_mov<0xA0>(x[14]);
              asm("v_fma_f32 %0, -%1, %2, %0" : "+v"(x[14]) : "v"(rr[0][3][2]), "v"(xa));
              asm("v_fma_f32 %0, -%1, %2, %0" : "+v"(x[15]) : "v"(rr[0][3][3]), "v"(xa));
            }
            __builtin_amdgcn_sched_barrier(0);
            { const float xa = dpp_mov<0xA0>(x[15]);
              asm("v_fma_f32 %0, -%1, %2, %0" : "+v"(x[14]) : "v"(rr[1][3][2]), "v"(xa));
              asm("v_fma_f32 %0, -%1, %2, %0" : "+v"(x[15]) : "v"(rr[1][3][3]), "v"(xa));
            }
            __builtin_amdgcn_sched_barrier(0);
            { const float xa = dpp_mov<0xF5>(x[14]);
              asm("v_fma_f32 %0, -%1, %2, %0" : "+v"(x[15]) : "v"(rr[2][3][3]), "v"(xa));
            }
            __builtin_amdgcn_sched_barrier(0);
#pragma unroll
            for (int mm = 0; mm < 8; ++mm) *(LAS unsigned*)(dst + 2 * (2 * mm + p)) = cvtpk(x[2 * mm], x[2 * mm + 1]);
        }
        __syncthreads();
        v4u prc[5], prh;
        { const v4u z0 = {0u, 0u, 0u, 0u}; prc[0] = z0; prc[1] = z0; prc[2] = z0; prc[3] = z0; prc[4] = z0; prh = z0; }
        if (sc + 1 < 68) SCAN_A_LOAD(sc + 1);
        {
            const int lane_ = lane_id_(); const int l31 = lane_ & 31, hh = lane_ >> 5;
            {
                const int q = wave >> 2, jb = wave & 1, jbp = (wave >> 1) & 1;
                f_tile<true>(GG + (q * 64 + 32 * jb + l31) * CS + 8 * hh, BCT + (q * 64 + 32 * jbp + l31) * CS + 8 * hh, BCT, PCT + (q * 64 + 32 * jbp + l31) * TS + 32 * jb, GC[q * 64 + 32 * jbp + l31], 32 * jbp + l31 - 32 * jb, hh);
            }
            if (wave >= 4 || lat) {
                const bool isE = wave < 4; const int q = (wave >> 1) & 1, x = wave & 1;
                const LAS bf16* X = (isE ? GG + (q * 64 + 32 * x) * CS : MM + (q * 32) * CS) + l31 * CS + 8 * hh;
                const LAS bf16* Y = (isE ? QBRT + (q * 32) * CS : BCT + (q * 64 + 32 * x) * CS) + l31 * CS + 8 * hh;
                const int str = isE ? TS : CS;
                const LAS bf16* Bp = (isE ? RB + (32 * q) * TS + 32 * x : KCT + (q * 64 + 32 * x) * CS) + l31 * str + 4 * hh;
                LAS bf16* Op = (isE ? E1T + (q * 32) * TS + 32 * x : DCT + (q * 64 + 32 * x) * CS) + l31 * str;
                f_tile<false>(X, Y, Bp, Op, 0.f, 0, hh);
            }
            if (lat && (wave == 1 || wave == 6)) {
                const int q = wave == 6;
                f_tile<false>(MM + (q * 32 + l31) * CS + 8 * hh, QBRT + (q * 32 + l31) * CS + 8 * hh, QKRT + (q * 32 + l31) * CS + 4 * hh, ZT + (q * 32 + l31) * CS, 0.f, 0, hh);
            }
        }
        __syncthreads();
        { GAS v4u* lp = lfr;
#pragma unroll
          for (int e4 = 0; e4 < 4; ++e4) lfrv[e4] = lp[e4]; }
        if (sc + 1 < 68) scan_a2(L, wave, d, sc + 1 >= 4, (sc + 1 >= 4) ? (sc + 1) * 64 - 256 : (sc + 1) * 64, prc[0], prc[1], prc[2], prc[3], prc[4], prh);
#pragma unroll
        for (int q = 0; q < 2; ++q) {
            if (wave < 2) {
                if (lat) {
                    const int lane_ = lane_id_(); const int l31 = lane_ & 31, hh = lane_ >> 5, ib = wave;
                    const LAS bf16* Scur = SST + scur * (64 * TS) + (32 * ib + l31) * TS + 8 * hh;
                    const LAS bf16* A1 = E1T + (q * 32 + l31) * TS + 8 * hh;
                    const LAS bf16* A2p = ZT + (q * 32 + l31) * CS + 8 * hh;
                    const LAS bf16* Vp = VT + (q * 64 + 32 * ib + l31) * CS + 8 * hh;
                    f32x16 acc;
#pragma unroll
                    for (int r = 0; r < 16; ++r) acc[r] = 0.f;
#pragma unroll
                    for (int s2 = 0; s2 < 2; ++s2) acc = __builtin_amdgcn_mfma_f32_32x32x16_bf16(*(const LAS bf16x8*)(Vp + 16 * s2), *(const LAS bf16x8*)(A2p + 16 * s2), acc, 0, 0, 0);
#pragma unroll
                    for (int s4 = 0; s4 < 4; ++s4) acc = __builtin_amdgcn_mfma_f32_32x32x16_bf16(*(const LAS bf16x8*)(Scur + 16 * s4), *(const LAS bf16x8*)(A1 + 16 * s4), acc, 0, 0, 0);
                    const unsigned yu = (unsigned)__builtin_amdgcn_readfirstlane((int)(((unsigned)d * ML + (unsigned)rbase) * 512u + (unsigned)(h * 64 + 32 * ib)));
                    GAS bf16* yb = (GAS bf16*)F.Y;
                    const int pos = pos0 + 32 * q + l31, idx = d ? (SEQ - 1 - pos) : pos;
                    const unsigned yo = yu + (unsigned)(idx * 512 + 4 * hh);
#pragma unroll
                    for (int gg = 0; gg < 4; ++gg) *(GAS u32x2*)(yb + yo + 8 * gg) = pk4(acc[4 * gg], acc[4 * gg + 1], acc[4 * gg + 2], acc[4 * gg + 3]);
                }
            } else if (wave < 6) {
                const int lane_ = lane_id_(); const int l31 = lane_ & 31, hh = lane_ >> 5, ib = (wave - 2) & 1, jbp = (wave - 2) >> 1;
                const LAS bf16* Scur = SST + scur * (64 * TS) + (32 * ib + l31) * TS + 8 * hh;
                const LAS bf16* A1 = PCT + (q * 64 + 32 * jbp + l31) * TS + 8 * hh;
                const LAS bf16* A2p = DCT + (q * 64 + 32 * jbp + l31) * CS + 8 * hh;
                const LAS bf16* Vp = VT + (q * 64 + 32 * ib + l31) * CS + 8 * hh;
                f32x16 acc;
#pragma unroll
                for (int r = 0; r < 16; ++r) acc[r] = 0.f;
#pragma unroll
                for (int s2 = 0; s2 < 2; ++s2) acc = __builtin_amdgcn_mfma_f32_32x32x16_bf16(*(const LAS bf16x8*)(A2p + 16 * s2), *(const LAS bf16x8*)(Vp + 16 * s2), acc, 0, 0, 0);
#pragma unroll
                for (int s4 = 0; s4 < 4; ++s4) acc = __builtin_amdgcn_mfma_f32_32x32x16_bf16(*(const LAS bf16x8*)(A1 + 16 * s4), *(const LAS bf16x8*)(Scur + 16 * s4), acc, 0, 0, 0);
                LAS bf16* Snx = SST + (scur ^ 1) * (64 * TS) + (32 * ib + l31) * TS + 32 * jbp;
#pragma unroll
                for (int gg = 0; gg < 4; ++gg) *(LAS u32x2*)(Snx + 8 * gg + 4 * hh) = pk4(acc[4 * gg], acc[4 * gg + 1], acc[4 * gg + 2], acc[4 * gg + 3]);
            } else if (wave == 6 && q == 0 && lat) {
                const int ln_ = lane_id_(); const int pos = pos0 + ln_, idx = d ? (SEQ - 1 - pos) : pos;
                F.bonus[(rbase + idx) * 16 + h * 2 + d] = BON[ln_]; BON[ln_] = 0.f;
            }
            scur ^= 1;
            __syncthreads();
        }
    }
}
__device__ __forceinline__ void p5_readout(Frame& F, const bool own_panel) {
    const int gw = own_panel ? (int)blockIdx.x * 256 + F.wave : F.vcu * NWAVES + F.wave, NGW = own_panel ? NWAVES : F.G * NWAVES, lane = lane_id_();
    const int mend = own_panel ? (int)blockIdx.x * 256 + 256 : ML;
    const int c8 = 8 * lane, hd = lane >> 3;
    float cw0[8], cw2[8], gw_[8], gb_[8];
#pragma unroll
    for (int e = 0; e < 8; ++e) { cw0[e] = F.conv_w[512 + c8 + e]; cw2[e] = F.conv_w[3584 + 512 + c8 + e]; gw_[e] = F.gn_w[c8 + e]; gb_[e] = F.gn_b[c8 + e]; }
    const bf16* EDGE = (const bf16*)(F.ws + WS_EDGE);
    for (int m0 = gw; m0 < mend; m0 += 2 * NGW) {
        v4u ya[2], yb[2], v0[2], ve[2], gg[2]; float bon[2]; bool ok[2], npv[2];
        const v4u z = {0u, 0u, 0u, 0u};
#pragma unroll
        for (int u = 0; u < 2; ++u) {
            const int m = m0 + u * NGW; ok[u] = m < mend; const int mm = ok[u] ? m : m0;
            const int tl = mm & (SEQ - 1), em = mm & 255; const bool np = em == 0 && tl > 0, nx = em == 255 && tl + 1 < SEQ;
            ya[u] = *(const GAS v4u*)((const bf16*)F.Y + (size_t)mm * 512 + c8); yb[u] = *(const GAS v4u*)((const bf16*)F.Y + ((size_t)ML + mm) * 512 + c8);
            const bf16* prow = F.P + (size_t)mm * PW;
            v0[u] = *(const GAS v4u*)(prow + PC_RWV + c8); npv[u] = np;
            ve[u] = (np || nx) ? *(const GAS v4u*)(EDGE + (size_t)((np ? (mm >> 8) - 1 : (mm >> 8) + 1) * 2 + (np ? 1 : 0)) * 1792 + 512 + c8) : z;
            gg[u] = *(const GAS v4u*)(prow + PC_RWG + c8);
            bon[u] = F.bonus[(size_t)mm * 16 + hd * 2] + F.bonus[(size_t)mm * 16 + hd * 2 + 1];
        }
#pragma unroll
        for (int u = 0; u < 2; ++u) {
            float y[8];
#pragma unroll
            for (int e2 = 0; e2 < 4; ++e2) { y[2 * e2] = __uint_as_float(ya[u][e2] << 16) + __uint_as_float(yb[u][e2] << 16); y[2 * e2 + 1] = __uint_as_float(ya[u][e2] & 0xffff0000u) + __uint_as_float(yb[u][e2] & 0xffff0000u); }
            float s = 0.f;
#pragma unroll
            for (int e = 0; e < 8; ++e) s += y[e];
            s = red8(s);
            const float mu = s * (1.f / 64.f); float q = 0.f;
#pragma unroll
            for (int e = 0; e < 8; ++e) { y[e] -= mu; q += y[e] * y[e]; }
            q = red8(q);
            const float rstd = rsqrtf(q * (1.f / 64.f) + GN_EPS);
            float o[8];
#pragma unroll
            for (int e2 = 0; e2 < 4; ++e2) {
#pragma unroll
                for (int hb = 0; hb < 2; ++hb) {
                    const int e = 2 * e2 + hb;
                    const float pv_0 = hb ? __uint_as_float(v0[u][e2] & 0xffff0000u) : __uint_as_float(v0[u][e2] << 16), pv_e = hb ? __uint_as_float(ve[u][e2] & 0xffff0000u) : __uint_as_float(ve[u][e2] << 16);
                    const float vc = pv_0 + (npv[u] ? cw0[e] : cw2[e]) * pv_e;
                    const float g = hb ? __uint_as_float(gg[u][e2] & 0xffff0000u) : __uint_as_float(gg[u][e2] << 16);
                    const float yn = y[e] * rstd * gw_[e] + gb_[e];
                    o[e] = (yn + bon[u] * vc) * siluf_(g);
                }
            }
            if (ok[u]) { v4u w; w.x = cvtpk(o[0], o[1]); w.y = cvtpk(o[2], o[3]); w.z = cvtpk(o[4], o[5]); w.w = cvtpk(o[6], o[7]);
                *(GAS v4u*)(F.MIX + (size_t)(m0 + u * NGW) * DM + 512 + c8) = w; }
        }
    }
}
__device__ __forceinline__ void p7_final(Frame& F) {
    const int gw = F.vcu * NWAVES + F.wave, NGW = F.G * NWAVES;
    for (int m = gw; m < ML; m += NGW) {
        const float rstd = rsqrtf(__hip_atomic_load(F.sumsq + m, __ATOMIC_RELAXED, __HIP_MEMORY_SCOPE_AGENT) * (1.f / DM) + RMS_EPS);
        GAS f32x4* o = (GAS f32x4*)(F.out + (size_t)m * DM) + lane_id_();
#pragma unroll
        for (int j = 0; j < 4; ++j) { const f32x4 g = *(const f32x4*)(F.final_g + 4 * (lane_id_() + 64 * j)); o[64 * j] = o[64 * j] * rstd * g; }
    }
}

struct Args { const float* in[21]; float* out; unsigned char* ws; };
__global__ void __launch_bounds__(NWAVES * 64, 2) mk_fwd(Args args) {
    extern __shared__ __attribute__((aligned(16))) unsigned char lds[];
    Frame F;
    F.lds = (LAS unsigned char*)lds;
    volatile LAS unsigned* MISC = (volatile LAS unsigned*)(F.lds + MISC_OFF);
    F.wave = __builtin_amdgcn_readfirstlane((int)threadIdx.x >> 6);
    F.G = gridDim.x; { const int bx = blockIdx.x; F.vcu = (F.G % 8 == 0) ? (bx % 8) * (F.G / 8) + bx / 8 : bx; }
    unsigned char* ws = args.ws;
    gu32* ctl = (gu32*)(ws + WS_CTL);
    F.x = args.in[0]; F.c = args.in[1]; F.ctx = args.in[2]; F.c_ctx = args.in[3]; F.w_mod = args.in[4]; F.b_mod = args.in[5]; F.norm_g = args.in[6]; F.w_in = args.in[7];
    F.conv_w = args.in[8]; F.decay_w0 = args.in[9]; F.decay_w2 = args.in[10]; F.aaa_a0 = args.in[11]; F.aaa_a2 = args.in[12]; F.k_k = args.in[13]; F.k_a = args.in[14];
    F.r_k = args.in[15]; F.gn_w = args.in[16]; F.gn_b = args.in[17]; F.na_rpb = args.in[18]; F.w_out = args.in[19]; F.final_g = args.in[20];
    F.out = args.out; F.ws = args.ws;
    F.mod = (float*)(ws + WS_MOD); F.sumsq = (float*)(ws + WS_SUMSQ); F.bonus = (float*)(ws + WS_BONUS);
    F.WoutT = (bf16*)(ws + WS_WOUT); F.WinT = (bf16*)(ws + WS_WIN); F.XN = (bf16*)(ws + WS_XN); F.P = (bf16*)(ws + WS_P); F.VT = (bf16*)(ws + WS_VT); F.MIX = (bf16*)(ws + WS_MIX); F.Y = (bf16*)(ws + WS_Y);
    if (F.wave == 0) ((LAS unsigned*)(F.lds + MISC_OFF))[lane_id_()] = 0u;
    __syncthreads();
    XcdBarrier bar = xcd_barrier_post((unsigned*)(ctl + CW_BAR), MISC + 8, F.wave == 0 && lane_id_() == 0);

    p0_prologue(F);
    xcd_barrier(bar);
    p1_xn(F);
    xcd_barrier(bar);
    {
        static_assert(WS_XN == 64 * (512u << 10) && WS_WIN == 8 * (512u << 10), "absolute panel indices of MergedOrder");
        pg8::Gemm g{(const pg8::bf16_t*)ws, (const pg8::bf16_t*)ws, MT, PW, DM}; pg8::MergedOrder S; S.init(F.G, (int)blockIdx.x);
        pg8::EpiMerged E{F.P, F.VT, PW, VTP, (pg8::bf16_t*)(ws + WS_EDGE), F.lds};
        { LAS float* CWL = (LAS float*)(F.lds + pg8::EPI_CW_OFF); for (int e = F.wave * 64 + lane_id_(); e < 3 * 1792; e += NWAVES * 64) CWL[e] = F.conv_w[e]; }
        __syncthreads();
        pg8::gemm_phase<pg8::EpiMerged, pg8::MergedOrder, true, true>(F.lds, g, S, E, F.wave);
    }
    xcd_barrier(bar);
    p3_attention(F);
    __syncthreads();
    p4_scan(F);
    xcd_barrier(bar);
    p5_readout(F, F.G == 256);
    if (F.G != 256) xcd_barrier(bar);
    if (F.G == 256) {
        LAS float* ssq = (LAS float*)(F.lds + 131072);
        const int lane2 = lane_id_();
        if (F.wave < 4) ssq[F.wave * 64 + lane2] = 0.f;
        asm volatile("s_waitcnt vmcnt(0)" ::: "memory");
        __syncthreads();
        pg8::Gemm g{F.MIX, F.WoutT, ML, DM, DM}; pg8::PanelOrder S; S.init(F.G, (int)blockIdx.x);
        pg8::EpiOutH E{F.x, F.mod, (pg8::bf16_t*)F.XN, ssq};
        pg8::gemm_phase<pg8::EpiOutH, pg8::PanelOrder, true, true>(F.lds, g, S, E, F.wave);
        __syncthreads();
        const int pm = (int)blockIdx.x;
        f32x4 fg[2][2];
#pragma unroll
        for (int j = 0; j < 2; ++j)
#pragma unroll
            for (int n = 0; n < 2; ++n) fg[j][n] = *(const f32x4*)(F.final_g + 512 * j + 8 * lane2 + 4 * n);
        for (int r = F.wave * 32; r < F.wave * 32 + 32; r += 4) {
            v4u hv[4][2];
#pragma unroll
            for (int u = 0; u < 4; ++u)
#pragma unroll
                for (int j = 0; j < 2; ++j) hv[u][j] = *(const GAS v4u*)(F.XN + ((size_t)pm * 256 + r + u) * DM + 512 * j + 8 * lane2);
#pragma unroll
            for (int u = 0; u < 4; ++u) {
                const float rs = rsqrtf(ssq[r + u] * (1.f / DM) + RMS_EPS);
                GAS f32x4* o = (GAS f32x4*)(F.out + ((size_t)pm * 256 + r + u) * DM + 8 * lane2);
#pragma unroll
                for (int j = 0; j < 2; ++j) {
                    const v4u h4 = hv[u][j];
                    const f32x4 a = {__uint_as_float(h4.x << 16), __uint_as_float(h4.x & 0xffff0000u), __uint_as_float(h4.y << 16), __uint_as_float(h4.y & 0xffff0000u)};
                    const f32x4 c = {__uint_as_float(h4.z << 16), __uint_as_float(h4.z & 0xffff0000u), __uint_as_float(h4.w << 16), __uint_as_float(h4.w & 0xffff0000u)};
                    o[128 * j] = a * rs * fg[j][0]; o[128 * j + 1] = c * rs * fg[j][1];
                }
            }
        }
    } else {
        { pg8::Gemm g{F.MIX, F.WoutT, ML, DM, DM}; pg8::StaticOrder S; S.init(ML, DM, F.G, (int)blockIdx.x);
          pg8::EpiOut E{F.x, F.mod, F.out, F.sumsq};
          pg8::gemm_phase<pg8::EpiOut, pg8::StaticOrder, true, true>(F.lds, g, S, E, F.wave); }
        xcd_barrier(bar);
        p7_final(F);
    }
}

extern "C" void kernel_launch(void* const* d_in, const int* in_sizes, int n_in, void* d_out, int out_size, void* d_ws, size_t ws_size, hipStream_t stream) {
    static int grid = 0;
    if (grid == 0) {
        if (n_in != 21 || out_size != ML * DM || ws_size < WS_END) { fprintf(stderr, "kernel_launch: unexpected shapes (n_in %d, out %d, ws %zu)\n", n_in, out_size, ws_size); grid = -1; return; }
        int dev = 0, cus = 0, per_cu = 0;
        if (hipGetDevice(&dev) != hipSuccess || hipDeviceGetAttribute(&cus, hipDeviceAttributeMultiprocessorCount, dev) != hipSuccess) { grid = -1; return; }
        if (hipFuncSetAttribute((const void*)mk_fwd, hipFuncAttributeMaxDynamicSharedMemorySize, LDS_BYTES) != hipSuccess) { fprintf(stderr, "kernel_launch: hipFuncSetAttribute failed\n"); grid = -1; return; }
        if (hipOccupancyMaxActiveBlocksPerMultiprocessor(&per_cu, (const void*)mk_fwd, NWAVES * 64, LDS_BYTES) != hipSuccess || per_cu < 1) { fprintf(stderr, "kernel_launch: occupancy query says %d\n", per_cu); }
        (void)hipGetLastError();
        grid = cus;
    }
    if (grid < 0) return;
    if (hipMemsetAsync((char*)d_ws + WS_CTL, 0, CTL_ZERO_BYTES, stream) != hipSuccess) return;
    Args a{};
    for (int i = 0; i < 21; ++i) a.in[i] = (const float*)d_in[i];
    a.out = (float*)d_out; a.ws = (unsigned char*)d_ws;
    hipLaunchKernelGGL(mk_fwd, dim3(grid), dim3(NWAVES * 64), LDS_BYTES, stream, a);
}
```

```cpp
#include <hip/hip_runtime.h>
#include <cstdio>
#include <cstdint>
namespace pg8 {
#define PG8_LAS __attribute__((address_space(3)))
typedef unsigned short bf16_t;
typedef short bf16x8 __attribute__((ext_vector_type(8)));
typedef float f32x4 __attribute__((ext_vector_type(4)));
typedef unsigned u32x4 __attribute__((ext_vector_type(4)));
constexpr int BM = 256, BK = 64, HALF = 128, HTB = HALF * BK * 2  , STAGE_BYTES = 8 * HTB, NXCD = 8, WGM = 4;

__host__ __device__ __forceinline__ int lds_byte(int r, int c) { const int st = (r >> 4) * 2 + (c >> 5), rr = r & 15, cc = c & 31, ob = rr * 64 + cc * 2; return st * 1024 + (ob ^ (((ob >> 9) & 1) << 5)); }
__host__ __device__ __forceinline__ void stage_rc(int b, int& R, int& C) { const int st = b / 1024, sb = b % 1024, swz = sb ^ (((sb >> 9) & 1) << 5); R = (st >> 1) * 16 + swz / 64; C = (st & 1) * 32 + (swz % 64) / 2; }
__host__ __device__ __forceinline__ int perm32(int rho) { const int n = rho >> 4, i = rho & 15; return 8 * (i >> 2) + 4 * n + (i & 3); }

struct Unit { int pm, pn; };
struct Gemm { const bf16_t* A; const bf16_t* Bt; int M, N, K; };

struct StaticOrder {
    int nM, nN, nwg, G, c;
    __host__ __device__ void init(int M, int N, int G_, int c_) { nM = M / BM; nN = N / BM; nwg = nM * nN; G = G_; c = c_; }
    __host__ __device__ bool next(int i, Unit& u) const {
        const long L = (long)i * G + c; if (L >= nwg) return false;
        int wgid = (int)L; { const int q = nwg / NXCD, r = nwg % NXCD, xcd = wgid % NXCD, off = wgid / NXCD; wgid = (xcd < r ? xcd * (q + 1) : r * (q + 1) + (xcd - r) * q) + off; }
        const int nig = WGM * nN, gid = wgid / nig, fm = gid * WGM, gsz = (nM - fm) < WGM ? (nM - fm) : WGM;
        u.pm = fm + ((wgid % nig) % gsz); u.pn = (wgid % nig) / gsz; return true;
    }
    __device__ __forceinline__ void a_ready(const Unit&) const {}
    __device__ __forceinline__ void done(const Unit&) const {}
};

__device__ __forceinline__ unsigned cvt_pk_bf16(float lo, float hi) { unsigned r; asm volatile("v_cvt_pk_bf16_f32 %0, %1, %2" : "=v"(r) : "v"(lo), "v"(hi)); return r; }
typedef float f32x2 __attribute__((ext_vector_type(2)));
__device__ __forceinline__ f32x2 gelu_pk(f32x2 v) {
    const f32x2 av = __builtin_elementwise_abs(v), d = av * 0.2316418882f + 1.0f;
    f32x2 t; t.x = __builtin_amdgcn_rcpf(d.x); t.y = __builtin_amdgcn_rcpf(d.y);
    f32x2 q = t * 0.5307027145f + (-0.7265760135f); q = q * t + 0.7107068705f; q = q * t + (-0.142248368f); q = q * t + 0.127414796f; q = q * t;
    const f32x2 s = (v * v) * (-0.72134752044f);
    f32x2 e; e.x = __builtin_amdgcn_exp2f(s.x); e.y = __builtin_amdgcn_exp2f(s.y);
    const f32x2 m = v * (q * e), r = v - m;
    f32x2 o; o.x = v.x < 0.f ? m.x : r.x; o.y = v.y < 0.f ? m.y : r.y; return o;
}

template <int ACT  > struct EpiBf16 {
    static constexpr bool PERM = true, AFTER_DRAIN = false; static_assert(ACT == 0 || ACT == 1, "EpiBf16: ACT is 0 (none) or 1 (gelu_pk)");
    bf16_t* O; int ldc; const float* bias; int split_cols; size_t split_stride; float scale0;
    __device__ __forceinline__ void operator()(const f32x4 (&acc)[2][2][4][2], const Unit& u, int wr, int wc, int fr, int fq) const {
        const int row0 = u.pm * BM + wr * 64 + fr; int colt = u.pn * BM; bf16_t* base = O;
        float sc = 1.f; if (split_cols) { const int t = colt / split_cols; base += (size_t)t * split_stride; colt -= t * split_cols; if (t == 0) sc = scale0; }
        const int col0 = colt + wc * 32 + 8 * fq, bcol0 = u.pn * BM + wc * 32 + 8 * fq;
        f32x4 bv[2][2];
#pragma unroll
        for (int bj = 0; bj < 2; ++bj)
#pragma unroll
            for (int n = 0; n < 2; ++n) bv[bj][n] = bias ? *(const f32x4*)(bias + bcol0 + bj * HALF + 4 * n) : (f32x4){0.f, 0.f, 0.f, 0.f};
#pragma unroll
        for (int ai = 0; ai < 2; ++ai)
#pragma unroll
            for (int m = 0; m < 4; ++m) { bf16_t* rowp = base + (size_t)(row0 + ai * HALF + m * 16) * ldc + col0;
#pragma unroll
                for (int bj = 0; bj < 2; ++bj) { f32x4 v0 = acc[ai][bj][m][0] + bv[bj][0], v1 = acc[ai][bj][m][1] + bv[bj][1];
                    if (ACT == 1) { f32x2 a = gelu_pk((f32x2){v0[0], v0[1]}), b = gelu_pk((f32x2){v0[2], v0[3]}), c = gelu_pk((f32x2){v1[0], v1[1]}), d = gelu_pk((f32x2){v1[2], v1[3]});
                        v0 = (f32x4){a.x, a.y, b.x, b.y}; v1 = (f32x4){c.x, c.y, d.x, d.y}; }
                    v0 = v0 * sc; v1 = v1 * sc; u32x4 w; w.x = cvt_pk_bf16(v0[0], v0[1]); w.y = cvt_pk_bf16(v0[2], v0[3]); w.z = cvt_pk_bf16(v1[0], v1[1]); w.w = cvt_pk_bf16(v1[2], v1[3]);
                    *(u32x4*)(rowp + bj * HALF) = w; } }
    }
};

struct MergedOrder {
    StaticOrder so; int G, c;
    __host__ __device__ void init(int G_, int c_) { so.init(65536, 3840, G_, c_); G = G_; c = c_; }
    __host__ __device__ bool next(int i, Unit& u) const {
        const long L = (long)i * G + c;
        if (L < 3840) { Unit t; so.next(i, t); u.pm = 64 + t.pm; u.pn = 8 + t.pn; return true; }
        const int r = (int)(L - 3840);
        if (r < 544) { u.pm = 8 + 15 + (r & 1); u.pn = 64 + (r >> 1); return true; }
        if (r < 656) { const int r2 = r - 544; u.pm = 64 + 256 + (r2 & 15); u.pn = 8 + (r2 >> 4); return true; }
        return false;
    }
    __device__ __forceinline__ void a_ready(const Unit&) const {}
    __device__ __forceinline__ void done(const Unit&) const {}
};
template <int CTRL> __device__ __forceinline__ float dppf(float x) { return __builtin_bit_cast(float, __builtin_amdgcn_update_dpp(0, __builtin_bit_cast(int, x), CTRL, 0xf, 0xf, true)); }
constexpr int EPI_EDGE_OFF = 131072, EPI_CW_OFF = 139264;
struct EpiMerged {
    static constexpr bool PERM = true, AFTER_DRAIN = false;
    bf16_t* P; bf16_t* VT; int ldp, ldv; bf16_t* EDGE; PG8_LAS unsigned char* lds;
    __device__ __forceinline__ void operator()(const f32x4 (&acc)[2][2][4][2], const Unit& u, int wr, int wc, int fr, int fq) const {
        const bool isv = u.pm < 64;
        const int rp = isv ? u.pm - 23 : u.pm - 64, cp = isv ? u.pn - 64 : u.pn - 8, ldc = isv ? ldv : ldp;
        bf16_t* base = isv ? VT : P;
        const int row0 = rp * BM + wr * 64 + fr, col0 = cp * BM + wc * 32 + 8 * fq;
        if (isv || cp < 2 || cp >= 9) {
#pragma unroll
        for (int ai = 0; ai < 2; ++ai)
#pragma unroll
            for (int m = 0; m < 4; ++m) { bf16_t* rowp = base + (size_t)(row0 + ai * HALF + m * 16) * ldc + col0;
#pragma unroll
                for (int bj = 0; bj < 2; ++bj) { const f32x4 v0 = acc[ai][bj][m][0], v1 = acc[ai][bj][m][1];
                    u32x4 w; w.x = cvt_pk_bf16(v0[0], v0[1]); w.y = cvt_pk_bf16(v0[2], v0[3]); w.z = cvt_pk_bf16(v1[0], v1[1]); w.w = cvt_pk_bf16(v1[2], v1[3]);
                    *(u32x4*)(rowp + bj * HALF) = w; } }
        } else {
            int fq8 = 8 * fq; asm volatile("" : "+v"(fq8));
            PG8_LAS float* EL = (PG8_LAS float*)(lds + EPI_EDGE_OFF) + wc * 32 + fq8;
            const PG8_LAS float* CWL = (const PG8_LAS float*)(lds + EPI_CW_OFF) + (cp - 2) * BM + wc * 32 + fq8;
            if (fr == 0) {
#pragma unroll
                for (int ai = 0; ai < 2; ++ai)
#pragma unroll
                    for (int bj = 0; bj < 2; ++bj)
#pragma unroll
                        for (int n = 0; n < 2; ++n) *(PG8_LAS f32x4*)(EL + ((2 * ai + wr) * 2 + 0) * 256 + bj * HALF + 4 * n) = acc[ai][bj][0][n];
            }
            if (fr == 15) {
#pragma unroll
                for (int ai = 0; ai < 2; ++ai)
#pragma unroll
                    for (int bj = 0; bj < 2; ++bj)
#pragma unroll
                        for (int n = 0; n < 2; ++n) *(PG8_LAS f32x4*)(EL + ((2 * ai + wr) * 2 + 1) * 256 + bj * HALF + 4 * n) = acc[ai][bj][3][n];
            }
            asm volatile("s_waitcnt lgkmcnt(0)" ::: "memory"); __builtin_amdgcn_s_barrier();
            if (wr == 0 && fr == 0) {
#pragma unroll
                for (int bj = 0; bj < 2; ++bj) { const f32x4 v0 = acc[0][bj][0][0], v1 = acc[0][bj][0][1];
                    u32x4 w; w.x = cvt_pk_bf16(v0[0], v0[1]); w.y = cvt_pk_bf16(v0[2], v0[3]); w.z = cvt_pk_bf16(v1[0], v1[1]); w.w = cvt_pk_bf16(v1[2], v1[3]);
                    *(u32x4*)(EDGE + (size_t)(rp * 2 + 0) * 1792 + (cp - 2) * BM + wc * 32 + 8 * fq + bj * HALF) = w; }
            }
            if (wr == 1 && fr == 15) {
#pragma unroll
                for (int bj = 0; bj < 2; ++bj) { const f32x4 v0 = acc[1][bj][3][0], v1 = acc[1][bj][3][1];
                    u32x4 w; w.x = cvt_pk_bf16(v0[0], v0[1]); w.y = cvt_pk_bf16(v0[2], v0[3]); w.z = cvt_pk_bf16(v1[0], v1[1]); w.w = cvt_pk_bf16(v1[2], v1[3]);
                    *(u32x4*)(EDGE + (size_t)(rp * 2 + 1) * 1792 + (cp - 2) * BM + wc * 32 + 8 * fq + bj * HALF) = w; }
            }
            const f32x4 zz = {0.f, 0.f, 0.f, 0.f};
#pragma unroll
            for (int bj = 0; bj < 2; ++bj) {
                f32x4 w0[2], w1[2], w2[2];
#pragma unroll
                for (int n = 0; n < 2; ++n) { w0[n] = *(const PG8_LAS f32x4*)(CWL + bj * HALF + 4 * n); w1[n] = *(const PG8_LAS f32x4*)(CWL + 1792 + bj * HALF + 4 * n); w2[n] = *(const PG8_LAS f32x4*)(CWL + 3584 + bj * HALF + 4 * n); }
#pragma unroll
                for (int ai = 0; ai < 2; ++ai) {
                    const int b4 = 2 * ai + wr;
                    f32x4 hp[2], hn[2];
#pragma unroll
                    for (int n = 0; n < 2; ++n) { hp[n] = b4 > 0 ? *(const PG8_LAS f32x4*)(EL + ((b4 - 1) * 2 + 1) * 256 + bj * HALF + 4 * n) : zz; hn[n] = b4 < 3 ? *(const PG8_LAS f32x4*)(EL + ((b4 + 1) * 2 + 0) * 256 + bj * HALF + 4 * n) : zz; }
#pragma unroll
                    for (int m = 0; m < 4; ++m) {
                        f32x4 t[2];
#pragma unroll
                        for (int n = 0; n < 2; ++n)
#pragma unroll
                            for (int e = 0; e < 4; ++e) {
                                const float c = acc[ai][bj][m][n][e];
                                const float up = m > 0 ? dppf<0x121>(acc[ai][bj][m > 0 ? m - 1 : 0][n][e]) : hp[n][e];
                                const float dn = m < 3 ? dppf<0x12F>(acc[ai][bj][m < 3 ? m + 1 : 3][n][e]) : hn[n][e];
                                const float pv = __builtin_bit_cast(float, __builtin_amdgcn_update_dpp(__builtin_bit_cast(int, up), __builtin_bit_cast(int, c), 0x111, 0xf, 0xf, false));
                                const float nv = __builtin_bit_cast(float, __builtin_amdgcn_update_dpp(__builtin_bit_cast(int, dn), __builtin_bit_cast(int, c), 0x101, 0xf, 0xf, false));
                                t[n][e] = w0[n][e] * pv + w1[n][e] * c + w2[n][e] * nv;
                            }
                        if (bj == 0 && cp == 6) {
                            const bool er = (ai == 0 && m == 0) ? (wr == 0 && fr == 0) : (ai == 1 && m == 3) ? (wr == 1 && fr == 15) : false;
#pragma unroll
                            for (int n = 0; n < 2; ++n)
#pragma unroll
                                for (int e = 0; e < 4; ++e) { const float th = 1.f - 2.f * __builtin_amdgcn_rcpf(__builtin_amdgcn_exp2f(t[n][e] * 2.885390081777927f) + 1.f); t[n][e] = er ? t[n][e] : th; }
                        }
                        u32x4 w; w.x = cvt_pk_bf16(t[0][0], t[0][1]); w.y = cvt_pk_bf16(t[0][2], t[0][3]); w.z = cvt_pk_bf16(t[1][0], t[1][1]); w.w = cvt_pk_bf16(t[1][2], t[1][3]);
                        *(u32x4*)(base + (size_t)(row0 + ai * HALF + m * 16) * ldc + col0 + bj * HALF) = w;
                    }
                }
            }
        }
    }
};
struct PanelOrder {
    int G, c;
    __host__ __device__ void init(int G_, int c_) { G = G_; c = c_; }
    __host__ __device__ bool next(int i, Unit& u) const { u.pm = c + (i >> 2) * G; u.pn = i & 3; return u.pm < 256; }
    __device__ __forceinline__ void a_ready(const Unit&) const {}
    __device__ __forceinline__ void done(const Unit&) const {}
};
struct EpiOutP {
    static constexpr bool PERM = false, AFTER_DRAIN = false;
    const float* x; const float* mod; float* out; PG8_LAS float* ssq;
    __device__ __forceinline__ void operator()(const f32x4 (&acc)[2][2][4][2], const Unit& u, int wr, int wc, int fr, int fq) const {
        const int col0 = u.pn * BM + wc * 32 + 4 * fq;
        const int b = (u.pm * BM) >> 12;
        const float* gate = mod + b * 3072 + 2048;
        f32x4 gv[2][2];
#pragma unroll
        for (int bj = 0; bj < 2; ++bj)
#pragma unroll
            for (int n = 0; n < 2; ++n) gv[bj][n] = *(const f32x4*)(gate + col0 + bj * HALF + n * 16);
#pragma unroll
        for (int ai = 0; ai < 2; ++ai)
#pragma unroll
            for (int m = 0; m < 4; ++m) {
                const int rl = ai * HALF + wr * 64 + m * 16 + fr, row = u.pm * BM + rl;
                const size_t off = (size_t)row * 1024 + col0;
                float ss = 0.f;
#pragma unroll
                for (int bj = 0; bj < 2; ++bj)
#pragma unroll
                    for (int n = 0; n < 2; ++n) {
                        const f32x4 xv = *(const f32x4*)(x + off + bj * HALF + n * 16);
                        const f32x4 o = xv + gv[bj][n] * acc[ai][bj][m][n];
                        *(f32x4*)(out + off + bj * HALF + n * 16) = o;
                        ss += (o[0] * o[0] + o[1] * o[1]) + (o[2] * o[2] + o[3] * o[3]);
                    }
                { auto r1 = __builtin_amdgcn_permlane16_swap(__float_as_uint(ss), __float_as_uint(ss), false, false); ss = __uint_as_float(r1[0]) + __uint_as_float(r1[1]);
                  auto r2 = __builtin_amdgcn_permlane32_swap(__float_as_uint(ss), __float_as_uint(ss), false, false); ss = __uint_as_float(r2[0]) + __uint_as_float(r2[1]); }
                if (fq == 0) __hip_atomic_fetch_add(ssq + rl, ss, __ATOMIC_RELAXED, __HIP_MEMORY_SCOPE_WORKGROUP);
                asm volatile("" ::: "memory");
            }
    }
};
struct EpiOutH {
    static constexpr bool PERM = true, AFTER_DRAIN = false;
    const float* x; const float* mod; bf16_t* H; PG8_LAS float* ssq;
    __device__ __forceinline__ void operator()(const f32x4 (&acc)[2][2][4][2], const Unit& u, int wr, int wc, int fr, int fq) const {
        const int col0 = u.pn * BM + wc * 32 + 8 * fq;
        const int b = (u.pm * BM) >> 12;
        const float* gate = mod + b * 3072 + 2048;
        f32x4 gv[2][2];
#pragma unroll
        for (int bj = 0; bj < 2; ++bj)
#pragma unroll
            for (int n = 0; n < 2; ++n) gv[bj][n] = *(const f32x4*)(gate + col0 + bj * HALF + 4 * n);
#pragma unroll
        for (int ai = 0; ai < 2; ++ai)
#pragma unroll
            for (int m = 0; m < 4; ++m) {
                const int rl = ai * HALF + wr * 64 + m * 16 + fr, row = u.pm * BM + rl;
                const size_t off = (size_t)row * 1024 + col0;
                float ss = 0.f;
#pragma unroll
                for (int bj = 0; bj < 2; ++bj) {
                    const f32x4 xa = *(const f32x4*)(x + off + bj * HALF), xb = *(const f32x4*)(x + off + bj * HALF + 4);
                    const f32x4 o0 = xa + gv[bj][0] * acc[ai][bj][m][0], o1 = xb + gv[bj][1] * acc[ai][bj][m][1];
                    u32x4 w; w.x = cvt_pk_bf16(o0[0], o0[1]); w.y = cvt_pk_bf16(o0[2], o0[3]); w.z = cvt_pk_bf16(o1[0], o1[1]); w.w = cvt_pk_bf16(o1[2], o1[3]);
                    *(u32x4*)(H + off + bj * HALF) = w;
                    ss += ((o0[0] * o0[0] + o0[1] * o0[1]) + (o0[2] * o0[2] + o0[3] * o0[3])) + ((o1[0] * o1[0] + o1[1] * o1[1]) + (o1[2] * o1[2] + o1[3] * o1[3]));
                }
                { auto r1 = __builtin_amdgcn_permlane16_swap(__float_as_uint(ss), __float_as_uint(ss), false, false); ss = __uint_as_float(r1[0]) + __uint_as_float(r1[1]);
                  auto r2 = __builtin_amdgcn_permlane32_swap(__float_as_uint(ss), __float_as_uint(ss), false, false); ss = __uint_as_float(r2[0]) + __uint_as_float(r2[1]); }
                if (fq == 0) __hip_atomic_fetch_add(ssq + rl, ss, __ATOMIC_RELAXED, __HIP_MEMORY_SCOPE_WORKGROUP);
                asm volatile("" ::: "memory");
            }
    }
};
struct EpiOut {
    static constexpr bool PERM = false, AFTER_DRAIN = false;
    const float* x; const float* mod; float* out; float* sumsq;
    __device__ __forceinline__ void operator()(const f32x4 (&acc)[2][2][4][2], const Unit& u, int wr, int wc, int fr, int fq) const {
        const int col0 = u.pn * BM + wc * 32 + 4 * fq;
        const int b = (u.pm * BM) >> 12;
        const float* gate = mod + b * 3072 + 2048;
        f32x4 gv[2][2];
#pragma unroll
        for (int bj = 0; bj < 2; ++bj)
#pragma unroll
            for (int n = 0; n < 2; ++n) gv[bj][n] = *(const f32x4*)(gate + col0 + bj * HALF + n * 16);
#pragma unroll
        for (int ai = 0; ai < 2; ++ai)
#pragma unroll
            for (int m = 0; m < 4; ++m) {
                const int row = u.pm * BM + ai * HALF + wr * 64 + m * 16 + fr;
                const size_t off = (size_t)row * 1024 + col0;
                float ss = 0.f;
#pragma unroll
                for (int bj = 0; bj < 2; ++bj)
#pragma unroll
                    for (int n = 0; n < 2; ++n) {
                        const f32x4 xv = *(const f32x4*)(x + off + bj * HALF + n * 16);
                        const f32x4 o = xv + gv[bj][n] * acc[ai][bj][m][n];
                        *(f32x4*)(out + off + bj * HALF + n * 16) = o;
                        ss += (o[0] * o[0] + o[1] * o[1]) + (o[2] * o[2] + o[3] * o[3]);
                    }
                ss += __shfl_xor(ss, 16); ss += __shfl_xor(ss, 32);
                if (fq == 0) atomicAdd(sumsq + row, ss);
                asm volatile("" ::: "memory");
            }
    }
};
template <class Epi, class Sched, bool ALIGN_EPI = false, bool SP2 = false>
__device__ __forceinline__ void gemm_phase(PG8_LAS unsigned char* lds, const Gemm g, const Sched& S, const Epi& E, const int wid_in) {
    int lane_o; asm volatile("v_mbcnt_lo_u32_b32 %0, -1, 0\n\tv_mbcnt_hi_u32_b32 %0, -1, %0" : "=v"(lane_o)); const int tid_o = wid_in * 64 + lane_o;
    const int tid = tid_o, wid = wid_in, lane = tid & 63, wr = wid >> 2, wc = wid & 3, fr = lane & 15, fq = lane >> 4;
    const int K = g.K, nt = K / BK;
    unsigned voffA[2], voffB[2];
#pragma unroll
    for (int i = 0; i < 2; ++i) { int R, C; stage_rc(tid * 16 + i * 8192, R, C); const int Rb = Epi::PERM ? ((R & ~31) + perm32(R & 31)) : R;
        voffA[i] = (unsigned)(R * K + C) * 2u; voffB[i] = (unsigned)(Rb * K + C) * 2u; }
    const size_t kstep = (size_t)(BK * 2);
    const size_t hstep = (size_t)HALF * K * 2;
    const size_t tstep = 2 * hstep;
    const unsigned ldsw = (unsigned)wid * 1024u;
    const int aoff = lds_byte(wr * 64 + fr, fq * 8), boff = lds_byte(wc * 32 + fr, fq * 8);
#define PG8_SA(b, h) (((b) * 2 + (h)) * HTB)
#define PG8_SB(b, h) ((4 + (b) * 2 + (h)) * HTB)
#define PG8_STAGE(bufoff, gbase, voff) do { _Pragma("unroll") for (int _i = 0; _i < 2; ++_i) \
        __builtin_amdgcn_global_load_lds((const unsigned*)((const char*)(gbase) + (voff)[_i]), (PG8_LAS unsigned*)(lds + (bufoff) + ldsw + _i * 8192), 16, 0, 0); } while (0)
#define PG8_LDA(dst, b, h) do { _Pragma("unroll") for (int m = 0; m < 4; ++m) _Pragma("unroll") for (int k = 0; k < 2; ++k) dst[m][k] = *(const PG8_LAS bf16x8*)(lds + PG8_SA(b, h) + aoff + m * 2048 + k * 1024); } while (0)
#define PG8_LDB(dst, b, h) do { _Pragma("unroll") for (int n = 0; n < 2; ++n) _Pragma("unroll") for (int k = 0; k < 2; ++k) dst[n][k] = *(const PG8_LAS bf16x8*)(lds + PG8_SB(b, h) + boff + n * 2048 + k * 1024); } while (0)
#define PG8_MMA(ai, bj, At, Bt) do { __builtin_amdgcn_s_setprio(1); _Pragma("unroll") for (int m = 0; m < 4; ++m) _Pragma("unroll") for (int n = 0; n < 2; ++n) _Pragma("unroll") for (int k = 0; k < 2; ++k) \
        acc[ai][bj][m][n] = __builtin_amdgcn_mfma_f32_16x16x32_bf16(Bt[n][k], At[m][k], acc[ai][bj][m][n], 0, 0, 0); __builtin_amdgcn_s_setprio(0); } while (0)
#define PG8_WAIT_V(n) asm volatile("s_waitcnt vmcnt(" #n ")" ::: "memory")
#define PG8_WAIT_L(n) asm volatile("s_waitcnt lgkmcnt(" #n ")" ::: "memory")
#define PG8_BAR __builtin_amdgcn_s_barrier()
#define PG8_SCHED __builtin_amdgcn_sched_barrier(0)
    Unit cur, nxt; int ui = 0;
    if (!S.next(0, cur)) return;
    f32x4 acc[2][2][4][2];
#pragma unroll
    for (int a = 0; a < 2; ++a)
#pragma unroll
        for (int b = 0; b < 2; ++b)
#pragma unroll
            for (int m = 0; m < 4; ++m)
#pragma unroll
                for (int n = 0; n < 2; ++n) acc[a][b][m][n] = (f32x4){0.f, 0.f, 0.f, 0.f};
    bf16x8 At[4][2], B0[2][2], B1[2][2];
    const char* cA = (const char*)g.A + (size_t)cur.pm * tstep; const char* cB = (const char*)g.Bt + (size_t)cur.pn * tstep;
    S.a_ready(cur);
    if constexpr (SP2) {
        PG8_STAGE(PG8_SB(0, 0), cB, voffB); PG8_STAGE(PG8_SB(0, 1), cB + hstep, voffB); PG8_STAGE(PG8_SA(0, 0), cA, voffA); PG8_STAGE(PG8_SA(0, 1), cA + hstep, voffA);
        if (wr == 1) PG8_BAR;
        PG8_WAIT_V(2); PG8_BAR;
        PG8_STAGE(PG8_SB(1, 0), cB + kstep, voffB); PG8_STAGE(PG8_SA(1, 0), cA + kstep, voffA); PG8_STAGE(PG8_SB(1, 1), cB + hstep + kstep, voffB);
        PG8_WAIT_V(6); PG8_BAR;
    } else {
        PG8_STAGE(PG8_SB(0, 0), cB, voffB); PG8_STAGE(PG8_SA(0, 0), cA, voffA); PG8_STAGE(PG8_SB(0, 1), cB + hstep, voffB); PG8_STAGE(PG8_SA(0, 1), cA + hstep, voffA);
        if (wr == 1) PG8_BAR;
        PG8_WAIT_V(4); PG8_BAR;
        PG8_STAGE(PG8_SB(1, 0), cB + kstep, voffB); PG8_STAGE(PG8_SA(1, 0), cA + kstep, voffA); PG8_STAGE(PG8_SB(1, 1), cB + hstep + kstep, voffB);
        PG8_WAIT_V(6); PG8_BAR;
    }
    for (;;) {
        const bool has_next = S.next(ui + 1, nxt);
        const char* nA = has_next ? (const char*)g.A + (size_t)nxt.pm * tstep : cA; const char* nB = has_next ? (const char*)g.Bt + (size_t)nxt.pn * tstep : cB;
        for (int t = 0; t < nt; t += 2) {
            const bool last = (t == nt - 2);
            const char* a1 = cA + (size_t)(t + 1) * kstep;
            const char* a2 = last ? nA : cA + (size_t)(t + 2) * kstep; const char* b2 = last ? nB : cB + (size_t)(t + 2) * kstep;
            const char* a3 = a2 + kstep; const char* b3 = b2 + kstep;
            if (last && has_next) S.a_ready(nxt);
            if constexpr (SP2) {
            PG8_LDB(B0, 0, 0); PG8_LDB(B1, 0, 1); PG8_SCHED; PG8_LDA(At, 0, 0); PG8_STAGE(PG8_SA(1, 1), a1 + hstep, voffA);
            PG8_WAIT_V(8); PG8_WAIT_L(0); PG8_BAR; PG8_MMA(0, 0, At, B0); PG8_MMA(0, 1, At, B1); PG8_BAR; PG8_SCHED;
            PG8_LDA(At, 0, 1); PG8_STAGE(PG8_SB(0, 0), b2, voffB); PG8_STAGE(PG8_SB(0, 1), b2 + hstep, voffB); PG8_STAGE(PG8_SA(0, 0), a2, voffA);
            PG8_WAIT_V(8); PG8_WAIT_L(0); PG8_BAR; PG8_MMA(1, 0, At, B0); PG8_MMA(1, 1, At, B1); PG8_BAR; PG8_SCHED;
            PG8_LDB(B0, 1, 0); PG8_LDB(B1, 1, 1); PG8_SCHED; PG8_LDA(At, 1, 0); PG8_STAGE(PG8_SA(0, 1), a2 + hstep, voffA);
            PG8_WAIT_V(8); PG8_WAIT_L(0); PG8_BAR; PG8_MMA(0, 0, At, B0); PG8_MMA(0, 1, At, B1); PG8_BAR; PG8_SCHED;
            PG8_LDA(At, 1, 1); PG8_STAGE(PG8_SB(1, 0), b3, voffB); PG8_STAGE(PG8_SB(1, 1), b3 + hstep, voffB); PG8_STAGE(PG8_SA(1, 0), a3, voffA);
            PG8_WAIT_V(8); PG8_WAIT_L(0); PG8_BAR; PG8_MMA(1, 0, At, B0); PG8_MMA(1, 1, At, B1); PG8_BAR; PG8_SCHED;
            } else {
            PG8_LDB(B0, 0, 0); PG8_SCHED; PG8_LDA(At, 0, 0); PG8_STAGE(PG8_SA(1, 1), a1 + hstep, voffA);
            PG8_WAIT_L(8); PG8_BAR; PG8_WAIT_L(0); PG8_MMA(0, 0, At, B0); PG8_BAR; PG8_SCHED;
            PG8_LDB(B1, 0, 1); PG8_STAGE(PG8_SB(0, 0), b2, voffB);
            PG8_BAR; PG8_WAIT_L(0); PG8_MMA(0, 1, At, B1); PG8_BAR;
            PG8_LDA(At, 0, 1); PG8_STAGE(PG8_SA(0, 0), a2, voffA);
            PG8_BAR; PG8_WAIT_L(0); PG8_MMA(1, 0, At, B0); PG8_BAR; PG8_SCHED;
            PG8_STAGE(PG8_SB(0, 1), b2 + hstep, voffB);
            PG8_WAIT_V(6); PG8_BAR; PG8_MMA(1, 1, At, B1); PG8_BAR;
            PG8_LDB(B0, 1, 0); PG8_SCHED; PG8_LDA(At, 1, 0); PG8_STAGE(PG8_SA(0, 1), a2 + hstep, voffA);
            PG8_WAIT_L(8); PG8_BAR; PG8_WAIT_L(0); PG8_MMA(0, 0, At, B0); PG8_BAR; PG8_SCHED;
            PG8_LDB(B1, 1, 1); PG8_STAGE(PG8_SB(1, 0), b3, voffB);
            PG8_BAR; PG8_WAIT_L(0); PG8_MMA(0, 1, At, B1); PG8_BAR;
            PG8_LDA(At, 1, 1); PG8_STAGE(PG8_SA(1, 0), a3, voffA);
            PG8_BAR; PG8_WAIT_L(0); PG8_MMA(1, 0, At, B0); PG8_BAR; PG8_SCHED;
            PG8_STAGE(PG8_SB(1, 1), b3 + hstep, voffB);
            PG8_WAIT_V(6); PG8_BAR; PG8_MMA(1, 1, At, B1); PG8_BAR;
            }
        }
        if constexpr (ALIGN_EPI) { if (wr == 0) PG8_BAR; }
        if constexpr (!Epi::AFTER_DRAIN) { E(acc, cur, wr, wc, fr, fq); S.done(cur); }
        if (!has_next) break;
#pragma unroll
        for (int a = 0; a < 2; ++a)
#pragma unroll
            for (int b = 0; b < 2; ++b)
#pragma unroll
                for (int m = 0; m < 4; ++m)
#pragma unroll
                    for (int n = 0; n < 2; ++n) acc[a][b][m][n] = (f32x4){0.f, 0.f, 0.f, 0.f};
        cur = nxt; cA = nA; cB = nB; ++ui;
        if constexpr (ALIGN_EPI) { if (wr == 1) PG8_BAR; }
    }
    PG8_WAIT_V(0);
    if constexpr (!ALIGN_EPI) { if (wr == 0) PG8_BAR; }
    PG8_BAR;
    if constexpr (Epi::AFTER_DRAIN) { E.fused(acc, cur, wr, wc, fr, fq, lds, wid, lane); S.done(cur); }
#undef PG8_SA
#undef PG8_SB
#undef PG8_STAGE
#undef PG8_LDA
#undef PG8_LDB
#undef PG8_MMA
#undef PG8_WAIT_V
#undef PG8_WAIT_L
#undef PG8_BAR
#undef PG8_SCHED
}
}
#define GAS __attribute__((address_space(1)))
#define LAS __attribute__((address_space(3)))
typedef unsigned short bf16;
typedef unsigned v4u __attribute__((ext_vector_type(4)));
typedef float f32x4 __attribute__((ext_vector_type(4)));
typedef short bf16x8 __attribute__((ext_vector_type(8)));
typedef GAS unsigned gu32;
typedef GAS unsigned long long gu64;
#define RLX_AGENT __ATOMIC_RELAXED, __HIP_MEMORY_SCOPE_AGENT
#define LDS_WAIT() asm volatile("s_waitcnt lgkmcnt(0)" ::: "memory")
#define VM_WAIT() asm volatile("s_waitcnt vmcnt(0)" ::: "memory")
__device__ __forceinline__ unsigned long long rt() { return __builtin_amdgcn_s_memrealtime(); }
__device__ __forceinline__ unsigned f2bf(float f) { unsigned u = __builtin_bit_cast(unsigned, f); return (u + 0x7fffu + ((u >> 16) & 1u)) >> 16; }
__device__ __forceinline__ unsigned pk2(float lo, float hi) { return f2bf(lo) | (f2bf(hi) << 16); }

#define XB_TMO      128
#define XB_XCNT(j)  (256  + 64 * (j))
#define XB_XSUB(j)  (1280 + 64 * (j))
#define XB_XGEN(j)  (2304 + 64 * (j))
#define XB_TOP      3328
#define XB_TOPGEN   3392
#define XCD_BAR_WORDS 3456
#define XB_SPIN_CAP (1u << 18)

__device__ __forceinline__ unsigned xb_ld(unsigned* p)              { return __hip_atomic_load(p, __ATOMIC_RELAXED, __HIP_MEMORY_SCOPE_AGENT); }
__device__ __forceinline__ unsigned xb_add(unsigned* p, unsigned v) { return __hip_atomic_fetch_add(p, v, __ATOMIC_RELAXED, __HIP_MEMORY_SCOPE_AGENT); }
__device__ __forceinline__ unsigned xb_xcc_id() { return (unsigned)__builtin_amdgcn_s_getreg((3 << 11) | 20) & 0xFu; }
#define XB_SPIN(cond, bar) do { unsigned _sp = 0; while (cond) { __builtin_amdgcn_s_sleep(1); \
    if ((++_sp & 255u) == 0u) { if (xb_ld(&(bar)[XB_TMO])) break; if (_sp > XB_SPIN_CAP) { atomicAdd(&(bar)[XB_TMO], 1u); break; } } } } while (0)

struct XcdBarrier {
    unsigned* bar; unsigned x; bool t0;
    volatile LAS unsigned* st;
};

__device__ __forceinline__ XcdBarrier xcd_barrier_post(unsigned* bar, volatile LAS unsigned* st, bool t0) {
    XcdBarrier b; b.bar = bar; b.x = xb_xcc_id(); b.st = st; b.t0 = t0;
    if (b.t0) (void)xb_add(&bar[XB_XCNT(b.x)], 1u);
    return b;
}
__device__ __forceinline__ void xcd_barrier_complete(unsigned* bar, unsigned x, unsigned& nloc, unsigned& nx) {
    const unsigned G = gridDim.x * gridDim.y * gridDim.z;
    unsigned sum, cnt, mine, sp = 0u;
    for (;;) {
        sum = 0u; cnt = 0u; mine = 0u;
#pragma unroll
        for (unsigned j = 0; j < 16; ++j) { const unsigned c = xb_ld(&bar[XB_XCNT(j)]); sum += c; cnt += (c > 0u) ? 1u : 0u; mine = (j == x) ? c : mine; }
        if (sum == G) break;
        __builtin_amdgcn_s_sleep(1);
        if ((++sp & 255u) == 0u) { if (xb_ld(&bar[XB_TMO])) break; if (sp > XB_SPIN_CAP) { atomicAdd(&bar[XB_TMO], 1u); break; } }
    }
    nloc = mine > 0u ? mine : 1u; nx = cnt > 0u ? cnt : 1u;
}

__device__ __forceinline__ void xcd_barrier(const XcdBarrier& b) {
    asm volatile("s_waitcnt vmcnt(0)" ::: "memory");
    __syncthreads();
    if (b.t0) {
        unsigned* bar = b.bar;
        __builtin_amdgcn_s_waitcnt(0);
        unsigned nloc = b.st[0], nx = b.st[1];
        if (nloc == 0u) { xcd_barrier_complete(bar, b.x, nloc, nx); b.st[0] = nloc; b.st[1] = nx; }
        const unsigned old = xb_add(&bar[XB_XSUB(b.x)], 1u);
        const unsigned gen = old / nloc;
        if (old + 1u == (gen + 1u) * nloc) {
            __builtin_amdgcn_fence(__ATOMIC_RELEASE, "agent");
            asm volatile("s_waitcnt vmcnt(0)" ::: "memory");
            const unsigned og = xb_add(&bar[XB_TOP], 1u);
            const unsigned tg = og / nx;
            if (og + 1u == (tg + 1u) * nx) xb_add(&bar[XB_TOPGEN], 1u);
            else XB_SPIN(xb_ld(&bar[XB_TOPGEN]) == tg, bar);
            __builtin_amdgcn_fence(__ATOMIC_ACQUIRE, "agent");
            xb_add(&bar[XB_XGEN(b.x)], 1u);
            asm volatile("s_waitcnt vmcnt(0)" ::: "memory");
        } else {
            XB_SPIN(xb_ld(&bar[XB_XGEN(b.x)]) == gen, bar);
            __builtin_amdgcn_fence(__ATOMIC_ACQUIRE, "agent");
            asm volatile("s_waitcnt vmcnt(0)" ::: "memory");
        }
    }
    __syncthreads();
}

constexpr int NWAVES = 8;
constexpr int DM = 1024, NB = 16, SEQ = 4096, CTXL = 256, NH = 8, HD = 64;
constexpr int ML = NB * SEQ;
constexpr int MC = NB * CTXL;
constexpr int MT = ML + MC;
constexpr int PW = 3840;
constexpr int PCW = 1792;
constexpr int PC_NAK = 0, PC_RWK = 512, PC_RWV = 1024, PC_WD = 1536, PC_AD = 1664, PC_RWR = 1792, PC_NAQ = 2304, PC_NAG = 2816, PC_RWG = 3328;
constexpr float RMS_EPS = 1e-6f, GN_EPS = 64e-5f;
constexpr float LOG2E = 1.4426950408889634f;

constexpr size_t MiB = 1u << 20;
constexpr size_t WS_CTL = 0, CTL_ZERO_BYTES = 1 * MiB;
constexpr size_t WS_MOD = 256 * 1024;
constexpr size_t WS_SUMSQ = 512 * 1024;
constexpr size_t WS_WOUT = 2 * MiB;
constexpr size_t WS_WIN = 4 * MiB;
constexpr size_t WS_BONUS = 16 * MiB;
constexpr size_t WS_EDGE = 24 * MiB;
constexpr size_t WS_XN = 32 * MiB;
constexpr size_t WS_P = 168 * MiB;
constexpr size_t WS_VT = 678 * MiB;
constexpr int VTP = MT + 64;
constexpr size_t WS_MIX = 747 * MiB;
constexpr size_t WS_Y = 876 * MiB;
constexpr size_t WS_LFR = 1004 * MiB;
constexpr size_t WS_END = 1012 * MiB;
static_assert(WS_WIN + (size_t)4352 * 1024 * 2 <= WS_BONUS && WS_BONUS + (size_t)ML * 16 * 4 <= WS_XN && WS_XN + (size_t)MT * 1024 * 2 <= WS_P && WS_P + (size_t)MT * PW * 2 <= WS_VT && WS_VT + (size_t)512 * VTP * 2 <= WS_MIX && WS_MIX + (size_t)ML * 1024 * 2 <= WS_END, "ws map");
constexpr int CW_BAR = 4096;

constexpr int LDS_BYTES = 160 * 1024;
constexpr int MISC_OFF = LDS_BYTES - 256;

__device__ __forceinline__ int lane_id_() { int l; asm volatile("v_mbcnt_lo_u32_b32 %0, -1, 0\n\tv_mbcnt_hi_u32_b32 %0, -1, %0" : "=v"(l)); return l; }
struct Frame {
    LAS unsigned char* lds;
    int wave, vcu, G;
    const float *x, *c, *ctx, *c_ctx, *w_mod, *b_mod, *norm_g, *w_in, *conv_w, *decay_w0, *decay_w2, *aaa_a0, *aaa_a2, *k_k, *k_a, *r_k, *gn_w, *gn_b, *na_rpb, *w_out, *final_g;
    float* out; unsigned char* ws;
    float *mod, *sumsq, *bonus;
    bf16 *WoutT, *WinT, *XN, *P, *VT, *MIX, *Y;
};

__device__ __forceinline__ float wave_sum(float v) {
#pragma unroll
    for (int o = 1; o < 64; o <<= 1) v += __shfl_xor(v, o);
    return v;
}
__device__ __forceinline__ float bf2f(unsigned h) { return __uint_as_float(h << 16); }
__device__ __forceinline__ float sigmoidf_(float x) { return __builtin_amdgcn_rcpf(1.f + __builtin_amdgcn_exp2f(-1.4426950408889634f * x)); }
__device__ __forceinline__ float siluf_(float x) { return x * __builtin_amdgcn_rcpf(1.f + __builtin_amdgcn_exp2f(-1.4426950408889634f * x)); }
typedef float f32x16 __attribute__((ext_vector_type(16)));
typedef unsigned u32x2 __attribute__((ext_vector_type(2)));
typedef float f32x2_t __attribute__((ext_vector_type(2))); typedef __bf16 bf16x2_t __attribute__((ext_vector_type(2)));
__device__ __forceinline__ unsigned cvtpk(float lo, float hi) { f32x2_t v = {lo, hi}; bf16x2_t b = __builtin_convertvector(v, bf16x2_t); return __builtin_bit_cast(unsigned, b); }
__device__ __forceinline__ u32x2 pk4(float a, float b, float c, float d) { u32x2 r; r.x = cvtpk(a, b); r.y = cvtpk(c, d); return r; }
template <int CTRL> __device__ __forceinline__ float dpp_mov(float x) { return __builtin_bit_cast(float, __builtin_amdgcn_update_dpp(0, __builtin_bit_cast(int, x), CTRL, 0xf, 0xf, true)); }
__device__ __forceinline__ float red8(float x) { x += dpp_mov<0xB1>(x); x += dpp_mov<0x4E>(x); x += dpp_mov<0x141>(x); return x; }
__device__ __forceinline__ float red16(float x) { x = red8(x); x += dpp_mov<0x140>(x); return x; }
__device__ __forceinline__ float sum32x(float x) { auto rr = __builtin_amdgcn_permlane32_swap(__float_as_uint(x), __float_as_uint(x), false, false); return __uint_as_float(rr[0]) + __uint_as_float(rr[1]); }
__device__ __forceinline__ float max32x(float x) { auto rr = __builtin_amdgcn_permlane32_swap(__float_as_uint(x), __float_as_uint(x), false, false); return fmaxf(__uint_as_float(rr[0]), __uint_as_float(rr[1])); }
__device__ __forceinline__ float sum16x(float x) { auto rr = __builtin_amdgcn_permlane16_swap(__float_as_uint(x), __float_as_uint(x), false, false); return __uint_as_float(rr[0]) + __uint_as_float(rr[1]); }
__device__ __forceinline__ float xlane32(float x, int hh) { auto rr = __builtin_amdgcn_permlane32_swap(__float_as_uint(x), __float_as_uint(x), false, false); return __uint_as_float(hh ? rr[0] : rr[1]); }
__device__ __forceinline__ float xlane16(float x, int godd) { auto rr = __builtin_amdgcn_permlane16_swap(__float_as_uint(x), __float_as_uint(x), false, false); return __uint_as_float(godd ? rr[0] : rr[1]); }

__device__ __forceinline__ void p0_transpose_item(const float* W, int K, int N, bf16* WT, int k0, int n0, int drow0, LAS float* scr, int lane) {
#pragma unroll 8
    for (int i = 0; i < 32; ++i) { const int kk = 2 * i + (lane >> 5); scr[kk * 33 + (lane & 31)] = W[(size_t)(k0 + kk) * N + n0 + (lane & 31)]; }
    LDS_WAIT(); asm volatile("" ::: "memory");
    const int c = lane & 7;
#pragma unroll
    for (int j = 0; j < 4; ++j) { const int n = (lane >> 3) + 8 * j; const LAS float* s = scr + (8 * c) * 33 + n;
        v4u o; o.x = pk2(s[0 * 33], s[1 * 33]); o.y = pk2(s[2 * 33], s[3 * 33]); o.z = pk2(s[4 * 33], s[5 * 33]); o.w = pk2(s[6 * 33], s[7 * 33]);
        *(GAS v4u*)(WT + (size_t)(drow0 + n) * K + k0 + 8 * c) = o; }
    LDS_WAIT(); asm volatile("" ::: "memory");
}
__device__ __forceinline__ void p0_prologue(Frame& F) {
    LAS float* scr = (LAS float*)(F.lds + F.wave * 16384);
    const int gw = F.vcu * NWAVES + F.wave, NGW = F.G * NWAVES, lane = lane_id_();
    for (int it = gw; it < 48 * 32; it += NGW) {
        const int cc = it % 48, ks = it / 48, n = cc * 64 + lane, k0 = ks * 32;
        for (int e = lane; e < 17 * 32; e += 64) { const int row = e >> 5, kk = e & 31; const float cv = (row < 16) ? F.c[row * 1024 + k0 + kk] : F.c_ctx[k0 + kk]; scr[e] = siluf_(cv); }
        LDS_WAIT(); asm volatile("" ::: "memory");
        float acc[17];
#pragma unroll
        for (int r = 0; r < 17; ++r) acc[r] = 0.f;
        for (int kk = 0; kk < 32; ++kk) { const float w = F.w_mod[(size_t)(k0 + kk) * 3072 + n];
#pragma unroll
            for (int r = 0; r < 17; ++r) acc[r] += scr[r * 32 + kk] * w; }
        if (ks == 0) { const float bb = F.b_mod[n];
#pragma unroll
            for (int r = 0; r < 17; ++r) acc[r] += bb; }
#pragma unroll
        for (int r = 0; r < 17; ++r) atomicAdd(F.mod + r * 3072 + n, acc[r]);
        LDS_WAIT(); asm volatile("" ::: "memory");
    }
    constexpr int I_IN = 16 * 136, I_OUT = 16 * 32;
    for (int it = gw; it < I_IN + I_OUT; it += NGW) {
        if (it < I_IN) { const int kb = it / 136, nb = it % 136, n0 = nb * 32; const int drow0 = (n0 < 512) ? n0 : (n0 < 1024 ? n0 + 3328 : n0 - 512);
            p0_transpose_item(F.w_in, 1024, 4352, F.WinT, kb * 64, n0, drow0, scr, lane); }
        else { const int r = it - I_IN, kb = r / 32, nb = r % 32; p0_transpose_item(F.w_out, 1024, 1024, F.WoutT, kb * 64, nb * 32, nb * 32, scr, lane); }
    }
}

__device__ __forceinline__ void p1_xn(Frame& F) {
    const int gw = F.vcu * NWAVES + F.wave, NGW = F.G * NWAVES, lane = lane_id_();
    f32x4 g[4];
#pragma unroll
    for (int j = 0; j < 4; ++j) g[j] = *(const f32x4*)(F.norm_g + 4 * (lane + 64 * j));
    for (int bb = 0; bb < 17; ++bb) {
        const float* md = F.mod + bb * 3072;
        f32x4 sh[4], sc[4];
#pragma unroll
        for (int j = 0; j < 4; ++j) { sh[j] = *(const f32x4*)(md + 4 * (lane + 64 * j)); sc[j] = *(const f32x4*)(md + 1024 + 4 * (lane + 64 * j)) + 1.0f; }
        for (int r0 = 2 * gw; r0 < 4096; r0 += 2 * NGW) {
            const size_t m0 = (size_t)bb * 4096 + r0;
            const float* xbase = (bb < 16) ? F.x + m0 * DM : F.ctx + (size_t)r0 * DM;
            f32x4 v[2][4]; float ss[2] = {0.f, 0.f};
#pragma unroll
            for (int u = 0; u < 2; ++u)
#pragma unroll
                for (int j = 0; j < 4; ++j) v[u][j] = *((const GAS f32x4*)(xbase + (size_t)u * DM) + lane + 64 * j);
#pragma unroll
            for (int u = 0; u < 2; ++u) {
#pragma unroll
                for (int j = 0; j < 4; ++j) ss[u] += (v[u][j].x * v[u][j].x + v[u][j].y * v[u][j].y) + (v[u][j].z * v[u][j].z + v[u][j].w * v[u][j].w);
                ss[u] = sum32x(sum16x(red16(ss[u])));
            }
#pragma unroll
            for (int u = 0; u < 2; ++u) {
                const float rstd = rsqrtf(ss[u] * (1.f / DM) + RMS_EPS);
                GAS unsigned long long* o8 = (GAS unsigned long long*)(F.XN + (m0 + u) * DM) + lane;
#pragma unroll
                for (int j = 0; j < 4; ++j) {
                    const f32x4 y = (v[u][j] * rstd * g[j]) * sc[j] + sh[j];
                    o8[64 * j] = (unsigned long long)cvtpk(y.x, y.y) | ((unsigned long long)cvtpk(y.z, y.w) << 32);
                }
            }
        }
    }
}

template <int V> struct ICst { static constexpr int value = V; };
constexpr int AT_SLOT = 18432, AT_VOFF = 9216, AT_NSLOT = 7, AT_WS = AT_NSLOT * AT_SLOT, AT_ROW = 72;
static_assert(AT_WS + 8 * 4096 <= MISC_OFF, "attention LDS map");
__device__ __forceinline__ void p3_attention(Frame& F) {
    LAS unsigned char* L = F.lds;
    LAS float* wsf = (LAS float*)(L + AT_WS + F.wave * 4096);
    LAS float* bt = wsf + 192;
    const int wave = F.wave, lane = lane_id_(), tid = wave * 64 + lane, q = lane & 31, hh = lane >> 5;
    const int ldk = tid >> 3, ldc = tid & 7;
    const float C2 = 0.125f * LOG2E;
    for (int bu = F.vcu * 8; bu < NB * NH * 16; bu += F.G * 8) {
        const int h = (bu >> 4) & 7, b = bu >> 7;
        for (int e = lane_id_(); e < 15 * 31; e += 64) bt[e] = F.na_rpb[h * 465 + e] * LOG2E;
        bf16x8 qf[4];
        for (int uu = 0; uu < 8; ++uu) {
            const int band = (bu + uu) & 15, i0 = 4 * band, i = i0 + (wave >> 1), J = wave & 1;
            const int r0 = min(max(i - 4, 0), 56), rmin = min(max(i0 - 4, 0), 56), dl = r0 - rmin;
            const int qc = 32 * J + q, c0 = min(max(qc - 8, 0), 48);
            const size_t qrow = (size_t)(b * SEQ + i * 64 + qc);
            if (uu == 0) {
#pragma unroll
                for (int s = 0; s < 4; ++s) qf[s] = *(const bf16x8*)(F.P + qrow * PW + PC_NAQ + h * 64 + 16 * s + 8 * hh);
            }
            float m_run = -1e30f, l_run = 0.f;
            f32x16 o0, o1;
#pragma unroll
            for (int r = 0; r < 16; ++r) { o0[r] = 0.f; o1[r] = 0.f; }
            const bf16* kgl = F.P + PC_NAK + h * 64 + 8 * ldc;
            const bf16* vgl = F.VT + (size_t)(h * 64 + ldk) * VTP + 8 * ldc;
            if (uu == 0) {
                const size_t tb0 = (size_t)ML + (size_t)b * CTXL;
                const v4u kr = *(const GAS v4u*)(kgl + (tb0 + ldk) * PW), vr = *(const GAS v4u*)(vgl + tb0);
                *(LAS v4u*)(L + 5 * AT_SLOT + (ldk * AT_ROW + 8 * ldc) * 2) = kr; *(LAS v4u*)(L + 5 * AT_SLOT + AT_VOFF + (ldk * AT_ROW + 8 * ldc) * 2) = vr;
            }
            asm volatile("" : "+v"(qf[0]), "+v"(qf[1]), "+v"(qf[2]), "+v"(qf[3]));
            if (uu == 0) __syncthreads();
            for (int ph = 0; ph < 8; ++ph) {
                v4u kreg[2], vreg[2]; int nslot[2]; bool nval[2];
#pragma unroll
                for (int x = 0; x < 2; ++x) {
                    const unsigned ktab = x == 0 ? 0xF9753FFFu : 0xFA864210u;
                    const int k = (int)((ktab >> (4 * ph)) & 15u), chunk = (ph + 1) & 7;
                    const bool cload = x == 0 && (ph < 3 || (ph == 7 && uu < 7));
                    const bool lload = k != 15 && rmin + k < 64;
                    nval[x] = cload || lload;
                    nslot[x] = cload ? 5 + (chunk & 1) : (k < 7 ? k : k - 7);
                    const size_t tb = cload ? (size_t)ML + (size_t)b * CTXL + 64 * chunk : (size_t)b * SEQ + 64 * (rmin + (k & 15));
                    if (nval[x]) { kreg[x] = *(const GAS v4u*)(kgl + (tb + ldk) * PW); vreg[x] = *(const GAS v4u*)(vgl + tb); }
                }
                const int p = ph - 4;
                auto phase_body = [&](auto Jc, auto Cc) __attribute__((always_inline)) {
                    constexpr int JC = decltype(Jc)::value; constexpr bool isctx = decltype(Cc)::value != 0;
                    constexpr int TD = JC ? 0 : 2, RD = JC ? 0 : 4;
#define AT_DEAD(tile, r) (!isctx && (tile) == TD && ((r) & 4) == RD)
                    const int ka = dl + 2 * p;
                    const int sA = isctx ? 5 + (ph & 1) : ka % 7, sB = isctx ? sA : (ka + 1) % 7;
                    constexpr int ntile = isctx ? 2 : 3;
                    f32x16 scs[3];
                    {
                        bf16x8 kf[3][4];
#pragma unroll
                        for (int tile = 0; tile < 3; ++tile) {
                            if (tile >= ntile) break;
                            const int cb = J + tile;
                            const LAS bf16* kp = isctx ? (const LAS bf16*)(L + sA * AT_SLOT) + (32 * tile + q) * AT_ROW + 8 * hh
                                                       : (const LAS bf16*)(L + ((q >> 4) ? sB : sA) * AT_SLOT) + (16 * cb + (q & 15)) * AT_ROW + 8 * hh;
#pragma unroll
                            for (int s = 0; s < 4; ++s) kf[tile][s] = *(const LAS bf16x8*)(kp + 16 * s);
                        }
                        __builtin_amdgcn_sched_barrier(0);
#pragma unroll
                        for (int tile = 0; tile < 3; ++tile) {
                            if (tile >= ntile) break;
#pragma unroll
                            for (int r = 0; r < 16; ++r) scs[tile][r] = 0.f;
#pragma unroll
                            for (int s = 0; s < 4; ++s) scs[tile] = __builtin_amdgcn_mfma_f32_32x32x16_bf16(kf[tile][s], qf[s], scs[tile], 0, 0, 0);
                        }
                    }
                    if (ph == 7 && uu < 7) {
                        const size_t qrow_n = (size_t)(b * SEQ + (i + 4) * 64 + qc);
#pragma unroll
                        for (int s = 0; s < 4; ++s) qf[s] = *(const bf16x8*)(F.P + qrow_n * PW + PC_NAQ + h * 64 + 16 * s + 8 * hh);
                    }
                    float tmax = -1e30f;
                    if (isctx) {
#pragma unroll
                        for (int tile = 0; tile < 2; ++tile)
#pragma unroll
                            for (int r = 0; r < 16; ++r) { scs[tile][r] *= C2; tmax = fmaxf(tmax, scs[tile][r]); }
                    } else {
                        float bvv[3][2][8];
#pragma unroll
                        for (int tile = 0; tile < 3; ++tile) {
                            const LAS float* bp = bt + (rmin + ka - i + 7) * 31 + 16 * (J + tile) - qc + 15 + 4 * hh;
#pragma unroll
                            for (int hf = 0; hf < 2; ++hf)
#pragma unroll
                                for (int r = 0; r < 8; ++r) bvv[tile][hf][r] = AT_DEAD(tile, r) ? 0.f : bp[31 * hf + (r & 3) + 8 * ((r >> 2) & 1)];
                        }
#pragma unroll
                        for (int tile = 0; tile < 3; ++tile)
#pragma unroll
                            for (int hf = 0; hf < 2; ++hf) {
                                if (tile != TD) asm volatile("" : "+v"(bvv[tile][hf][0]), "+v"(bvv[tile][hf][1]), "+v"(bvv[tile][hf][2]), "+v"(bvv[tile][hf][3]), "+v"(bvv[tile][hf][4]), "+v"(bvv[tile][hf][5]), "+v"(bvv[tile][hf][6]), "+v"(bvv[tile][hf][7]));
                                else asm volatile("" : "+v"(bvv[tile][hf][4 - RD]), "+v"(bvv[tile][hf][5 - RD]), "+v"(bvv[tile][hf][6 - RD]), "+v"(bvv[tile][hf][7 - RD]));
                            }
#pragma unroll
                        for (int tile = 0; tile < 3; ++tile) {
                            const int t0 = 16 * (J + tile) - c0 + 4 * hh;
#pragma unroll
                            for (int hf = 0; hf < 2; ++hf)
#pragma unroll
                                for (int r = 0; r < 8; ++r) {
                                    if (AT_DEAD(tile, r)) continue;
                                    const int co = (r & 3) + 8 * ((r >> 2) & 1);
                                    const bool valid = (unsigned)(t0 + co) < 16u;
                                    const float val = valid ? scs[tile][8 * hf + r] * C2 + bvv[tile][hf][r] : -1e30f;
                                    scs[tile][8 * hf + r] = val; tmax = fmaxf(tmax, val);
                                }
                        }
                    }
                    tmax = max32x(tmax);
                    {
                        if (__builtin_amdgcn_ballot_w64(tmax - m_run > 6.f) != 0ull) {
                            const float m_new = fmaxf(m_run, tmax), alpha = __builtin_amdgcn_exp2f(m_run - m_new);
                            m_run = m_new; l_run *= alpha;
#pragma unroll
                            for (int r = 0; r < 16; ++r) { o0[r] *= alpha; o1[r] *= alpha; }
                        }
                    }
#pragma unroll
                    for (int tile = 0; tile < 3; ++tile) {
                        if (tile >= ntile) break;
                        const int cb = J + tile;
                        bf16x8 vf[2][2];
#pragma unroll
                        for (int db = 0; db < 2; ++db)
#pragma unroll
                            for (int s = 0; s < 2; ++s) {
                                const LAS bf16* vp = isctx ? (const LAS bf16*)(L + sA * AT_SLOT + AT_VOFF) + (32 * db + q) * AT_ROW + 32 * tile + 16 * s + 4 * hh
                                                           : (const LAS bf16*)(L + (s ? sB : sA) * AT_SLOT + AT_VOFF) + (32 * db + q) * AT_ROW + 16 * cb + 4 * hh;
                                const u32x2 lo = *(const LAS u32x2*)vp, hi = *(const LAS u32x2*)(vp + 8);
                                v4u w; w.x = lo.x; w.y = lo.y; w.z = hi.x; w.w = hi.y;
                                vf[db][s] = __builtin_bit_cast(bf16x8, w);
                            }
                        float psum = 0.f; f32x16 sc;
#pragma unroll
                        for (int r = 0; r < 16; ++r) { if (AT_DEAD(tile, r)) { sc[r] = 0.f; continue; } sc[r] = __builtin_amdgcn_exp2f(scs[tile][r] - m_run); psum += sc[r]; }
                        l_run += psum;
                        bf16x8 pa[2];
#pragma unroll
                        for (int s = 0; s < 2; ++s) { v4u w; w.x = cvtpk(sc[8 * s + 0], sc[8 * s + 1]); w.y = cvtpk(sc[8 * s + 2], sc[8 * s + 3]); w.z = cvtpk(sc[8 * s + 4], sc[8 * s + 5]); w.w = cvtpk(sc[8 * s + 6], sc[8 * s + 7]); pa[s] = __builtin_bit_cast(bf16x8, w); }
#pragma unroll
                        for (int s = 0; s < 2; ++s) { o0 = __builtin_amdgcn_mfma_f32_32x32x16_bf16(vf[0][s], pa[s], o0, 0, 0, 0); o1 = __builtin_amdgcn_mfma_f32_32x32x16_bf16(vf[1][s], pa[s], o1, 0, 0, 0); }
                    }
                };
#undef AT_DEAD
                if (ph < 4) phase_body(ICst<0>{}, ICst<1>{}); else if (J == 0) phase_body(ICst<0>{}, ICst<0>{}); else phase_body(ICst<1>{}, ICst<0>{});
#pragma unroll
                for (int x = 0; x < 2; ++x) if (nval[x]) {
                    *(LAS v4u*)(L + nslot[x] * AT_SLOT + (ldk * AT_ROW + 8 * ldc) * 2) = kreg[x]; *(LAS v4u*)(L + nslot[x] * AT_SLOT + AT_VOFF + (ldk * AT_ROW + 8 * ldc) * 2) = vreg[x]; }
                __syncthreads();
            }
            const float inv = 1.f / sum32x(l_run);
            {
                const size_t tq = (size_t)(b * SEQ + i * 64 + 32 * J + q);
                const bf16* gp = F.P + tq * PW + PC_NAG + h * 64; bf16* mp = F.MIX + tq * DM + h * 64;
#pragma unroll
                for (int db = 0; db < 2; ++db)
#pragma unroll
                    for (int gg = 0; gg < 4; ++gg) {
                        const int d0 = 32 * db + 8 * gg + 4 * hh;
                        const u32x2 gv = *(const GAS u32x2*)(gp + d0);
                        float o[4];
#pragma unroll
                        for (int e = 0; e < 4; ++e) { const float g = (e & 1) ? __uint_as_float((e < 2 ? gv.x : gv.y) & 0xffff0000u) : __uint_as_float((e < 2 ? gv.x : gv.y) << 16);
                            o[e] = (db ? o1[4 * gg + e] : o0[4 * gg + e]) * inv * siluf_(g); }
                        *(GAS u32x2*)(mp + d0) = pk4(o[0], o[1], o[2], o[3]);
                    }
            }
            LDS_WAIT(); asm volatile("" ::: "memory");
        }
    }
}

constexpr int SX_KC = 0, SX_VC = 16384, SX_RC = 24576, SX_TW = 32768, SX_AD = 41984, SX_INVN = 51200;
constexpr int SX_NBAT = 0, SX_NKA = 8192, SX_QBRT = 13312, SX_QKRT = 18432, SX_TT = 27648, SX_G = 32768, SX_M = 43008, SX_E1T = 48128, SX_ZT = 57344;
constexpr int SY0 = 62464, SY_AB = SY0, SY_BB = SY0 + 9216, SY_KB = SY0 + 18432, SY_RB = SY0 + 27648, SY_PCT = SY0;
constexpr int SZ0 = 99328, SZ_ABT = SZ0, SZ_BCT = SZ0 + 10240, SZ_KCT = SZ0 + 20480, SZ_VT = SZ0 + 30720, SZ_DCT = SZ0;
constexpr int SS_ST = 140288  , SM_GC = 158720, SM_BON = SM_GC + 512, SCAN_LDS_END = SM_BON + 256;
constexpr int SC_CW = SCAN_LDS_END;
constexpr int SC_RAW = 52224;
static_assert(SC_CW + 4096 <= MISC_OFF, "scan LDS map");
constexpr int TS = 72, CS = 40;

template <int NK> __device__ __forceinline__ f32x16 tile_mm(const LAS bf16* xrow, const LAS bf16* yrow) {
    f32x16 acc;
#pragma unroll
    for (int r = 0; r < 16; ++r) acc[r] = 0.f;
#pragma unroll
    for (int s = 0; s < NK; ++s) acc = __builtin_amdgcn_mfma_f32_32x32x16_bf16(*(const LAS bf16x8*)(xrow + 16 * s), *(const LAS bf16x8*)(yrow + 16 * s), acc, 0, 0, 0);
    return acc;
}

typedef short bf16x4 __attribute__((ext_vector_type(4)));

template <bool ISP> __device__ __forceinline__ void f_tile(const LAS bf16* X, const LAS bf16* Y, const LAS bf16* Bp, LAS bf16* Op, const float gcv, const int dj, const int hh) {
    bf16x4 bvv[4];
    if (!ISP) {
#pragma unroll
        for (int gg = 0; gg < 4; ++gg) bvv[gg] = *(const LAS bf16x4*)(Bp + 8 * gg);
    }
    const f32x16 acc = tile_mm<2>(X, Y);
#pragma unroll
    for (int gg = 0; gg < 4; ++gg) {
        const int r0 = 8 * gg + 4 * hh;
        float o[4];
#pragma unroll
        for (int e = 0; e < 4; ++e) { const float base = ISP ? ((r0 + e) == dj ? gcv : 0.f) : bf2f((unsigned short)bvv[gg][e]); o[e] = base - acc[4 * gg + e]; }
        *(LAS u32x2*)(Op + r0) = pk4(o[0], o[1], o[2], o[3]);
    }
}
__device__ __forceinline__ v4u patch8(const v4u c, const v4u e, const LAS float* w) {
    const f32x4 wa = *(const LAS f32x4*)w, wb = *(const LAS f32x4*)(w + 4);
    v4u o;
#pragma unroll
    for (int e2 = 0; e2 < 4; ++e2) {
        const float wl = e2 < 2 ? wa[2 * e2] : wb[2 * e2 - 4], wh = e2 < 2 ? wa[2 * e2 + 1] : wb[2 * e2 - 3];
        o[e2] = cvtpk(__uint_as_float(c[e2] << 16) + wl * __uint_as_float(e[e2] << 16), __uint_as_float(c[e2] & 0xffff0000u) + wh * __uint_as_float(e[e2] & 0xffff0000u));
    }
    return o;
}
__device__ __forceinline__ void scan_a2(LAS unsigned char* L, const int wave, const int d, const bool lat_, const int p0_, v4u c0, v4u c1, v4u c2, v4u c3, v4u c4, const v4u prh) {
    const int lane_ = lane_id_(); const int tt = 8 * wave + (lane_ >> 3), nn = lane_ & 7;
    LAS float* KC = (LAS float*)(L + SX_KC); LAS bf16* VC = (LAS bf16*)(L + SX_VC); LAS bf16* RC = (LAS bf16*)(L + SX_RC);
    LAS bf16* TW = (LAS bf16*)(L + SX_TW); LAS bf16* AD = (LAS bf16*)(L + SX_AD); LAS float* INVN = (LAS float*)(L + SX_INVN); LAS float* BON = (LAS float*)(L + SM_BON);
    const LAS float* CW = (const LAS float*)(L + SC_CW);
    if ((wave == 0 || wave == 7) && lat_) {
        const int ttp = wave ? 63 : 0, idxp = d ? (SEQ - 1 - p0_ - ttp) : p0_ + ttp, em = idxp & 255;
        const bool np = em == 0 && idxp > 0, nx = em == 255 && idxp < SEQ - 1;
        if (np || nx) {
            LAS bf16* PT = (LAS bf16*)(L + SC_RAW) + (wave ? 320 : 0);
            if (lane_ < 40) *(LAS v4u*)(PT + lane_ * 8) = prh;
            asm volatile("s_waitcnt lgkmcnt(0)" ::: "memory");
            if (tt == ttp) {
                const LAS float* cw = CW + (np ? 0 : 640) + 8 * nn;
                c0 = patch8(c0, *(const LAS v4u*)(PT + 0 * 64 + 8 * nn), cw + 0 * 64); c1 = patch8(c1, *(const LAS v4u*)(PT + 1 * 64 + 8 * nn), cw + 1 * 64); c2 = patch8(c2, *(const LAS v4u*)(PT + 2 * 64 + 8 * nn), cw + 2 * 64);
                c3 = patch8(c3, *(const LAS v4u*)(PT + 3 * 64 + 8 * nn), cw + 3 * 64); c4 = patch8(c4, *(const LAS v4u*)(PT + 4 * 64 + 8 * nn), cw + 4 * 64);
            }
        }
    }
    {
        const f32x4 ka = *(const LAS f32x4*)(CW + 960 + 8 * nn), kb = *(const LAS f32x4*)(CW + 960 + 8 * nn + 4);
        float u[8]; float ss = 0.f;
#pragma unroll
        for (int e2 = 0; e2 < 4; ++e2) { u[2 * e2] = __uint_as_float(c0[e2] << 16); u[2 * e2 + 1] = __uint_as_float(c0[e2] & 0xffff0000u); }
#pragma unroll
        for (int e = 0; e < 8; ++e) { const float kq = u[e] * (e < 4 ? ka[e] : kb[e - 4]); ss += kq * kq; }
        *(LAS f32x4*)(KC + tt * 64 + 8 * nn) = (f32x4){u[0], u[1], u[2], u[3]}; *(LAS f32x4*)(KC + tt * 64 + 8 * nn + 4) = (f32x4){u[4], u[5], u[6], u[7]};
        ss = red8(ss);
        if (nn == 0) INVN[tt] = rsqrtf(fmaxf(ss, 1e-24f));
    }
    *(LAS v4u*)(VC + tt * 64 + 8 * nn) = c1;
    *(LAS v4u*)(RC + tt * 64 + 8 * nn) = c2;
    if (wave == 0 || wave == 7) {
        const int pos_ = p0_ + tt, idx_ = d ? ((lat_ ? SEQ : CTXL) - 1 - pos_) : pos_, em = idx_ & 255;
        if (em == 0 || em == 255) {
#pragma unroll
            for (int e2 = 0; e2 < 4; ++e2) {
                const float ta = __builtin_amdgcn_exp2f(__uint_as_float(c3[e2] << 16) * (2.f * LOG2E)), tb = __builtin_amdgcn_exp2f(__uint_as_float(c3[e2] & 0xffff0000u) * (2.f * LOG2E));
                c3[e2] = cvtpk(1.f - 2.f * __builtin_amdgcn_rcpf(ta + 1.f), 1.f - 2.f * __builtin_amdgcn_rcpf(tb + 1.f));
            }
        }
    }
    *(LAS v4u*)(TW + tt * TS + 8 * nn) = c3;
    *(LAS v4u*)(AD + tt * TS + 8 * nn) = c4;
}
__device__ __forceinline__ void p4_scan(Frame& F) {
    if (F.vcu >= NB * NH * 2) return;
    const int chain = F.vcu, d = chain & 1, h = (chain >> 1) & 7, b = chain >> 4;
    const int wave = F.wave, lane = lane_id_(), tid = wave * 64 + lane;
    LAS unsigned char* L = F.lds;
    LAS float* KC = (LAS float*)(L + SX_KC); LAS bf16* VC = (LAS bf16*)(L + SX_VC); LAS bf16* RC = (LAS bf16*)(L + SX_RC);
    LAS bf16* TW = (LAS bf16*)(L + SX_TW); LAS bf16* AD = (LAS bf16*)(L + SX_AD); LAS float* INVN = (LAS float*)(L + SX_INVN);
    LAS float* NBAT = (LAS float*)(L + SX_NBAT); LAS bf16* NKA = (LAS bf16*)(L + SX_NKA); LAS bf16* QBRT = (LAS bf16*)(L + SX_QBRT); LAS bf16* QKRT = (LAS bf16*)(L + SX_QKRT);
    LAS bf16* TT = (LAS bf16*)(L + SX_TT); LAS bf16* GG = (LAS bf16*)(L + SX_G); LAS bf16* MM = (LAS bf16*)(L + SX_M); LAS bf16* E1T = (LAS bf16*)(L + SY_KB);       LAS bf16* ZT = (LAS bf16*)(L + SX_ZT);
    LAS bf16* AB = (LAS bf16*)(L + SY_AB); LAS bf16* BB = (LAS bf16*)(L + SY_BB); LAS bf16* KB = (LAS bf16*)(L + SY_KB); LAS bf16* RB = (LAS bf16*)(L + SY_RB); LAS bf16* PCT = (LAS bf16*)(L + SY_PCT);
    LAS bf16* ABT = (LAS bf16*)(L + SZ_ABT); LAS bf16* BCT = (LAS bf16*)(L + SZ_BCT); LAS bf16* KCT = (LAS bf16*)(L + SZ_KCT); LAS bf16* VT = (LAS bf16*)(L + SZ_VT); LAS bf16* DCT = (LAS bf16*)(L + SZ_DCT);
    LAS bf16* SST = (LAS bf16*)(L + SS_ST); LAS float* GC = (LAS float*)(L + SM_GC); LAS float* BON = (LAS float*)(L + SM_BON);
    LAS float* CW = (LAS float*)(L + SC_CW);
    if (tid < 64) CW[960 + tid] = F.k_k[h * 64 + tid];
    for (int e = tid; e < 960; e += 512) { const int tap = e / 320, g = (e % 320) >> 6, c = e & 63;
        const int col = (g == 0 ? PC_RWK + h * 64 : g == 1 ? PC_RWV + h * 64 : g == 2 ? PC_RWR + h * 64 : g == 3 ? PC_WD + d * 64 : PC_AD + d * 64) + c;
        CW[e] = F.conv_w[tap * 1792 + col - 512]; }
    bf16x8 bwf[2], baf[2];
    { const int n_ = lane & 15, g_ = lane >> 4, cj_ = h * 64 + 16 * (wave & 3) + n_;
#pragma unroll
      for (int s2 = 0; s2 < 2; ++s2) { v4u ww, wa;
#pragma unroll
        for (int e2 = 0; e2 < 4; ++e2) { const int r0_ = 32 * s2 + 8 * g_ + 2 * e2;
            ww[e2] = cvtpk(F.decay_w2[((size_t)d * 64 + r0_) * 512 + cj_], F.decay_w2[((size_t)d * 64 + r0_ + 1) * 512 + cj_]);
            wa[e2] = cvtpk(F.aaa_a2[((size_t)d * 64 + r0_) * 512 + cj_], F.aaa_a2[((size_t)d * 64 + r0_ + 1) * 512 + cj_]); }
        bwf[s2] = __builtin_bit_cast(bf16x8, ww); baf[s2] = __builtin_bit_cast(bf16x8, wa); } }
    GAS v4u* lfr = (GAS v4u*)(F.ws + WS_LFR) + ((size_t)chain * 512 + tid) * 4;
    lfr[0] = __builtin_bit_cast(v4u, bwf[0]); lfr[1] = __builtin_bit_cast(v4u, bwf[1]); lfr[2] = __builtin_bit_cast(v4u, baf[0]); lfr[3] = __builtin_bit_cast(v4u, baf[1]);
    v4u lfrv[4] = {__builtin_bit_cast(v4u, bwf[0]), __builtin_bit_cast(v4u, bwf[1]), __builtin_bit_cast(v4u, baf[0]), __builtin_bit_cast(v4u, baf[1])};
    const int cjp_ = h * 64 + 16 * (wave & 3) + (lane & 15);
    const float w0 = F.decay_w0[d * 512 + cjp_], a0v = F.aaa_a0[d * 512 + cjp_], kkc = F.k_k[cjp_], kac = F.k_a[cjp_], rkc = F.r_k[cjp_];
    for (int e = tid; e < 2 * 64 * TS / 2; e += 512) ((LAS unsigned*)SST)[e] = 0u;
    if (tid < 64) BON[tid] = 0.f;
    int scur = 0;
#define SCAN_A_GEOM(SCN) const int sn_ = (SCN); const bool lat_ = sn_ >= 4; const int Lq_ = lat_ ? SEQ : CTXL; \
        const size_t rb_ = lat_ ? (size_t)b * SEQ : (size_t)ML + (size_t)b * CTXL; const int p0_ = lat_ ? sn_ * 64 - 256 : sn_ * 64; \
        const int tid_ = wave * 64 + lane_id_(); const int tt = tid_ >> 3, nn = tid_ & 7; \
        const int pos_ = p0_ + tt, idx_ = d ? (Lq_ - 1 - pos_) : pos_, lo_ = d ? (Lq_ - 64 - p0_) : p0_;
#define SCAN_COL(g) ((g) == 0 ? PC_RWK + hc_ : (g) == 1 ? PC_RWV + hc_ : (g) == 2 ? PC_RWR + hc_ : (g) == 3 ? PC_WD + dc_ : PC_AD + dc_)
#define SCAN_A_LOAD(SCN) do { SCAN_A_GEOM(SCN) int hc_ = h * 64, dc_ = d * 64; asm volatile("" : "+v"(hc_), "+v"(dc_));     \
        const bf16* prow = F.P + (rb_ + idx_) * PW; const v4u z = {0u, 0u, 0u, 0u}; \
        _Pragma("unroll") for (int g = 0; g < 5; ++g) { if (g == 2 && !lat_) prc[g] = z; else prc[g] = *(const GAS v4u*)(prow + SCAN_COL(g) + 8 * nn); } \
        prh = z; if ((wave == 0 || wave == 7) && lat_) { const int l_ = tid_ & 63, idxp_ = d ? (Lq_ - 1 - p0_ - (wave ? 63 : 0)) : p0_ + (wave ? 63 : 0), em_ = idxp_ & 255;        \
            const bool np_ = em_ == 0 && idxp_ > 0, nx_ = em_ == 255 && idxp_ < SEQ - 1; \
            if (l_ < 40 && (np_ || nx_)) { const int tl_ = (int)((rb_ + idxp_) >> 8), hg_ = l_ >> 3; \
                int colh_ = ((hg_ == 0) ? 0 : (hg_ == 1) ? 512 : (hg_ == 2) ? 1280 : (hg_ == 3) ? 1024 : 1152) + ((hg_ < 3) ? h : d) * 64 + 8 * nn; asm volatile("" : "+v"(colh_)); \
                prh = *(const GAS v4u*)((const bf16*)(F.ws + WS_EDGE) + (size_t)((np_ ? tl_ - 1 : tl_ + 1) * 2 + (np_ ? 1 : 0)) * 1792 + colh_); } } } while (0)
    { v4u prc[5], prh;
    SCAN_A_LOAD(0);
    __syncthreads();
    scan_a2(L, wave, d, false, 0, prc[0], prc[1], prc[2], prc[3], prc[4], prh); }
    __syncthreads();
    for (int sc = 0; sc < 68; ++sc) {
        const bool lat = sc >= 4;
        const int Lq = lat ? SEQ : CTXL;
        const size_t rbase = lat ? (size_t)b * SEQ : (size_t)ML + (size_t)b * CTXL;
        const int pos0 = lat ? sc * 64 - 256 : sc * 64;
        {
            const int lane_ = lane_id_();
            const int q = wave >> 2, cb = wave & 3, n = lane_ & 15, g = lane_ >> 4, j = 16 * cb + n, cj = h * 64 + j;
            int bo64 = (32 * q + 4 * g) * 64 + j, boTS = (32 * q + 4 * g) * TS + j; asm volatile("" : "+v"(bo64), "+v"(boTS));
            const LAS float* KCb = KC + bo64; const LAS unsigned short* VCu = (const LAS unsigned short*)VC + bo64; const LAS unsigned short* RCu = (const LAS unsigned short*)RC + bo64; const LAS float* INb = INVN + 32 * q + 4 * g;
            f32x2_t kq_[2][2], iq_[2][2]; unsigned vr_[2][4], rr_[2][4];
#pragma unroll
            for (int tb = 0; tb < 2; ++tb)
#pragma unroll
                for (int ep = 0; ep < 2; ++ep) { const int so = 16 * tb + 2 * ep;
                    kq_[tb][ep] = (f32x2_t){KCb[so * 64], KCb[(so + 1) * 64]};
                    vr_[tb][2 * ep] = VCu[so * 64]; vr_[tb][2 * ep + 1] = VCu[(so + 1) * 64];
                    rr_[tb][2 * ep] = RCu[so * 64]; rr_[tb][2 * ep + 1] = RCu[(so + 1) * 64];
                    iq_[tb][ep] = *(const LAS f32x2_t*)(INb + so); }
            f32x4 accW[2], accA[2];
#pragma unroll
            for (int tb = 0; tb < 2; ++tb) {
                accW[tb] = (f32x4){0.f, 0.f, 0.f, 0.f}; accA[tb] = (f32x4){0.f, 0.f, 0.f, 0.f};
#pragma unroll
                for (int s = 0; s < 2; ++s) {
                    const bf16x8 atw = *(const LAS bf16x8*)(TW + (32 * q + 16 * tb + n) * TS + 32 * s + 8 * g), aad = *(const LAS bf16x8*)(AD + (32 * q + 16 * tb + n) * TS + 32 * s + 8 * g);
                    const bf16x8 bw = __builtin_bit_cast(bf16x8, lfrv[s]), ba = __builtin_bit_cast(bf16x8, lfrv[2 + s]);
                    accW[tb] = __builtin_amdgcn_mfma_f32_16x16x32_bf16(atw, bw, accW[tb], 0, 0, 0);
                    accA[tb] = __builtin_amdgcn_mfma_f32_16x16x32_bf16(aad, ba, accA[tb], 0, 0, 0);
                }
            }
            float w0_ = w0, a0v_ = a0v, kkc_ = kkc, kac_ = kac, rkc_ = rkc; asm volatile("" : "+v"(w0_), "+v"(a0v_), "+v"(kkc_), "+v"(kac_), "+v"(rkc_));
            float lw[2][4], cl[2][4];
            float sA = 0.f, sB = 0.f;
#pragma unroll
            for (int tb = 0; tb < 2; ++tb)
#pragma unroll
                for (int ep = 0; ep < 2; ++ep) {
                    const f32x2_t aw = {accW[tb][2 * ep], accW[tb][2 * ep + 1]};
                    const f32x2_t arg = aw * (-LOG2E) + (-LOG2E * w0_);
                    f32x2_t den; den.x = __builtin_amdgcn_exp2f(arg.x); den.y = __builtin_amdgcn_exp2f(arg.y); den = den + 1.f;
                    lw[tb][2 * ep] = (-0.6065306597126334f * LOG2E) * __builtin_amdgcn_rcpf(den.x); lw[tb][2 * ep + 1] = (-0.6065306597126334f * LOG2E) * __builtin_amdgcn_rcpf(den.y);
                }
#pragma unroll
            for (int e = 0; e < 4; ++e) { sA += lw[0][e]; cl[0][e] = sA; sB += lw[1][e]; cl[1][e] = sB; }
            float pairA, pairB, totA, totB;
            { auto s1 = __builtin_amdgcn_permlane16_swap(__float_as_uint(sA), __float_as_uint(sA), false, false); pairA = __uint_as_float(s1[0]) + __uint_as_float(s1[1]);
              auto s2 = __builtin_amdgcn_permlane32_swap(__float_as_uint(pairA), __float_as_uint(pairA), false, false); totA = __uint_as_float(s2[0]) + __uint_as_float(s2[1]);
              auto s3 = __builtin_amdgcn_permlane16_swap(__float_as_uint(sB), __float_as_uint(sB), false, false); pairB = __uint_as_float(s3[0]) + __uint_as_float(s3[1]);
              auto s4 = __builtin_amdgcn_permlane32_swap(__float_as_uint(pairB), __float_as_uint(pairB), false, false); totB = __uint_as_float(s4[0]) + __uint_as_float(s4[1]); }
            const float m1 = (float)(g & 1), m2 = (float)(g >> 1);
            const float offA = m1 * (pairA - sA) + m2 * (totA - pairA);
            const float offB = totA + m1 * (pairB - sB) + m2 * (totB - pairB);
            const float clC = totA + totB, gC = __builtin_amdgcn_exp2f(clC);
            if (g == 0) GC[q * 64 + j] = gC;
            LAS unsigned short* ABu = (LAS unsigned short*)AB + boTS; LAS unsigned short* BBu = (LAS unsigned short*)BB + boTS; LAS unsigned short* KBu = (LAS unsigned short*)KB + boTS; LAS unsigned short* RBu = (LAS unsigned short*)RB + boTS;
#pragma unroll
            for (int tb = 0; tb < 2; ++tb) {
                const float offT = tb ? offB : offA;
                u32x2 alp, bcp, kcp, vtp; float bon[4];
                float gprev = 0.f;
#pragma unroll
                for (int ep = 0; ep < 2; ++ep) {
                    const int e0 = 2 * ep, so = 16 * tb + e0;
                    const f32x2_t c = (f32x2_t){cl[tb][e0], cl[tb][e0 + 1]} + offT;
                    f32x2_t gt; gt.x = __builtin_amdgcn_exp2f(c.x); gt.y = __builtin_amdgcn_exp2f(c.y);
                    f32x2_t gm1; gm1.x = ep ? gprev : __builtin_amdgcn_exp2f(c.x - lw[tb][0]); gm1.y = gt.x; gprev = gt.y;
                    f32x2_t ig; ig.x = __builtin_amdgcn_rcpf(gt.x); ig.y = __builtin_amdgcn_rcpf(gt.y);
                    const f32x2_t gce = ig * gC;
                    const f32x2_t k = kq_[tb][ep];
                    const f32x2_t r = {__uint_as_float(rr_[tb][e0] << 16), __uint_as_float(rr_[tb][e0 + 1] << 16)};
                    const f32x2_t invn = iq_[tb][ep];
                    const f32x2_t aarg = (f32x2_t){accA[tb][e0], accA[tb][e0 + 1]} * (-LOG2E) + (-LOG2E * a0v_);
                    f32x2_t ad_; ad_.x = __builtin_amdgcn_exp2f(aarg.x); ad_.y = __builtin_amdgcn_exp2f(aarg.y); ad_ = ad_ + 1.f;
                    f32x2_t a; a.x = __builtin_amdgcn_rcpf(ad_.x); a.y = __builtin_amdgcn_rcpf(ad_.y);
                    const f32x2_t kkv = k * kkc_ * invn, kdv = k * ((a - 1.f) * kac_ + 1.f), bv = kkv * a;
                    const f32x2_t al = kkv * gm1, be = bv * ig, ka = kdv * ig, rh = r * gt, bc = bv * gce, kc = kdv * gce, bn = r * kdv * rkc_;
                    const unsigned alq = cvtpk(al.x, al.y), beq = cvtpk(be.x, be.y), kaq = cvtpk(ka.x, ka.y), rhq = cvtpk(rh.x, rh.y);
                    ABu[so * TS] = (unsigned short)alq; ABu[(so + 1) * TS] = (unsigned short)(alq >> 16);
                    BBu[so * TS] = (unsigned short)beq; BBu[(so + 1) * TS] = (unsigned short)(beq >> 16);
                    KBu[so * TS] = (unsigned short)kaq; KBu[(so + 1) * TS] = (unsigned short)(kaq >> 16);
                    RBu[so * TS] = (unsigned short)rhq; RBu[(so + 1) * TS] = (unsigned short)(rhq >> 16);
                    alp[ep] = alq; bcp[ep] = cvtpk(bc.x, bc.y); kcp[ep] = cvtpk(kc.x, kc.y); vtp[ep] = vr_[tb][e0] | (vr_[tb][e0 + 1] << 16);
                    bon[e0] = bn.x; bon[e0 + 1] = bn.y;
                }
                const int to = (q * 64 + j) * CS + 16 * tb + 4 * g;
                *(LAS u32x2*)(ABT + to) = alp; *(LAS u32x2*)(BCT + to) = bcp; *(LAS u32x2*)(KCT + to) = kcp; *(LAS u32x2*)(VT + to) = vtp;
                if (lat) {
                    float xs[4];
#pragma unroll
                    for (int e = 0; e < 4; ++e) xs[e] = red16(bon[e]);
                    if (n == 0) {
#pragma unroll
                        for (int e = 0; e < 4; ++e) __hip_atomic_fetch_add(BON + 32 * q + 16 * tb + 4 * g + e, xs[e], __ATOMIC_RELAXED, __HIP_MEMORY_SCOPE_WORKGROUP);
                    }
                }
            }
        }
        __syncthreads();
        {
            const int lane_ = lane_id_(); const int l31 = lane_ & 31, hh = lane_ >> 5;
            const int q = wave >> 2, pi = wave & 3;
            if (lat || pi < 2) {
            const LAS bf16* X = (pi == 0 ? AB : pi == 1 ? AB : pi == 2 ? BB : KB) + (32 * q + l31) * TS + 8 * hh;
            const LAS bf16* Y = (pi == 0 ? BB : pi == 1 ? KB : RB) + (32 * q + l31) * TS + 8 * hh;
            const f32x16 acc = tile_mm<4>(X, Y);
            const int c = l31;
            const bool low = pi < 2;
            f32x4 o[4];
#pragma unroll
            for (int gg = 0; gg < 4; ++gg)
#pragma unroll
                for (int e = 0; e < 4; ++e) { const int r = 8 * gg + 4 * hh + e; const bool keep = low ? (c < r) : (r <= c); o[gg][e] = keep ? acc[4 * gg + e] : 0.f; }
            if (pi == 0) {
                LAS float* op = NBAT + (q * 32 + c) * 32 + 4 * hh;
#pragma unroll
                for (int gg = 0; gg < 4; ++gg) *(LAS f32x4*)(op + 8 * gg) = o[gg];
            } else {
                LAS bf16* op = (pi == 1 ? NKA : pi == 2 ? QBRT : QKRT) + (q * 32 + c) * CS + 4 * hh;
#pragma unroll
                for (int gg = 0; gg < 4; ++gg) *(LAS u32x2*)(op + 8 * gg) = pk4(o[gg][0], o[gg][1], o[gg][2], o[gg][3]);
            }
            }
        }
        __syncthreads();
        if (wave < 3) {
            const int lane_ = lane_id_();
            const int q = (wave < 2) ? wave : (lane_ >> 5);
            const LAS bf16* src = (wave < 2) ? ABT + (q * 64 + lane_) * CS : NKA + (q * 32 + (lane_ & 31)) * CS;
            LAS bf16* dst = (wave < 2) ? GG + (q * 64 + lane_) * CS : MM + (q * 32 + (lane_ & 31)) * CS;
            float x[32];
#pragma unroll
            for (int c4 = 0; c4 < 4; ++c4) { const v4u rv = *(const LAS v4u*)(src + 8 * c4);
#pragma unroll
                for (int e = 0; e < 4; ++e) { x[8 * c4 + 2 * e] = __uint_as_float(rv[e] << 16); x[8 * c4 + 2 * e + 1] = __uint_as_float(rv[e] & 0xffff0000u); } }
            const LAS float* nb_ = NBAT + q * 1024;
            f32x4 ra0, ra1, ra2, ra3, ra4, ra5, ra6, ra7, rb0, rb1, rb2, rb3, rb4, rb5, rb6, rb7;
            ra0 = *(const LAS f32x4*)(nb_ + 0);
            ra1 = *(const LAS f32x4*)(nb_ + 4);
            ra2 = *(const LAS f32x4*)(nb_ + 8);
            ra3 = *(const LAS f32x4*)(nb_ + 12);
            ra4 = *(const LAS f32x4*)(nb_ + 16);
            ra5 = *(const LAS f32x4*)(nb_ + 20);
            ra6 = *(const LAS f32x4*)(nb_ + 24);
            ra7 = *(const LAS f32x4*)(nb_ + 28);
            rb0 = *(const LAS f32x4*)(nb_ + 32);
            rb1 = *(const LAS f32x4*)(nb_ + 36);
            rb2 = *(const LAS f32x4*)(nb_ + 40);
            rb3 = *(const LAS f32x4*)(nb_ + 44);
            rb4 = *(const LAS f32x4*)(nb_ + 48);
            rb5 = *(const LAS f32x4*)(nb_ + 52);
            rb6 = *(const LAS f32x4*)(nb_ + 56);
            rb7 = *(const LAS f32x4*)(nb_ + 60);
            { const float xa = x[0];
              x[1] -= ra0[1] * xa;
              x[2] -= ra0[2] * xa;
              x[3] -= ra0[3] * xa;
              x[4] -= ra1[0] * xa;
              x[5] -= ra1[1] * xa;
              x[6] -= ra1[2] * xa;
              x[7] -= ra1[3] * xa;
              x[8] -= ra2[0] * xa;
              x[9] -= ra2[1] * xa;
              x[10] -= ra2[2] * xa;
              x[11] -= ra2[3] * xa;
              x[12] -= ra3[0] * xa;
              x[13] -= ra3[1] * xa;
              x[14] -= ra3[2] * xa;
              x[15] -= ra3[3] * xa;
              x[16] -= ra4[0] * xa;
              x[17] -= ra4[1] * xa;
              x[18] -= ra4[2] * xa;
              x[19] -= ra4[3] * xa;
              x[20] -= ra5[0] * xa;
              x[21] -= ra5[1] * xa;
              x[22] -= ra5[2] * xa;
              x[23] -= ra5[3] * xa;
              x[24] -= ra6[0] * xa;
              x[25] -= ra6[1] * xa;
              x[26] -= ra6[2] * xa;
              x[27] -= ra6[3] * xa;
              x[28] -= ra7[0] * xa;
              x[29] -= ra7[1] * xa;
              x[30] -= ra7[2] * xa;
              x[31] -= ra7[3] * xa;
            }
            __builtin_amdgcn_sched_barrier(0);
            ra0 = *(const LAS f32x4*)(nb_ + 64);
            ra1 = *(const LAS f32x4*)(nb_ + 68);
            ra2 = *(const LAS f32x4*)(nb_ + 72);
            ra3 = *(const LAS f32x4*)(nb_ + 76);
            ra4 = *(const LAS f32x4*)(nb_ + 80);
            ra5 = *(const LAS f32x4*)(nb_ + 84);
            ra6 = *(const LAS f32x4*)(nb_ + 88);
            ra7 = *(const LAS f32x4*)(nb_ + 92);
            { const float xa = x[1];
              x[2] -= rb0[2] * xa;
              x[3] -= rb0[3] * xa;
              x[4] -= rb1[0] * xa;
              x[5] -= rb1[1] * xa;
              x[6] -= rb1[2] * xa;
              x[7] -= rb1[3] * xa;
              x[8] -= rb2[0] * xa;
              x[9] -= rb2[1] * xa;
              x[10] -= rb2[2] * xa;
              x[11] -= rb2[3] * xa;
              x[12] -= rb3[0] * xa;
              x[13] -= rb3[1] * xa;
              x[14] -= rb3[2] * xa;
              x[15] -= rb3[3] * xa;
              x[16] -= rb4[0] * xa;
              x[17] -= rb4[1] * xa;
              x[18] -= rb4[2] * xa;
              x[19] -= rb4[3] * xa;
              x[20] -= rb5[0] * xa;
              x[21] -= rb5[1] * xa;
              x[22] -= rb5[2] * xa;
              x[23] -= rb5[3] * xa;
              x[24] -= rb6[0] * xa;
              x[25] -= rb6[1] * xa;
              x[26] -= rb6[2] * xa;
              x[27] -= rb6[3] * xa;
              x[28] -= rb7[0] * xa;
              x[29] -= rb7[1] * xa;
              x[30] -= rb7[2] * xa;
              x[31] -= rb7[3] * xa;
            }
            __builtin_amdgcn_sched_barrier(0);
            rb1 = *(const LAS f32x4*)(nb_ + 100);
            rb2 = *(const LAS f32x4*)(nb_ + 104);
            rb3 = *(const LAS f32x4*)(nb_ + 108);
            rb4 = *(const LAS f32x4*)(nb_ + 112);
            rb5 = *(const LAS f32x4*)(nb_ + 116);
            rb6 = *(const LAS f32x4*)(nb_ + 120);
            rb7 = *(const LAS f32x4*)(nb_ + 124);
            { const float xa = x[2];
              x[3] -= ra0[3] * xa;
              x[4] -= ra1[0] * xa;
              x[5] -= ra1[1] * xa;
              x[6] -= ra1[2] * xa;
              x[7] -= ra1[3] * xa;
              x[8] -= ra2[0] * xa;
              x[9] -= ra2[1] * xa;
              x[10] -= ra2[2] * xa;
              x[11] -= ra2[3] * xa;
              x[12] -= ra3[0] * xa;
              x[13] -= ra3[1] * xa;
              x[14] -= ra3[2] * xa;
              x[15] -= ra3[3] * xa;
              x[16] -= ra4[0] * xa;
              x[17] -= ra4[1] * xa;
              x[18] -= ra4[2] * xa;
              x[19] -= ra4[3] * xa;
              x[20] -= ra5[0] * xa;
              x[21] -= ra5[1] * xa;
              x[22] -= ra5[2] * xa;
              x[23] -= ra5[3] * xa;
              x[24] -= ra6[0] * xa;
              x[25] -= ra6[1] * xa;
              x[26] -= ra6[2] * xa;
              x[27] -= ra6[3] * xa;
              x[28] -= ra7[0] * xa;
              x[29] -= ra7[1] * xa;
              x[30] -= ra7[2] * xa;
              x[31] -= ra7[3] * xa;
            }
            __builtin_amdgcn_sched_barrier(0);
            ra1 = *(const LAS f32x4*)(nb_ + 132);
            ra2 = *(const LAS f32x4*)(nb_ + 136);
            ra3 = *(const LAS f32x4*)(nb_ + 140);
            ra4 = *(const LAS f32x4*)(nb_ + 144);
            ra5 = *(const LAS f32x4*)(nb_ + 148);
            ra6 = *(const LAS f32x4*)(nb_ + 152);
            ra7 = *(const LAS f32x4*)(nb_ + 156);
            { const float xa = x[3];
              x[4] -= rb1[0] * xa;
              x[5] -= rb1[1] * xa;
              x[6] -= rb1[2] * xa;
              x[7] -= rb1[3] * xa;
              x[8] -= rb2[0] * xa;
              x[9] -= rb2[1] * xa;
              x[10] -= rb2[2] * xa;
              x[11] -= rb2[3] * xa;
              x[12] -= rb3[0] * xa;
              x[13] -= rb3[1] * xa;
              x[14] -= rb3[2] * xa;
              x[15] -= rb3[3] * xa;
              x[16] -= rb4[0] * xa;
              x[17] -= rb4[1] * xa;
              x[18] -= rb4[2] * xa;
              x[19] -= rb4[3] * xa;
              x[20] -= rb5[0] * xa;
              x[21] -= rb5[1] * xa;
              x[22] -= rb5[2] * xa;
              x[23] -= rb5[3] * xa;
              x[24] -= rb6[0] * xa;
              x[25] -= rb6[1] * xa;
              x[26] -= rb6[2] * xa;
              x[27] -= rb6[3] * xa;
              x[28] -= rb7[0] * xa;
              x[29] -= rb7[1] * xa;
              x[30] -= rb7[2] * xa;
              x[31] -= rb7[3] * xa;
            }
            __builtin_amdgcn_sched_barrier(0);
            rb1 = *(const LAS f32x4*)(nb_ + 164);
            rb2 = *(const LAS f32x4*)(nb_ + 168);
            rb3 = *(const LAS f32x4*)(nb_ + 172);
            rb4 = *(const LAS f32x4*)(nb_ + 176);
            rb5 = *(const LAS f32x4*)(nb_ + 180);
            rb6 = *(const LAS f32x4*)(nb_ + 184);
            rb7 = *(const LAS f32x4*)(nb_ + 188);
            { const float xa = x[4];
              x[5] -= ra1[1] * xa;
              x[6] -= ra1[2] * xa;
              x[7] -= ra1[3] * xa;
              x[8] -= ra2[0] * xa;
              x[9] -= ra2[1] * xa;
              x[10] -= ra2[2] * xa;
              x[11] -= ra2[3] * xa;
              x[12] -= ra3[0] * xa;
              x[13] -= ra3[1] * xa;
              x[14] -= ra3[2] * xa;
              x[15] -= ra3[3] * xa;
              x[16] -= ra4[0] * xa;
              x[17] -= ra4[1] * xa;
              x[18] -= ra4[2] * xa;
              x[19] -= ra4[3] * xa;
              x[20] -= ra5[0] * xa;
              x[21] -= ra5[1] * xa;
              x[22] -= ra5[2] * xa;
              x[23] -= ra5[3] * xa;
              x[24] -= ra6[0] * xa;
              x[25] -= ra6[1] * xa;
              x[26] -= ra6[2] * xa;
              x[27] -= ra6[3] * xa;
              x[28] -= ra7[0] * xa;
              x[29] -= ra7[1] * xa;
              x[30] -= ra7[2] * xa;
              x[31] -= ra7[3] * xa;
            }
            __builtin_amdgcn_sched_barrier(0);
            ra1 = *(const LAS f32x4*)(nb_ + 196);
            ra2 = *(const LAS f32x4*)(nb_ + 200);
            ra3 = *(const LAS f32x4*)(nb_ + 204);
            ra4 = *(const LAS f32x4*)(nb_ + 208);
            ra5 = *(const LAS f32x4*)(nb_ + 212);
            ra6 = *(const LAS f32x4*)(nb_ + 216);
            ra7 = *(const LAS f32x4*)(nb_ + 220);
            { const float xa = x[5];
              x[6] -= rb1[2] * xa;
              x[7] -= rb1[3] * xa;
              x[8] -= rb2[0] * xa;
              x[9] -= rb2[1] * xa;
              x[10] -= rb2[2] * xa;
              x[11] -= rb2[3] * xa;
              x[12] -= rb3[0] * xa;
              x[13] -= rb3[1] * xa;
              x[14] -= rb3[2] * xa;
              x[15] -= rb3[3] * xa;
              x[16] -= rb4[0] * xa;
              x[17] -= rb4[1] * xa;
              x[18] -= rb4[2] * xa;
              x[19] -= rb4[3] * xa;
              x[20] -= rb5[0] * xa;
              x[21] -= rb5[1] * xa;
              x[22] -= rb5[2] * xa;
              x[23] -= rb5[3] * xa;
              x[24] -= rb6[0] * xa;
              x[25] -= rb6[1] * xa;
              x[26] -= rb6[2] * xa;
              x[27] -= rb6[3] * xa;
              x[28] -= rb7[0] * xa;
              x[29] -= rb7[1] * xa;
              x[30] -= rb7[2] * xa;
              x[31] -= rb7[3] * xa;
            }
            __builtin_amdgcn_sched_barrier(0);
            rb2 = *(const LAS f32x4*)(nb_ + 232);
            rb3 = *(const LAS f32x4*)(nb_ + 236);
            rb4 = *(const LAS f32x4*)(nb_ + 240);
            rb5 = *(const LAS f32x4*)(nb_ + 244);
            rb6 = *(const LAS f32x4*)(nb_ + 248);
            rb7 = *(const LAS f32x4*)(nb_ + 252);
            { const float xa = x[6];
              x[7] -= ra1[3] * xa;
              x[8] -= ra2[0] * xa;
              x[9] -= ra2[1] * xa;
              x[10] -= ra2[2] * xa;
              x[11] -= ra2[3] * xa;
              x[12] -= ra3[0] * xa;
              x[13] -= ra3[1] * xa;
              x[14] -= ra3[2] * xa;
              x[15] -= ra3[3] * xa;
              x[16] -= ra4[0] * xa;
              x[17] -= ra4[1] * xa;
              x[18] -= ra4[2] * xa;
              x[19] -= ra4[3] * xa;
              x[20] -= ra5[0] * xa;
              x[21] -= ra5[1] * xa;
              x[22] -= ra5[2] * xa;
              x[23] -= ra5[3] * xa;
              x[24] -= ra6[0] * xa;
              x[25] -= ra6[1] * xa;
              x[26] -= ra6[2] * xa;
              x[27] -= ra6[3] * xa;
              x[28] -= ra7[0] * xa;
              x[29] -= ra7[1] * xa;
              x[30] -= ra7[2] * xa;
              x[31] -= ra7[3] * xa;
            }
            __builtin_amdgcn_sched_barrier(0);
            ra2 = *(const LAS f32x4*)(nb_ + 264);
            ra3 = *(const LAS f32x4*)(nb_ + 268);
            ra4 = *(const LAS f32x4*)(nb_ + 272);
            ra5 = *(const LAS f32x4*)(nb_ + 276);
            ra6 = *(const LAS f32x4*)(nb_ + 280);
            ra7 = *(const LAS f32x4*)(nb_ + 284);
            { const float xa = x[7];
              x[8] -= rb2[0] * xa;
              x[9] -= rb2[1] * xa;
              x[10] -= rb2[2] * xa;
              x[11] -= rb2[3] * xa;
              x[12] -= rb3[0] * xa;
              x[13] -= rb3[1] * xa;
              x[14] -= rb3[2] * xa;
              x[15] -= rb3[3] * xa;
              x[16] -= rb4[0] * xa;
              x[17] -= rb4[1] * xa;
              x[18] -= rb4[2] * xa;
              x[19] -= rb4[3] * xa;
              x[20] -= rb5[0] * xa;
              x[21] -= rb5[1] * xa;
              x[22] -= rb5[2] * xa;
              x[23] -= rb5[3] * xa;
              x[24] -= rb6[0] * xa;
              x[25] -= rb6[1] * xa;
              x[26] -= rb6[2] * xa;
              x[27] -= rb6[3] * xa;
              x[28] -= rb7[0] * xa;
              x[29] -= rb7[1] * xa;
              x[30] -= rb7[2] * xa;
              x[31] -= rb7[3] * xa;
            }
            __builtin_amdgcn_sched_barrier(0);
            rb2 = *(const LAS f32x4*)(nb_ + 296);
            rb3 = *(const LAS f32x4*)(nb_ + 300);
            rb4 = *(const LAS f32x4*)(nb_ + 304);
            rb5 = *(const LAS f32x4*)(nb_ + 308);
            rb6 = *(const LAS f32x4*)(nb_ + 312);
            rb7 = *(const LAS f32x4*)(nb_ + 316);
            { const float xa = x[8];
              x[9] -= ra2[1] * xa;
              x[10] -= ra2[2] * xa;
              x[11] -= ra2[3] * xa;
              x[12] -= ra3[0] * xa;
              x[13] -= ra3[1] * xa;
              x[14] -= ra3[2] * xa;
              x[15] -= ra3[3] * xa;
              x[16] -= ra4[0] * xa;
              x[17] -= ra4[1] * xa;
              x[18] -= ra4[2] * xa;
              x[19] -= ra4[3] * xa;
              x[20] -= ra5[0] * xa;
              x[21] -= ra5[1] * xa;
              x[22] -= ra5[2] * xa;
              x[23] -= ra5[3] * xa;
              x[24] -= ra6[0] * xa;
              x[25] -= ra6[1] * xa;
              x[26] -= ra6[2] * xa;
              x[27] -= ra6[3] * xa;
              x[28] -= ra7[0] * xa;
              x[29] -= ra7[1] * xa;
              x[30] -= ra7[2] * xa;
              x[31] -= ra7[3] * xa;
            }
            __builtin_amdgcn_sched_barrier(0);
            ra2 = *(const LAS f32x4*)(nb_ + 328);
            ra3 = *(const LAS f32x4*)(nb_ + 332);
            ra4 = *(const LAS f32x4*)(nb_ + 336);
            ra5 = *(const LAS f32x4*)(nb_ + 340);
            ra6 = *(const LAS f32x4*)(nb_ + 344);
            ra7 = *(const LAS f32x4*)(nb_ + 348);
            { const float xa = x[9];
              x[10] -= rb2[2] * xa;
              x[11] -= rb2[3] * xa;
              x[12] -= rb3[0] * xa;
              x[13] -= rb3[1] * xa;
              x[14] -= rb3[2] * xa;
              x[15] -= rb3[3] * xa;
              x[16] -= rb4[0] * xa;
              x[17] -= rb4[1] * xa;
              x[18] -= rb4[2] * xa;
              x[19] -= rb4[3] * xa;
              x[20] -= rb5[0] * xa;
              x[21] -= rb5[1] * xa;
              x[22] -= rb5[2] * xa;
              x[23] -= rb5[3] * xa;
              x[24] -= rb6[0] * xa;
              x[25] -= rb6[1] * xa;
              x[26] -= rb6[2] * xa;
              x[27] -= rb6[3] * xa;
              x[28] -= rb7[0] * xa;
              x[29] -= rb7[1] * xa;
              x[30] -= rb7[2] * xa;
              x[31] -= rb7[3] * xa;
            }
            __builtin_amdgcn_sched_barrier(0);
            rb3 = *(const LAS f32x4*)(nb_ + 364);
            rb4 = *(const LAS f32x4*)(nb_ + 368);
            rb5 = *(const LAS f32x4*)(nb_ + 372);
            rb6 = *(const LAS f32x4*)(nb_ + 376);
            rb7 = *(const LAS f32x4*)(nb_ + 380);
            { const float xa = x[10];
              x[11] -= ra2[3] * xa;
              x[12] -= ra3[0] * xa;
              x[13] -= ra3[1] * xa;
              x[14] -= ra3[2] * xa;
              x[15] -= ra3[3] * xa;
              x[16] -= ra4[0] * xa;
              x[17] -= ra4[1] * xa;
              x[18] -= ra4[2] * xa;
              x[19] -= ra4[3] * xa;
              x[20] -= ra5[0] * xa;
              x[21] -= ra5[1] * xa;
              x[22] -= ra5[2] * xa;
              x[23] -= ra5[3] * xa;
              x[24] -= ra6[0] * xa;
              x[25] -= ra6[1] * xa;
              x[26] -= ra6[2] * xa;
              x[27] -= ra6[3] * xa;
              x[28] -= ra7[0] * xa;
              x[29] -= ra7[1] * xa;
              x[30] -= ra7[2] * xa;
              x[31] -= ra7[3] * xa;
            }
            __builtin_amdgcn_sched_barrier(0);
            ra3 = *(const LAS f32x4*)(nb_ + 396);
            ra4 = *(const LAS f32x4*)(nb_ + 400);
            ra5 = *(const LAS f32x4*)(nb_ + 404);
            ra6 = *(const LAS f32x4*)(nb_ + 408);
            ra7 = *(const LAS f32x4*)(nb_ + 412);
            { const float xa = x[11];
              x[12] -= rb3[0] * xa;
              x[13] -= rb3[1] * xa;
              x[14] -= rb3[2] * xa;
              x[15] -= rb3[3] * xa;
              x[16] -= rb4[0] * xa;
              x[17] -= rb4[1] * xa;
              x[18] -= rb4[2] * xa;
              x[19] -= rb4[3] * xa;
              x[20] -= rb5[0] * xa;
              x[21] -= rb5[1] * xa;
              x[22] -= rb5[2] * xa;
              x[23] -= rb5[3] * xa;
              x[24] -= rb6[0] * xa;
              x[25] -= rb6[1] * xa;
              x[26] -= rb6[2] * xa;
              x[27] -= rb6[3] * xa;
              x[28] -= rb7[0] * xa;
              x[29] -= rb7[1] * xa;
              x[30] -= rb7[2] * xa;
              x[31] -= rb7[3] * xa;
            }
            __builtin_amdgcn_sched_barrier(0);
            rb3 = *(const LAS f32x4*)(nb_ + 428);
            rb4 = *(const LAS f32x4*)(nb_ + 432);
            rb5 = *(const LAS f32x4*)(nb_ + 436);
            rb6 = *(const LAS f32x4*)(nb_ + 440);
            rb7 = *(const LAS f32x4*)(nb_ + 444);
            { const float xa = x[12];
              x[13] -= ra3[1] * xa;
              x[14] -= ra3[2] * xa;
              x[15] -= ra3[3] * xa;
              x[16] -= ra4[0] * xa;
              x[17] -= ra4[1] * xa;
              x[18] -= ra4[2] * xa;
              x[19] -= ra4[3] * xa;
              x[20] -= ra5[0] * xa;
              x[21] -= ra5[1] * xa;
              x[22] -= ra5[2] * xa;
              x[23] -= ra5[3] * xa;
              x[24] -= ra6[0] * xa;
              x[25] -= ra6[1] * xa;
              x[26] -= ra6[2] * xa;
              x[27] -= ra6[3] * xa;
              x[28] -= ra7[0] * xa;
              x[29] -= ra7[1] * xa;
              x[30] -= ra7[2] * xa;
              x[31] -= ra7[3] * xa;
            }
            __builtin_amdgcn_sched_barrier(0);
            ra3 = *(const LAS f32x4*)(nb_ + 460);
            ra4 = *(const LAS f32x4*)(nb_ + 464);
            ra5 = *(const LAS f32x4*)(nb_ + 468);
            ra6 = *(const LAS f32x4*)(nb_ + 472);
            ra7 = *(const LAS f32x4*)(nb_ + 476);
            { const float xa = x[13];
              x[14] -= rb3[2] * xa;
              x[15] -= rb3[3] * xa;
              x[16] -= rb4[0] * xa;
              x[17] -= rb4[1] * xa;
              x[18] -= rb4[2] * xa;
              x[19] -= rb4[3] * xa;
              x[20] -= rb5[0] * xa;
              x[21] -= rb5[1] * xa;
              x[22] -= rb5[2] * xa;
              x[23] -= rb5[3] * xa;
              x[24] -= rb6[0] * xa;
              x[25] -= rb6[1] * xa;
              x[26] -= rb6[2] * xa;
              x[27] -= rb6[3] * xa;
              x[28] -= rb7[0] * xa;
              x[29] -= rb7[1] * xa;
              x[30] -= rb7[2] * xa;
              x[31] -= rb7[3] * xa;
            }
            __builtin_amdgcn_sched_barrier(0);
            rb4 = *(const LAS f32x4*)(nb_ + 496);
            rb5 = *(const LAS f32x4*)(nb_ + 500);
            rb6 = *(const LAS f32x4*)(nb_ + 504);
            rb7 = *(const LAS f32x4*)(nb_ + 508);
            { const float xa = x[14];
              x[15] -= ra3[3] * xa;
              x[16] -= ra4[0] * xa;
              x[17] -= ra4[1] * xa;
              x[18] -= ra4[2] * xa;
              x[19] -= ra4[3] * xa;
              x[20] -= ra5[0] * xa;
              x[21] -= ra5[1] * xa;
              x[22] -= ra5[2] * xa;
              x[23] -= ra5[3] * xa;
              x[24] -= ra6[0] * xa;
              x[25] -= ra6[1] * xa;
              x[26] -= ra6[2] * xa;
              x[27] -= ra6[3] * xa;
              x[28] -= ra7[0] * xa;
              x[29] -= ra7[1] * xa;
              x[30] -= ra7[2] * xa;
              x[31] -= ra7[3] * xa;
            }
            __builtin_amdgcn_sched_barrier(0);
            ra4 = *(const LAS f32x4*)(nb_ + 528);
            ra5 = *(const LAS f32x4*)(nb_ + 532);
            ra6 = *(const LAS f32x4*)(nb_ + 536);
            ra7 = *(const LAS f32x4*)(nb_ + 540);
            { const float xa = x[15];
              x[16] -= rb4[0] * xa;
              x[17] -= rb4[1] * xa;
              x[18] -= rb4[2] * xa;
              x[19] -= rb4[3] * xa;
              x[20] -= rb5[0] * xa;
              x[21] -= rb5[1] * xa;
              x[22] -= rb5[2] * xa;
              x[23] -= rb5[3] * xa;
              x[24] -= rb6[0] * xa;
              x[25] -= rb6[1] * xa;
              x[26] -= rb6[2] * xa;
              x[27] -= rb6[3] * xa;
              x[28] -= rb7[0] * xa;
              x[29] -= rb7[1] * xa;
              x[30] -= rb7[2] * xa;
              x[31] -= rb7[3] * xa;
            }
            __builtin_amdgcn_sched_barrier(0);
            rb4 = *(const LAS f32x4*)(nb_ + 560);
            rb5 = *(const LAS f32x4*)(nb_ + 564);
            rb6 = *(const LAS f32x4*)(nb_ + 568);
            rb7 = *(const LAS f32x4*)(nb_ + 572);
            { const float xa = x[16];
              x[17] -= ra4[1] * xa;
              x[18] -= ra4[2] * xa;
              x[19] -= ra4[3] * xa;
              x[20] -= ra5[0] * xa;
              x[21] -= ra5[1] * xa;
              x[22] -= ra5[2] * xa;
              x[23] -= ra5[3] * xa;
              x[24] -= ra6[0] * xa;
              x[25] -= ra6[1] * xa;
              x[26] -= ra6[2] * xa;
              x[27] -= ra6[3] * xa;
              x[28] -= ra7[0] * xa;
              x[29] -= ra7[1] * xa;
              x[30] -= ra7[2] * xa;
              x[31] -= ra7[3] * xa;
            }
            __builtin_amdgcn_sched_barrier(0);
            ra4 = *(const LAS f32x4*)(nb_ + 592);
            ra5 = *(const LAS f32x4*)(nb_ + 596);
            ra6 = *(const LAS f32x4*)(nb_ + 600);
            ra7 = *(const LAS f32x4*)(nb_ + 604);
            { const float xa = x[17];
              x[18] -= rb4[2] * xa;
              x[19] -= rb4[3] * xa;
              x[20] -= rb5[0] * xa;
              x[21] -= rb5[1] * xa;
              x[22] -= rb5[2] * xa;
              x[23] -= rb5[3] * xa;
              x[24] -= rb6[0] * xa;
              x[25] -= rb6[1] * xa;
              x[26] -= rb6[2] * xa;
              x[27] -= rb6[3] * xa;
              x[28] -= rb7[0] * xa;
              x[29] -= rb7[1] * xa;
              x[30] -= rb7[2] * xa;
              x[31] -= rb7[3] * xa;
            }
            __builtin_amdgcn_sched_barrier(0);
            rb5 = *(const LAS f32x4*)(nb_ + 628);
            rb6 = *(const LAS f32x4*)(nb_ + 632);
            rb7 = *(const LAS f32x4*)(nb_ + 636);
            { const float xa = x[18];
              x[19] -= ra4[3] * xa;
              x[20] -= ra5[0] * xa;
              x[21] -= ra5[1] * xa;
              x[22] -= ra5[2] * xa;
              x[23] -= ra5[3] * xa;
              x[24] -= ra6[0] * xa;
              x[25] -= ra6[1] * xa;
              x[26] -= ra6[2] * xa;
              x[27] -= ra6[3] * xa;
              x[28] -= ra7[0] * xa;
              x[29] -= ra7[1] * xa;
              x[30] -= ra7[2] * xa;
              x[31] -= ra7[3] * xa;
            }
            __builtin_amdgcn_sched_barrier(0);
            ra5 = *(const LAS f32x4*)(nb_ + 660);
            ra6 = *(const LAS f32x4*)(nb_ + 664);
            ra7 = *(const LAS f32x4*)(nb_ + 668);
            { const float xa = x[19];
              x[20] -= rb5[0] * xa;
              x[21] -= rb5[1] * xa;
              x[22] -= rb5[2] * xa;
              x[23] -= rb5[3] * xa;
              x[24] -= rb6[0] * xa;
              x[25] -= rb6[1] * xa;
              x[26] -= rb6[2] * xa;
              x[27] -= rb6[3] * xa;
              x[28] -= rb7[0] * xa;
              x[29] -= rb7[1] * xa;
              x[30] -= rb7[2] * xa;
              x[31] -= rb7[3] * xa;
            }
            __builtin_amdgcn_sched_barrier(0);
            rb5 = *(const LAS f32x4*)(nb_ + 692);
            rb6 = *(const LAS f32x4*)(nb_ + 696);
            rb7 = *(const LAS f32x4*)(nb_ + 700);
            { const float xa = x[20];
              x[21] -= ra5[1] * xa;
              x[22] -= ra5[2] * xa;
              x[23] -= ra5[3] * xa;
              x[24] -= ra6[0] * xa;
              x[25] -= ra6[1] * xa;
              x[26] -= ra6[2] * xa;
              x[27] -= ra6[3] * xa;
              x[28] -= ra7[0] * xa;
              x[29] -= ra7[1] * xa;
              x[30] -= ra7[2] * xa;
              x[31] -= ra7[3] * xa;
            }
            __builtin_amdgcn_sched_barrier(0);
            ra5 = *(const LAS f32x4*)(nb_ + 724);
            ra6 = *(const LAS f32x4*)(nb_ + 728);
            ra7 = *(const LAS f32x4*)(nb_ + 732);
            { const float xa = x[21];
              x[22] -= rb5[2] * xa;
              x[23] -= rb5[3] * xa;
              x[24] -= rb6[0] * xa;
              x[25] -= rb6[1] * xa;
              x[26] -= rb6[2] * xa;
              x[27] -= rb6[3] * xa;
              x[28] -= rb7[0] * xa;
              x[29] -= rb7[1] * xa;
              x[30] -= rb7[2] * xa;
              x[31] -= rb7[3] * xa;
            }
            __builtin_amdgcn_sched_barrier(0);
            rb6 = *(const LAS f32x4*)(nb_ + 760);
            rb7 = *(const LAS f32x4*)(nb_ + 764);
            { const float xa = x[22];
              x[23] -= ra5[3] * xa;
              x[24] -= ra6[0] * xa;
              x[25] -= ra6[1] * xa;
              x[26] -= ra6[2] * xa;
              x[27] -= ra6[3] * xa;
              x[28] -= ra7[0] * xa;
              x[29] -= ra7[1] * xa;
              x[30] -= ra7[2] * xa;
              x[31] -= ra7[3] * xa;
            }
            __builtin_amdgcn_sched_barrier(0);
            ra6 = *(const LAS f32x4*)(nb_ + 792);
            ra7 = *(const LAS f32x4*)(nb_ + 796);
            { const float xa = x[23];
              x[24] -= rb6[0] * xa;
              x[25] -= rb6[1] * xa;
              x[26] -= rb6[2] * xa;
              x[27] -= rb6[3] * xa;
              x[28] -= rb7[0] * xa;
              x[29] -= rb7[1] * xa;
              x[30] -= rb7[2] * xa;
              x[31] -= rb7[3] * xa;
            }
            __builtin_amdgcn_sched_barrier(0);
            rb6 = *(const LAS f32x4*)(nb_ + 824);
            rb7 = *(const LAS f32x4*)(nb_ + 828);
            { const float xa = x[24];
              x[25] -= ra6[1] * xa;
              x[26] -= ra6[2] * xa;
              x[27] -= ra6[3] * xa;
              x[28] -= ra7[0] * xa;
              x[29] -= ra7[1] * xa;
              x[30] -= ra7[2] * xa;
              x[31] -= ra7[3] * xa;
            }
            __builtin_amdgcn_sched_barrier(0);
            ra6 = *(const LAS f32x4*)(nb_ + 856);
            ra7 = *(const LAS f32x4*)(nb_ + 860);
            { const float xa = x[25];
              x[26] -= rb6[2] * xa;
              x[27] -= rb6[3] * xa;
              x[28] -= rb7[0] * xa;
              x[29] -= rb7[1] * xa;
              x[30] -= rb7[2] * xa;
              x[31] -= rb7[3] * xa;
            }
            __builtin_amdgcn_sched_barrier(0);
            rb7 = *(const LAS f32x4*)(nb_ + 892);
            { const float xa = x[26];
              x[27] -= ra6[3] * xa;
              x[28] -= ra7[0] * xa;
              x[29] -= ra7[1] * xa;
              x[30] -= ra7[2] * xa;
              x[31] -= ra7[3] * xa;
            }
            __builtin_amdgcn_sched_barrier(0);
            ra7 = *(const LAS f32x4*)(nb_ + 924);
            { const float xa = x[27];
              x[28] -= rb7[0] * xa;
              x[29] -= rb7[1] * xa;
              x[30] -= rb7[2] * xa;
              x[31] -= rb7[3] * xa;
            }
            __builtin_amdgcn_sched_barrier(0);
            rb7 = *(const LAS f32x4*)(nb_ + 956);
            { const float xa = x[28];
              x[29] -= ra7[1] * xa;
              x[30] -= ra7[2] * xa;
              x[31] -= ra7[3] * xa;
            }
            __builtin_amdgcn_sched_barrier(0);
            ra7 = *(const LAS f32x4*)(nb_ + 988);
            { const float xa = x[29];
              x[30] -= rb7[2] * xa;
              x[31] -= rb7[3] * xa;
            }
            __builtin_amdgcn_sched_barrier(0);
            { const float xa = x[30];
              x[31] -= ra7[3] * xa;
            }
            __builtin_amdgcn_sched_barrier(0);
#pragma unroll
            for (int c4 = 0; c4 < 4; ++c4) { v4u w; w.x = cvtpk(x[8 * c4], x[8 * c4 + 1]); w.y = cvtpk(x[8 * c4 + 2], x[8 * c4 + 3]); w.z = cvtpk(x[8 * c4 + 4], x[8 * c4 + 5]); w.w = cvtpk(x[8 * c4 + 6], x[8 * c4 + 7]);
                *(LAS v4u*)(dst + 8 * c4) = w; }
        }
        __syncthreads();
        v4u prc[5], prh;
        { const v4u z0 = {0u, 0u, 0u, 0u}; prc[0] = z0; prc[1] = z0; prc[2] = z0; prc[3] = z0; prc[4] = z0; prh = z0; }
        if (sc + 1 < 68) SCAN_A_LOAD(sc + 1);
        {
            const int lane_ = lane_id_(); const int l31 = lane_ & 31, hh = lane_ >> 5;
            {
                const int q = wave >> 2, jb = wave & 1, jbp = (wave >> 1) & 1;
                f_tile<true>(GG + (q * 64 + 32 * jb + l31) * CS + 8 * hh, BCT + (q * 64 + 32 * jbp + l31) * CS + 8 * hh, BCT, PCT + (q * 64 + 32 * jbp + l31) * TS + 32 * jb, GC[q * 64 + 32 * jbp + l31], 32 * jbp + l31 - 32 * jb, hh);
            }
            if (wave >= 4 || lat) {
                const bool isE = wave < 4; const int q = (wave >> 1) & 1, x = wave & 1;
                const LAS bf16* X = (isE ? GG + (q * 64 + 32 * x) * CS : MM + (q * 32) * CS) + l31 * CS + 8 * hh;
                const LAS bf16* Y = (isE ? QBRT + (q * 32) * CS : BCT + (q * 64 + 32 * x) * CS) + l31 * CS + 8 * hh;
                const int str = isE ? TS : CS;
                const LAS bf16* Bp = (isE ? RB + (32 * q) * TS + 32 * x : KCT + (q * 64 + 32 * x) * CS) + l31 * str + 4 * hh;
                LAS bf16* Op = (isE ? E1T + (q * 32) * TS + 32 * x : DCT + (q * 64 + 32 * x) * CS) + l31 * str;
                f_tile<false>(X, Y, Bp, Op, 0.f, 0, hh);
            }
            if (lat && (wave == 1 || wave == 6)) {
                const int q = wave == 6;
                f_tile<false>(MM + (q * 32 + l31) * CS + 8 * hh, QBRT + (q * 32 + l31) * CS + 8 * hh, QKRT + (q * 32 + l31) * CS + 4 * hh, ZT + (q * 32 + l31) * CS, 0.f, 0, hh);
            }
        }
        __syncthreads();
        { GAS v4u* lp = lfr;
#pragma unroll
          for (int e4 = 0; e4 < 4; ++e4) lfrv[e4] = lp[e4]; }
        if (sc + 1 < 68) scan_a2(L, wave, d, sc + 1 >= 4, (sc + 1 >= 4) ? (sc + 1) * 64 - 256 : (sc + 1) * 64, prc[0], prc[1], prc[2], prc[3], prc[4], prh);
#pragma unroll
        for (int q = 0; q < 2; ++q) {
            if (wave < 2) {
                if (lat) {
                    const int lane_ = lane_id_(); const int l31 = lane_ & 31, hh = lane_ >> 5, ib = wave;
                    const LAS bf16* Scur = SST + scur * (64 * TS) + (32 * ib + l31) * TS + 8 * hh;
                    const LAS bf16* A1 = E1T + (q * 32 + l31) * TS + 8 * hh;
                    const LAS bf16* A2p = ZT + (q * 32 + l31) * CS + 8 * hh;
                    const LAS bf16* Vp = VT + (q * 64 + 32 * ib + l31) * CS + 8 * hh;
                    f32x16 acc;
#pragma unroll
                    for (int r = 0; r < 16; ++r) acc[r] = 0.f;
#pragma unroll
                    for (int s2 = 0; s2 < 2; ++s2) acc = __builtin_amdgcn_mfma_f32_32x32x16_bf16(*(const LAS bf16x8*)(Vp + 16 * s2), *(const LAS bf16x8*)(A2p + 16 * s2), acc, 0, 0, 0);
#pragma unroll
                    for (int s4 = 0; s4 < 4; ++s4) acc = __builtin_amdgcn_mfma_f32_32x32x16_bf16(*(const LAS bf16x8*)(Scur + 16 * s4), *(const LAS bf16x8*)(A1 + 16 * s4), acc, 0, 0, 0);
                    const unsigned yu = (unsigned)__builtin_amdgcn_readfirstlane((int)(((unsigned)d * ML + (unsigned)rbase) * 512u + (unsigned)(h * 64 + 32 * ib)));
                    GAS bf16* yb = (GAS bf16*)F.Y;
                    const int pos = pos0 + 32 * q + l31, idx = d ? (SEQ - 1 - pos) : pos;
                    const unsigned yo = yu + (unsigned)(idx * 512 + 4 * hh);
#pragma unroll
                    for (int gg = 0; gg < 4; ++gg) *(GAS u32x2*)(yb + yo + 8 * gg) = pk4(acc[4 * gg], acc[4 * gg + 1], acc[4 * gg + 2], acc[4 * gg + 3]);
                }
            } else if (wave < 6) {
                const int lane_ = lane_id_(); const int l31 = lane_ & 31, hh = lane_ >> 5, ib = (wave - 2) & 1, jbp = (wave - 2) >> 1;
                const LAS bf16* Scur = SST + scur * (64 * TS) + (32 * ib + l31) * TS + 8 * hh;
                const LAS bf16* A1 = PCT + (q * 64 + 32 * jbp + l31) * TS + 8 * hh;
                const LAS bf16* A2p = DCT + (q * 64 + 32 * jbp + l31) * CS + 8 * hh;
                const LAS bf16* Vp = VT + (q * 64 + 32 * ib + l31) * CS + 8 * hh;
                f32x16 acc;
#pragma unroll
                for (int r = 0; r < 16; ++r) acc[r] = 0.f;
#pragma unroll
                for (int s2 = 0; s2 < 2; ++s2) acc = __builtin_amdgcn_mfma_f32_32x32x16_bf16(*(const LAS bf16x8*)(A2p + 16 * s2), *(const LAS bf16x8*)(Vp + 16 * s2), acc, 0, 0, 0);
#pragma unroll
                for (int s4 = 0; s4 < 4; ++s4) acc = __builtin_amdgcn_mfma_f32_32x32x16_bf16(*(const LAS bf16x8*)(A1 + 16 * s4), *(const LAS bf16x8*)(Scur + 16 * s4), acc, 0, 0, 0);
                LAS bf16* Snx = SST + (scur ^ 1) * (64 * TS) + (32 * ib + l31) * TS + 32 * jbp;
#pragma unroll
                for (int gg = 0; gg < 4; ++gg) *(LAS u32x2*)(Snx + 8 * gg + 4 * hh) = pk4(acc[4 * gg], acc[4 * gg + 1], acc[4 * gg + 2], acc[4 * gg + 3]);
            } else if (wave == 6 && q == 0 && lat) {
                const int ln_ = lane_id_(); const int pos = pos0 + ln_, idx = d ? (SEQ - 1 - pos) : pos;
                F.bonus[(rbase + idx) * 16 + h * 2 + d] = BON[ln_]; BON[ln_] = 0.f;
            }
            scur ^= 1;
            __syncthreads();
        }
    }
}
__device__ __forceinline__ void p5_readout(Frame& F, const bool own_panel) {
    const int gw = own_panel ? (int)blockIdx.x * 256 + F.wave : F.vcu * NWAVES + F.wave, NGW = own_panel ? NWAVES : F.G * NWAVES, lane = lane_id_();
    const int mend = own_panel ? (int)blockIdx.x * 256 + 256 : ML;
    const int c8 = 8 * lane, hd = lane >> 3;
    float cw0[8], cw2[8], gw_[8], gb_[8];
#pragma unroll
    for (int e = 0; e < 8; ++e) { cw0[e] = F.conv_w[512 + c8 + e]; cw2[e] = F.conv_w[3584 + 512 + c8 + e]; gw_[e] = F.gn_w[c8 + e]; gb_[e] = F.gn_b[c8 + e]; }
    const bf16* EDGE = (const bf16*)(F.ws + WS_EDGE);
    for (int m0 = gw; m0 < mend; m0 += 2 * NGW) {
        v4u ya[2], yb[2], v0[2], ve[2], gg[2]; float bon[2]; bool ok[2], npv[2];
        const v4u z = {0u, 0u, 0u, 0u};
#pragma unroll
        for (int u = 0; u < 2; ++u) {
            const int m = m0 + u * NGW; ok[u] = m < mend; const int mm = ok[u] ? m : m0;
            const int tl = mm & (SEQ - 1), em = mm & 255; const bool np = em == 0 && tl > 0, nx = em == 255 && tl + 1 < SEQ;
            ya[u] = *(const GAS v4u*)((const bf16*)F.Y + (size_t)mm * 512 + c8); yb[u] = *(const GAS v4u*)((const bf16*)F.Y + ((size_t)ML + mm) * 512 + c8);
            const bf16* prow = F.P + (size_t)mm * PW;
            v0[u] = *(const GAS v4u*)(prow + PC_RWV + c8); npv[u] = np;
            ve[u] = (np || nx) ? *(const GAS v4u*)(EDGE + (size_t)((np ? (mm >> 8) - 1 : (mm >> 8) + 1) * 2 + (np ? 1 : 0)) * 1792 + 512 + c8) : z;
            gg[u] = *(const GAS v4u*)(prow + PC_RWG + c8);
            bon[u] = F.bonus[(size_t)mm * 16 + hd * 2] + F.bonus[(size_t)mm * 16 + hd * 2 + 1];
        }
#pragma unroll
        for (int u = 0; u < 2; ++u) {
            float y[8];
#pragma unroll
            for (int e2 = 0; e2 < 4; ++e2) { y[2 * e2] = __uint_as_float(ya[u][e2] << 16) + __uint_as_float(yb[u][e2] << 16); y[2 * e2 + 1] = __uint_as_float(ya[u][e2] & 0xffff0000u) + __uint_as_float(yb[u][e2] & 0xffff0000u); }
            float s = 0.f;
#pragma unroll
            for (int e = 0; e < 8; ++e) s += y[e];
            s = red8(s);
            const float mu = s * (1.f / 64.f); float q = 0.f;
#pragma unroll
            for (int e = 0; e < 8; ++e) { y[e] -= mu; q += y[e] * y[e]; }
            q = red8(q);
            const float rstd = rsqrtf(q * (1.f / 64.f) + GN_EPS);
            float o[8];
#pragma unroll
            for (int e2 = 0; e2 < 4; ++e2) {
#pragma unroll
                for (int hb = 0; hb < 2; ++hb) {
                    const int e = 2 * e2 + hb;
                    const float pv_0 = hb ? __uint_as_float(v0[u][e2] & 0xffff0000u) : __uint_as_float(v0[u][e2] << 16), pv_e = hb ? __uint_as_float(ve[u][e2] & 0xffff0000u) : __uint_as_float(ve[u][e2] << 16);
                    const float vc = pv_0 + (npv[u] ? cw0[e] : cw2[e]) * pv_e;
                    const float g = hb ? __uint_as_float(gg[u][e2] & 0xffff0000u) : __uint_as_float(gg[u][e2] << 16);
                    const float yn = y[e] * rstd * gw_[e] + gb_[e];
                    o[e] = (yn + bon[u] * vc) * siluf_(g);
                }
            }
            if (ok[u]) { v4u w; w.x = cvtpk(o[0], o[1]); w.y = cvtpk(o[2], o[3]); w.z = cvtpk(o[4], o[5]); w.w = cvtpk(o[6], o[7]);
                *(GAS v4u*)(F.MIX + (size_t)(m0 + u * NGW) * DM + 512 + c8) = w; }
        }
    }
}
__device__ __forceinline__ void p7_final(Frame& F) {
    const int gw = F.vcu * NWAVES + F.wave, NGW = F.G * NWAVES;
    for (int m = gw; m < ML; m += NGW) {
        const float rstd = rsqrtf(__hip_atomic_load(F.sumsq + m, __ATOMIC_RELAXED, __HIP_MEMORY_SCOPE_AGENT) * (1.f / DM) + RMS_EPS);
        GAS f32x4* o = (GAS f32x4*)(F.out + (size_t)m * DM) + lane_id_();
#pragma unroll
        for (int j = 0; j < 4; ++j) { const f32x4 g = *(const f32x4*)(F.final_g + 4 * (lane_id_() + 64 * j)); o[64 * j] = o[64 * j] * rstd * g; }
    }
}

struct Args { const float* in[21]; float* out; unsigned char* ws; };
__global__ void __launch_bounds__(NWAVES * 64, 2) mk_fwd(Args args) {
    extern __shared__ __attribute__((aligned(16))) unsigned char lds[];
    Frame F;
    F.lds = (LAS unsigned char*)lds;
    volatile LAS unsigned* MISC = (volatile LAS unsigned*)(F.lds + MISC_OFF);
    F.wave = __builtin_amdgcn_readfirstlane((int)threadIdx.x >> 6);
    F.G = gridDim.x; { const int bx = blockIdx.x; F.vcu = (F.G % 8 == 0) ? (bx % 8) * (F.G / 8) + bx / 8 : bx; }
    unsigned char* ws = args.ws;
    gu32* ctl = (gu32*)(ws + WS_CTL);
    F.x = args.in[0]; F.c = args.in[1]; F.ctx = args.in[2]; F.c_ctx = args.in[3]; F.w_mod = args.in[4]; F.b_mod = args.in[5]; F.norm_g = args.in[6]; F.w_in = args.in[7];
    F.conv_w = args.in[8]; F.decay_w0 = args.in[9]; F.decay_w2 = args.in[10]; F.aaa_a0 = args.in[11]; F.aaa_a2 = args.in[12]; F.k_k = args.in[13]; F.k_a = args.in[14];
    F.r_k = args.in[15]; F.gn_w = args.in[16]; F.gn_b = args.in[17]; F.na_rpb = args.in[18]; F.w_out = args.in[19]; F.final_g = args.in[20];
    F.out = args.out; F.ws = args.ws;
    F.mod = (float*)(ws + WS_MOD); F.sumsq = (float*)(ws + WS_SUMSQ); F.bonus = (float*)(ws + WS_BONUS);
    F.WoutT = (bf16*)(ws + WS_WOUT); F.WinT = (bf16*)(ws + WS_WIN); F.XN = (bf16*)(ws + WS_XN); F.P = (bf16*)(ws + WS_P); F.VT = (bf16*)(ws + WS_VT); F.MIX = (bf16*)(ws + WS_MIX); F.Y = (bf16*)(ws + WS_Y);
    if (F.wave == 0) ((LAS unsigned*)(F.lds + MISC_OFF))[lane_id_()] = 0u;
    __syncthreads();
    XcdBarrier bar = xcd_barrier_post((unsigned*)(ctl + CW_BAR), MISC + 8, F.wave == 0 && lane_id_() == 0);

    p0_prologue(F);
    xcd_barrier(bar);
    p1_xn(F);
    xcd_barrier(bar);
    {
        static_assert(WS_XN == 64 * (512u << 10) && WS_WIN == 8 * (512u << 10), "absolute panel indices of MergedOrder");
        pg8::Gemm g{(const pg8::bf16_t*)ws, (const pg8::bf16_t*)ws, MT, PW, DM}; pg8::MergedOrder S; S.init(F.G, (int)blockIdx.x);
        pg8::EpiMerged E{F.P, F.VT, PW, VTP, (pg8::bf16_t*)(ws + WS_EDGE), F.lds};
        { LAS float* CWL = (LAS float*)(F.lds + pg8::EPI_CW_OFF); for (int e = F.wave * 64 + lane_id_(); e < 3 * 1792; e += NWAVES * 64) CWL[e] = F.conv_w[e]; }
        __syncthreads();
        pg8::gemm_phase<pg8::EpiMerged, pg8::MergedOrder, true, true>(F.lds, g, S, E, F.wave);
    }
    xcd_barrier(bar);
    p3_attention(F);
    __syncthreads();
    p4_scan(F);
    xcd_barrier(bar);
    p5_readout(F, F.G == 256);
    if (F.G != 256) xcd_barrier(bar);
    if (F.G == 256) {
        LAS float* ssq = (LAS float*)(F.lds + 131072);
        const int lane2 = lane_id_();
        if (F.wave < 4) ssq[F.wave * 64 + lane2] = 0.f;
        asm volatile("s_waitcnt vmcnt(0)" ::: "memory");
        __syncthreads();
        pg8::Gemm g{F.MIX, F.WoutT, ML, DM, DM}; pg8::PanelOrder S; S.init(F.G, (int)blockIdx.x);
        pg8::EpiOutH E{F.x, F.mod, (pg8::bf16_t*)F.XN, ssq};
        pg8::gemm_phase<pg8::EpiOutH, pg8::PanelOrder, true, true>(F.lds, g, S, E, F.wave);
        __syncthreads();
        const int pm = (int)blockIdx.x;
        f32x4 fg[2][2];
#pragma unroll
        for (int j = 0; j < 2; ++j)
#pragma unroll
            for (int n = 0; n < 2; ++n) fg[j][n] = *(const f32x4*)(F.final_g + 512 * j + 8 * lane2 + 4 * n);
        for (int r = F.wave * 32; r < F.wave * 32 + 32; r += 4) {
            v4u hv[4][2];
#pragma unroll
            for (int u = 0; u < 4; ++u)
#pragma unroll
                for (int j = 0; j < 2; ++j) hv[u][j] = *(const GAS v4u*)(F.XN + ((size_t)pm * 256 + r + u) * DM + 512 * j + 8 * lane2);
#pragma unroll
            for (int u = 0; u < 4; ++u) {
                const float rs = rsqrtf(ssq[r + u] * (1.f / DM) + RMS_EPS);
                GAS f32x4* o = (GAS f32x4*)(F.out + ((size_t)pm * 256 + r + u) * DM + 8 * lane2);
#pragma unroll
                for (int j = 0; j < 2; ++j) {
                    const v4u h4 = hv[u][j];
                    const f32x4 a = {__uint_as_float(h4.x << 16), __uint_as_float(h4.x & 0xffff0000u), __uint_as_float(h4.y << 16), __uint_as_float(h4.y & 0xffff0000u)};
                    const f32x4 c = {__uint_as_float(h4.z << 16), __uint_as_float(h4.z & 0xffff0000u), __uint_as_float(h4.w << 16), __uint_as_float(h4.w & 0xffff0000u)};
                    o[128 * j] = a * rs * fg[j][0]; o[128 * j + 1] = c * rs * fg[j][1];
                }
            }
        }
    } else {
        { pg8::Gemm g{F.MIX, F.WoutT, ML, DM, DM}; pg8::StaticOrder S; S.init(ML, DM, F.G, (int)blockIdx.x);
          pg8::EpiOut E{F.x, F.mod, F.out, F.sumsq};
          pg8::gemm_phase<pg8::EpiOut, pg8::StaticOrder, true, true>(F.lds, g, S, E, F.wave); }
        xcd_barrier(bar);
        p7_final(F);
    }
}

extern "C" void kernel_launch(void* const* d_in, const int* in_sizes, int n_in, void* d_out, int out_size, void* d_ws, size_t ws_size, hipStream_t stream) {
    static int grid = 0;
    if (grid == 0) {
        if (n_in != 21 || out_size != ML * DM || ws_size < WS_END) { fprintf(stderr, "kernel_launch: unexpected shapes (n_in %d, out %d, ws %zu)\n", n_in, out_size, ws_size); grid = -1; return; }
        int dev = 0, cus = 0, per_cu = 0;
        if (hipGetDevice(&dev) != hipSuccess || hipDeviceGetAttribute(&cus, hipDeviceAttributeMultiprocessorCount, dev) != hipSuccess) { grid = -1; return; }
        if (hipFuncSetAttribute((const void*)mk_fwd, hipFuncAttributeMaxDynamicSharedMemorySize, LDS_BYTES) != hipSuccess) { fprintf(stderr, "kernel_launch: hipFuncSetAttribute failed\n"); grid = -1; return; }
        if (hipOccupancyMaxActiveBlocksPerMultiprocessor(&per_cu, (const void*)mk_fwd, NWAVES * 64, LDS_BYTES) != hipSuccess || per_cu < 1) { fprintf(stderr, "kernel_launch: occupancy query says %d\n", per_cu); }
        (void)hipGetLastError();
        grid = cus;
    }
    if (grid < 0) return;
    if (hipMemsetAsync((char*)d_ws + WS_CTL, 0, CTL_ZERO_BYTES, stream) != hipSuccess) return;
    Args a{};
    for (int i = 0; i < 21; ++i) a.in[i] = (const float*)d_in[i];
    a.out = (float*)d_out; a.ws = (unsigned char*)d_ws;
    hipLaunchKernelGGL(mk_fwd, dim3(grid), dim3(NWAVES * 64), LDS_BYTES, stream, a);
}
```

```cpp
#include <hip/hip_runtime.h>
#include <cstdio>
#include <cstdint>
namespace pg8 {
#define PG8_LAS __attribute__((address_space(3)))
typedef unsigned short bf16_t;
typedef short bf16x8 __attribute__((ext_vector_type(8)));
typedef float f32x4 __attribute__((ext_vector_type(4)));
typedef unsigned u32x4 __attribute__((ext_vector_type(4)));
constexpr int BM = 256, BK = 64, HALF = 128, HTB = HALF * BK * 2  , STAGE_BYTES = 8 * HTB, NXCD = 8, WGM = 4;

__host__ __device__ __forceinline__ int lds_byte(int r, int c) { const int st = (r >> 4) * 2 + (c >> 5), rr = r & 15, cc = c & 31, ob = rr * 64 + cc * 2; return st * 1024 + (ob ^ (((ob >> 9) & 1) << 5)); }
__host__ __device__ __forceinline__ void stage_rc(int b, int& R, int& C) { const int st = b / 1024, sb = b % 1024, swz = sb ^ (((sb >> 9) & 1) << 5); R = (st >> 1) * 16 + swz / 64; C = (st & 1) * 32 + (swz % 64) / 2; }
__host__ __device__ __forceinline__ int perm32(int rho) { const int n = rho >> 4, i = rho & 15; return 8 * (i >> 2) + 4 * n + (i & 3); }

struct Unit { int pm, pn; };
struct Gemm { const bf16_t* A; const bf16_t* Bt; int M, N, K; };

struct StaticOrder {
    int nM, nN, nwg, G, c;
    __host__ __device__ void init(int M, int N, int G_, int c_) { nM = M / BM; nN = N / BM; nwg = nM * nN; G = G_; c = c_; }
    __host__ __device__ bool next(int i, Unit& u) const {
        const long L = (long)i * G + c; if (L >= nwg) return false;
        int wgid = (int)L; { const int q = nwg / NXCD, r = nwg % NXCD, xcd = wgid % NXCD, off = wgid / NXCD; wgid = (xcd < r ? xcd * (q + 1) : r * (q + 1) + (xcd - r) * q) + off; }
        const int nig = WGM * nN, gid = wgid / nig, fm = gid * WGM, gsz = (nM - fm) < WGM ? (nM - fm) : WGM;
        u.pm = fm + ((wgid % nig) % gsz); u.pn = (wgid % nig) / gsz; return true;
    }
    __device__ __forceinline__ void a_ready(const Unit&) const {}
    __device__ __forceinline__ void done(const Unit&) const {}
};

__device__ __forceinline__ unsigned cvt_pk_bf16(float lo, float hi) { unsigned r; asm volatile("v_cvt_pk_bf16_f32 %0, %1, %2" : "=v"(r) : "v"(lo), "v"(hi)); return r; }
typedef float f32x2 __attribute__((ext_vector_type(2)));
__device__ __forceinline__ f32x2 gelu_pk(f32x2 v) {
    const f32x2 av = __builtin_elementwise_abs(v), d = av * 0.2316418882f + 1.0f;
    f32x2 t; t.x = __builtin_amdgcn_rcpf(d.x); t.y = __builtin_amdgcn_rcpf(d.y);
    f32x2 q = t * 0.5307027145f + (-0.7265760135f); q = q * t + 0.7107068705f; q = q * t + (-0.142248368f); q = q * t + 0.127414796f; q = q * t;
    const f32x2 s = (v * v) * (-0.72134752044f);
    f32x2 e; e.x = __builtin_amdgcn_exp2f(s.x); e.y = __builtin_amdgcn_exp2f(s.y);
    const f32x2 m = v * (q * e), r = v - m;
    f32x2 o; o.x = v.x < 0.f ? m.x : r.x; o.y = v.y < 0.f ? m.y : r.y; return o;
}

template <int ACT  > struct EpiBf16 {
    static constexpr bool PERM = true, AFTER_DRAIN = false; static_assert(ACT == 0 || ACT == 1, "EpiBf16: ACT is 0 (none) or 1 (gelu_pk)");
    bf16_t* O; int ldc; const float* bias; int split_cols; size_t split_stride; float scale0;
    __device__ __forceinline__ void operator()(const f32x4 (&acc)[2][2][4][2], const Unit& u, int wr, int wc, int fr, int fq) const {
        const int row0 = u.pm * BM + wr * 64 + fr; int colt = u.pn * BM; bf16_t* base = O;
        float sc = 1.f; if (split_cols) { const int t = colt / split_cols; base += (size_t)t * split_stride; colt -= t * split_cols; if (t == 0) sc = scale0; }
        const int col0 = colt + wc * 32 + 8 * fq, bcol0 = u.pn * BM + wc * 32 + 8 * fq;
        f32x4 bv[2][2];
#pragma unroll
        for (int bj = 0; bj < 2; ++bj)
#pragma unroll
            for (int n = 0; n < 2; ++n) bv[bj][n] = bias ? *(const f32x4*)(bias + bcol0 + bj * HALF + 4 * n) : (f32x4){0.f, 0.f, 0.f, 0.f};
#pragma unroll
        for (int ai = 0; ai < 2; ++ai)
#pragma unroll
            for (int m = 0; m < 4; ++m) { bf16_t* rowp = base + (size_t)(row0 + ai * HALF + m * 16) * ldc + col0;
#pragma unroll
                for (int bj = 0; bj < 2; ++bj) { f32x4 v0 = acc[ai][bj][m][0] + bv[bj][0], v1 = acc[ai][bj][m][1] + bv[bj][1];
                    if (ACT == 1) { f32x2 a = gelu_pk((f32x2){v0[0], v0[1]}), b = gelu_pk((f32x2){v0[2], v0[3]}), c = gelu_pk((f32x2){v1[0], v1[1]}), d = gelu_pk((f32x2){v1[2], v1[3]});
                        v0 = (f32x4){a.x, a.y, b.x, b.y}; v1 = (f32x4){c.x, c.y, d.x, d.y}; }
                    v0 = v0 * sc; v1 = v1 * sc; u32x4 w; w.x = cvt_pk_bf16(v0[0], v0[1]); w.y = cvt_pk_bf16(v0[2], v0[3]); w.z = cvt_pk_bf16(v1[0], v1[1]); w.w = cvt_pk_bf16(v1[2], v1[3]);
                    *(u32x4*)(rowp + bj * HALF) = w; } }
    }
};

struct MergedOrder {
    StaticOrder so; int G, c; long base, limit;
    __host__ __device__ void init(int G_, int c_) { so.init(65536, 3840, G_, c_); G = G_; c = c_; base = 0; limit = 4496; }
    __host__ __device__ bool next(int i, Unit& u) const {
        const long L = base + (long)i * G + c; if (L >= limit) return false;
        if (L < 3840) { Unit t; so.next(i, t); u.pm = 64 + t.pm; u.pn = 8 + t.pn; return true; }
        const int r = (int)(L - 3840);
        if (r < 544) { u.pm = 8 + 15 + (r & 1); u.pn = 64 + (r >> 1); return true; }
        if (r < 656) { const int r2 = r - 544; u.pm = 64 + 256 + (r2 & 15); u.pn = 8 + (r2 >> 4); return true; }
        return false;
    }
    __device__ __forceinline__ void a_ready(const Unit&) const {}
    __device__ __forceinline__ void done(const Unit&) const {}
};
template <int CTRL> __device__ __forceinline__ float dppf(float x) { return __builtin_bit_cast(float, __builtin_amdgcn_update_dpp(0, __builtin_bit_cast(int, x), CTRL, 0xf, 0xf, true)); }
constexpr int EPI_EDGE_OFF = 131072, EPI_CW_OFF = 139264;
struct EpiMerged {
    static constexpr bool PERM = true, AFTER_DRAIN = false;
    bf16_t* P; bf16_t* VT; int ldp, ldv; bf16_t* EDGE; PG8_LAS unsigned char* lds;
    __device__ __forceinline__ void operator()(const f32x4 (&acc)[2][2][4][2], const Unit& u, int wr, int wc, int fr, int fq) const {
        const bool isv = u.pm < 64;
        const int rp = isv ? u.pm - 23 : u.pm - 64, cp = isv ? u.pn - 64 : u.pn - 8, ldc = isv ? ldv : ldp;
        bf16_t* base = isv ? VT : P;
        const int row0 = rp * BM + wr * 64 + fr, col0 = cp * BM + wc * 32 + 8 * fq;
        if (isv || cp < 2 || cp >= 9) {
#pragma unroll
        for (int ai = 0; ai < 2; ++ai)
#pragma unroll
            for (int m = 0; m < 4; ++m) { bf16_t* rowp = base + (size_t)(row0 + ai * HALF + m * 16) * ldc + col0;
#pragma unroll
                for (int bj = 0; bj < 2; ++bj) { const f32x4 v0 = acc[ai][bj][m][0], v1 = acc[ai][bj][m][1];
                    u32x4 w; w.x = cvt_pk_bf16(v0[0], v0[1]); w.y = cvt_pk_bf16(v0[2], v0[3]); w.z = cvt_pk_bf16(v1[0], v1[1]); w.w = cvt_pk_bf16(v1[2], v1[3]);
                    *(u32x4*)(rowp + bj * HALF) = w; } }
        } else {
            int fq8 = 8 * fq; asm volatile("" : "+v"(fq8));
            PG8_LAS float* EL = (PG8_LAS float*)(lds + EPI_EDGE_OFF) + wc * 32 + fq8;
            const PG8_LAS float* CWL = (const PG8_LAS float*)(lds + EPI_CW_OFF) + (cp - 2) * BM + wc * 32 + fq8;
            if (fr == 0) {
#pragma unroll
                for (int ai = 0; ai < 2; ++ai)
#pragma unroll
                    for (int bj = 0; bj < 2; ++bj)
#pragma unroll
                        for (int n = 0; n < 2; ++n) *(PG8_LAS f32x4*)(EL + ((2 * ai + wr) * 2 + 0) * 256 + bj * HALF + 4 * n) = acc[ai][bj][0][n];
            }
            if (fr == 15) {
#pragma unroll
                for (int ai = 0; ai < 2; ++ai)
#pragma unroll
                    for (int bj = 0; bj < 2; ++bj)
#pragma unroll
                        for (int n = 0; n < 2; ++n) *(PG8_LAS f32x4*)(EL + ((2 * ai + wr) * 2 + 1) * 256 + bj * HALF + 4 * n) = acc[ai][bj][3][n];
            }
            asm volatile("s_waitcnt lgkmcnt(0)" ::: "memory"); __builtin_amdgcn_s_barrier();
            if (wr == 0 && fr == 0) {
#pragma unroll
                for (int bj = 0; bj < 2; ++bj) { const f32x4 v0 = acc[0][bj][0][0], v1 = acc[0][bj][0][1];
                    u32x4 w; w.x = cvt_pk_bf16(v0[0], v0[1]); w.y = cvt_pk_bf16(v0[2], v0[3]); w.z = cvt_pk_bf16(v1[0], v1[1]); w.w = cvt_pk_bf16(v1[2], v1[3]);
                    *(u32x4*)(EDGE + (size_t)(rp * 2 + 0) * 1792 + (cp - 2) * BM + wc * 32 + 8 * fq + bj * HALF) = w; }
            }
            if (wr == 1 && fr == 15) {
#pragma unroll
                for (int bj = 0; bj < 2; ++bj) { const f32x4 v0 = acc[1][bj][3][0], v1 = acc[1][bj][3][1];
                    u32x4 w; w.x = cvt_pk_bf16(v0[0], v0[1]); w.y = cvt_pk_bf16(v0[2], v0[3]); w.z = cvt_pk_bf16(v1[0], v1[1]); w.w = cvt_pk_bf16(v1[2], v1[3]);
                    *(u32x4*)(EDGE + (size_t)(rp * 2 + 1) * 1792 + (cp - 2) * BM + wc * 32 + 8 * fq + bj * HALF) = w; }
            }
            const f32x4 zz = {0.f, 0.f, 0.f, 0.f};
#pragma unroll
            for (int bj = 0; bj < 2; ++bj) {
                f32x4 w0[2], w1[2], w2[2];
#pragma unroll
                for (int n = 0; n < 2; ++n) { w0[n] = *(const PG8_LAS f32x4*)(CWL + bj * HALF + 4 * n); w1[n] = *(const PG8_LAS f32x4*)(CWL + 1792 + bj * HALF + 4 * n); w2[n] = *(const PG8_LAS f32x4*)(CWL + 3584 + bj * HALF + 4 * n); }
#pragma unroll
                for (int ai = 0; ai < 2; ++ai) {
                    const int b4 = 2 * ai + wr;
                    f32x4 hp[2], hn[2];
#pragma unroll
                    for (int n = 0; n < 2; ++n) { hp[n] = b4 > 0 ? *(const PG8_LAS f32x4*)(EL + ((b4 - 1) * 2 + 1) * 256 + bj * HALF + 4 * n) : zz; hn[n] = b4 < 3 ? *(const PG8_LAS f32x4*)(EL + ((b4 + 1) * 2 + 0) * 256 + bj * HALF + 4 * n) : zz; }
#pragma unroll
                    for (int m = 0; m < 4; ++m) {
                        f32x4 t[2];
#pragma unroll
                        for (int n = 0; n < 2; ++n)
#pragma unroll
                            for (int e = 0; e < 4; ++e) {
                                const float c = acc[ai][bj][m][n][e];
                                const float up = m > 0 ? dppf<0x121>(acc[ai][bj][m > 0 ? m - 1 : 0][n][e]) : hp[n][e];
                                const float dn = m < 3 ? dppf<0x12F>(acc[ai][bj][m < 3 ? m + 1 : 3][n][e]) : hn[n][e];
                                const float pv = __builtin_bit_cast(float, __builtin_amdgcn_update_dpp(__builtin_bit_cast(int, up), __builtin_bit_cast(int, c), 0x111, 0xf, 0xf, false));
                                const float nv = __builtin_bit_cast(float, __builtin_amdgcn_update_dpp(__builtin_bit_cast(int, dn), __builtin_bit_cast(int, c), 0x101, 0xf, 0xf, false));
                                t[n][e] = w0[n][e] * pv + w1[n][e] * c + w2[n][e] * nv;
                            }
                        if (bj == 0 && cp == 6) {
                            const bool er = (ai == 0 && m == 0) ? (wr == 0 && fr == 0) : (ai == 1 && m == 3) ? (wr == 1 && fr == 15) : false;
#pragma unroll
                            for (int n = 0; n < 2; ++n)
#pragma unroll
                                for (int e = 0; e < 4; ++e) { const float th = 1.f - 2.f * __builtin_amdgcn_rcpf(__builtin_amdgcn_exp2f(t[n][e] * 2.885390081777927f) + 1.f); t[n][e] = er ? t[n][e] : th; }
                        }
                        u32x4 w; w.x = cvt_pk_bf16(t[0][0], t[0][1]); w.y = cvt_pk_bf16(t[0][2], t[0][3]); w.z = cvt_pk_bf16(t[1][0], t[1][1]); w.w = cvt_pk_bf16(t[1][2], t[1][3]);
                        *(u32x4*)(base + (size_t)(row0 + ai * HALF + m * 16) * ldc + col0 + bj * HALF) = w;
                    }
                }
            }
        }
    }
};
struct PanelOrder {
    int G, c;
    __host__ __device__ void init(int G_, int c_) { G = G_; c = c_; }
    __host__ __device__ bool next(int i, Unit& u) const { u.pm = c + (i >> 2) * G; u.pn = i & 3; return u.pm < 256; }
    __device__ __forceinline__ void a_ready(const Unit&) const {}
    __device__ __forceinline__ void done(const Unit&) const {}
};
struct EpiOutP {
    static constexpr bool PERM = false, AFTER_DRAIN = false;
    const float* x; const float* mod; float* out; PG8_LAS float* ssq;
    __device__ __forceinline__ void operator()(const f32x4 (&acc)[2][2][4][2], const Unit& u, int wr, int wc, int fr, int fq) const {
        const int col0 = u.pn * BM + wc * 32 + 4 * fq;
        const int b = (u.pm * BM) >> 12;
        const float* gate = mod + b * 3072 + 2048;
        f32x4 gv[2][2];
#pragma unroll
        for (int bj = 0; bj < 2; ++bj)
#pragma unroll
            for (int n = 0; n < 2; ++n) gv[bj][n] = *(const f32x4*)(gate + col0 + bj * HALF + n * 16);
#pragma unroll
        for (int ai = 0; ai < 2; ++ai)
#pragma unroll
            for (int m = 0; m < 4; ++m) {
                const int rl = ai * HALF + wr * 64 + m * 16 + fr, row = u.pm * BM + rl;
                const size_t off = (size_t)row * 1024 + col0;
                float ss = 0.f;
#pragma unroll
                for (int bj = 0; bj < 2; ++bj)
#pragma unroll
                    for (int n = 0; n < 2; ++n) {
                        const f32x4 xv = *(const f32x4*)(x + off + bj * HALF + n * 16);
                        const f32x4 o = xv + gv[bj][n] * acc[ai][bj][m][n];
                        *(f32x4*)(out + off + bj * HALF + n * 16) = o;
                        ss += (o[0] * o[0] + o[1] * o[1]) + (o[2] * o[2] + o[3] * o[3]);
                    }
                { auto r1 = __builtin_amdgcn_permlane16_swap(__float_as_uint(ss), __float_as_uint(ss), false, false); ss = __uint_as_float(r1[0]) + __uint_as_float(r1[1]);
                  auto r2 = __builtin_amdgcn_permlane32_swap(__float_as_uint(ss), __float_as_uint(ss), false, false); ss = __uint_as_float(r2[0]) + __uint_as_float(r2[1]); }
                if (fq == 0) __hip_atomic_fetch_add(ssq + rl, ss, __ATOMIC_RELAXED, __HIP_MEMORY_SCOPE_WORKGROUP);
                asm volatile("" ::: "memory");
            }
    }
};
struct EpiOutH {
    static constexpr bool PERM = true, AFTER_DRAIN = false;
    const float* x; const float* mod; bf16_t* H; PG8_LAS float* ssq; float* out; const float* fgp; float eps;
    __device__ __forceinline__ void operator()(f32x4 (&acc)[2][2][4][2], const Unit& u, int wr, int wc, int fr, int fq) const {
        const int col0 = u.pn * BM + wc * 32 + 8 * fq;
        const int b = (u.pm * BM) >> 12;
        const float* gate = mod + b * 3072 + 2048;
        const bool lastt = u.pn == 3;
        f32x4 gv[2][2];
#pragma unroll
        for (int bj = 0; bj < 2; ++bj)
#pragma unroll
            for (int n = 0; n < 2; ++n) gv[bj][n] = *(const f32x4*)(gate + col0 + bj * HALF + 4 * n);
#pragma unroll
        for (int ai = 0; ai < 2; ++ai)
#pragma unroll
            for (int m = 0; m < 4; ++m) {
                const int rl = ai * HALF + wr * 64 + m * 16 + fr, row = u.pm * BM + rl;
                const size_t off = (size_t)row * 1024 + col0;
                float ss = 0.f;
#pragma unroll
                for (int bj = 0; bj < 2; ++bj) {
                    const f32x4 xa = *(const f32x4*)(x + off + bj * HALF), xb = *(const f32x4*)(x + off + bj * HALF + 4);
                    const f32x4 o0 = xa + gv[bj][0] * acc[ai][bj][m][0], o1 = xb + gv[bj][1] * acc[ai][bj][m][1];
                    if (lastt) { acc[ai][bj][m][0] = o0; acc[ai][bj][m][1] = o1; }
                    else { u32x4 w; w.x = cvt_pk_bf16(o0[0], o0[1]); w.y = cvt_pk_bf16(o0[2], o0[3]); w.z = cvt_pk_bf16(o1[0], o1[1]); w.w = cvt_pk_bf16(o1[2], o1[3]);
                        *(u32x4*)(H + off + bj * HALF) = w; }
                    ss += ((o0[0] * o0[0] + o0[1] * o0[1]) + (o0[2] * o0[2] + o0[3] * o0[3])) + ((o1[0] * o1[0] + o1[1] * o1[1]) + (o1[2] * o1[2] + o1[3] * o1[3]));
                }
                { auto r1 = __builtin_amdgcn_permlane16_swap(__float_as_uint(ss), __float_as_uint(ss), false, false); ss = __uint_as_float(r1[0]) + __uint_as_float(r1[1]);
                  auto r2 = __builtin_amdgcn_permlane32_swap(__float_as_uint(ss), __float_as_uint(ss), false, false); ss = __uint_as_float(r2[0]) + __uint_as_float(r2[1]); }
                if (fq == 0) __hip_atomic_fetch_add(ssq + rl, ss, __ATOMIC_RELAXED, __HIP_MEMORY_SCOPE_WORKGROUP);
                asm volatile("" ::: "memory");
            }
        if (lastt) {
            asm volatile("s_waitcnt lgkmcnt(0)" ::: "memory"); __builtin_amdgcn_s_barrier();
            f32x4 fgv[2][2];
#pragma unroll
            for (int bj = 0; bj < 2; ++bj)
#pragma unroll
                for (int n = 0; n < 2; ++n) fgv[bj][n] = *(const f32x4*)(fgp + col0 + bj * HALF + 4 * n);
#pragma unroll
            for (int ai = 0; ai < 2; ++ai)
#pragma unroll
                for (int m = 0; m < 4; ++m) {
                    const int rl = ai * HALF + wr * 64 + m * 16 + fr;
                    const size_t off = (size_t)(u.pm * BM + rl) * 1024 + col0;
                    const float rs = rsqrtf(ssq[rl] * (1.f / 1024.f) + eps);
#pragma unroll
                    for (int bj = 0; bj < 2; ++bj) { *(f32x4*)(out + off + bj * HALF) = acc[ai][bj][m][0] * rs * fgv[bj][0]; *(f32x4*)(out + off + bj * HALF + 4) = acc[ai][bj][m][1] * rs * fgv[bj][1]; }
                }
        }
    }
};
struct EpiOut {
    static constexpr bool PERM = false, AFTER_DRAIN = false;
    const float* x; const float* mod; float* out; float* sumsq;
    __device__ __forceinline__ void operator()(const f32x4 (&acc)[2][2][4][2], const Unit& u, int wr, int wc, int fr, int fq) const {
        const int col0 = u.pn * BM + wc * 32 + 4 * fq;
        const int b = (u.pm * BM) >> 12;
        const float* gate = mod + b * 3072 + 2048;
        f32x4 gv[2][2];
#pragma unroll
        for (int bj = 0; bj < 2; ++bj)
#pragma unroll
            for (int n = 0; n < 2; ++n) gv[bj][n] = *(const f32x4*)(gate + col0 + bj * HALF + n * 16);
#pragma unroll
        for (int ai = 0; ai < 2; ++ai)
#pragma unroll
            for (int m = 0; m < 4; ++m) {
                const int row = u.pm * BM + ai * HALF + wr * 64 + m * 16 + fr;
                const size_t off = (size_t)row * 1024 + col0;
                float ss = 0.f;
#pragma unroll
                for (int bj = 0; bj < 2; ++bj)
#pragma unroll
                    for (int n = 0; n < 2; ++n) {
                        const f32x4 xv = *(const f32x4*)(x + off + bj * HALF + n * 16);
                        const f32x4 o = xv + gv[bj][n] * acc[ai][bj][m][n];
                        *(f32x4*)(out + off + bj * HALF + n * 16) = o;
                        ss += (o[0] * o[0] + o[1] * o[1]) + (o[2] * o[2] + o[3] * o[3]);
                    }
                ss += __shfl_xor(ss, 16); ss += __shfl_xor(ss, 32);
                if (fq == 0) atomicAdd(sumsq + row, ss);
                asm volatile("" ::: "memory");
            }
    }
};
template <class Epi, class Sched, bool ALIGN_EPI = false, bool SP2 = false>
__device__ __forceinline__ void gemm_phase(PG8_LAS unsigned char* lds, const Gemm g, const Sched& S, const Epi& E, const int wid_in) {
    int lane_o; asm volatile("v_mbcnt_lo_u32_b32 %0, -1, 0\n\tv_mbcnt_hi_u32_b32 %0, -1, %0" : "=v"(lane_o)); const int tid_o = wid_in * 64 + lane_o;
    const int tid = tid_o, wid = wid_in, lane = tid & 63, wr = wid >> 2, wc = wid & 3, fr = lane & 15, fq = lane >> 4;
    const int K = g.K, nt = K / BK;
    unsigned voffA[2], voffB[2];
#pragma unroll
    for (int i = 0; i < 2; ++i) { int R, C; stage_rc(tid * 16 + i * 8192, R, C); const int Rb = Epi::PERM ? ((R & ~31) + perm32(R & 31)) : R;
        voffA[i] = (unsigned)(R * K + C) * 2u; voffB[i] = (unsigned)(Rb * K + C) * 2u; }
    const size_t kstep = (size_t)(BK * 2);
    const size_t hstep = (size_t)HALF * K * 2;
    const size_t tstep = 2 * hstep;
    const unsigned ldsw = (unsigned)wid * 1024u;
    const int aoff = lds_byte(wr * 64 + fr, fq * 8), boff = lds_byte(wc * 32 + fr, fq * 8);
#define PG8_SA(b, h) (((b) * 2 + (h)) * HTB)
#define PG8_SB(b, h) ((4 + (b) * 2 + (h)) * HTB)
#define PG8_STAGE(bufoff, gbase, voff) do { _Pragma("unroll") for (int _i = 0; _i < 2; ++_i) \
        __builtin_amdgcn_global_load_lds((const unsigned*)((const char*)(gbase) + (voff)[_i]), (PG8_LAS unsigned*)(lds + (bufoff) + ldsw + _i * 8192), 16, 0, 0); } while (0)
#define PG8_LDA(dst, b, h) do { _Pragma("unroll") for (int m = 0; m < 4; ++m) _Pragma("unroll") for (int k = 0; k < 2; ++k) dst[m][k] = *(const PG8_LAS bf16x8*)(lds + PG8_SA(b, h) + aoff + m * 2048 + k * 1024); } while (0)
#define PG8_LDB(dst, b, h) do { _Pragma("unroll") for (int n = 0; n < 2; ++n) _Pragma("unroll") for (int k = 0; k < 2; ++k) dst[n][k] = *(const PG8_LAS bf16x8*)(lds + PG8_SB(b, h) + boff + n * 2048 + k * 1024); } while (0)
#define PG8_MMA(ai, bj, At, Bt) do { __builtin_amdgcn_s_setprio(1); _Pragma("unroll") for (int m = 0; m < 4; ++m) _Pragma("unroll") for (int n = 0; n < 2; ++n) _Pragma("unroll") for (int k = 0; k < 2; ++k) \
        acc[ai][bj][m][n] = __builtin_amdgcn_mfma_f32_16x16x32_bf16(Bt[n][k], At[m][k], acc[ai][bj][m][n], 0, 0, 0); __builtin_amdgcn_s_setprio(0); } while (0)
#define PG8_WAIT_V(n) asm volatile("s_waitcnt vmcnt(" #n ")" ::: "memory")
#define PG8_WAIT_L(n) asm volatile("s_waitcnt lgkmcnt(" #n ")" ::: "memory")
#define PG8_BAR __builtin_amdgcn_s_barrier()
#define PG8_SCHED __builtin_amdgcn_sched_barrier(0)
    Unit cur, nxt; int ui = 0;
    if (!S.next(0, cur)) return;
    f32x4 acc[2][2][4][2];
#pragma unroll
    for (int a = 0; a < 2; ++a)
#pragma unroll
        for (int b = 0; b < 2; ++b)
#pragma unroll
            for (int m = 0; m < 4; ++m)
#pragma unroll
                for (int n = 0; n < 2; ++n) acc[a][b][m][n] = (f32x4){0.f, 0.f, 0.f, 0.f};
    bf16x8 At[4][2], B0[2][2], B1[2][2];
    const char* cA = (const char*)g.A + (size_t)cur.pm * tstep; const char* cB = (const char*)g.Bt + (size_t)cur.pn * tstep;
    S.a_ready(cur);
    if constexpr (SP2) {
        PG8_STAGE(PG8_SB(0, 0), cB, voffB); PG8_STAGE(PG8_SB(0, 1), cB + hstep, voffB); PG8_STAGE(PG8_SA(0, 0), cA, voffA); PG8_STAGE(PG8_SA(0, 1), cA + hstep, voffA);
        if (wr == 1) PG8_BAR;
        PG8_WAIT_V(2); PG8_BAR;
        PG8_STAGE(PG8_SB(1, 0), cB + kstep, voffB); PG8_STAGE(PG8_SA(1, 0), cA + kstep, voffA); PG8_STAGE(PG8_SB(1, 1), cB + hstep + kstep, voffB);
        PG8_WAIT_V(6); PG8_BAR;
    } else {
        PG8_STAGE(PG8_SB(0, 0), cB, voffB); PG8_STAGE(PG8_SA(0, 0), cA, voffA); PG8_STAGE(PG8_SB(0, 1), cB + hstep, voffB); PG8_STAGE(PG8_SA(0, 1), cA + hstep, voffA);
        if (wr == 1) PG8_BAR;
        PG8_WAIT_V(4); PG8_BAR;
        PG8_STAGE(PG8_SB(1, 0), cB + kstep, voffB); PG8_STAGE(PG8_SA(1, 0), cA + kstep, voffA); PG8_STAGE(PG8_SB(1, 1), cB + hstep + kstep, voffB);
        PG8_WAIT_V(6); PG8_BAR;
    }
    for (;;) {
        const bool has_next = S.next(ui + 1, nxt);
        const char* nA = has_next ? (const char*)g.A + (size_t)nxt.pm * tstep : cA; const char* nB = has_next ? (const char*)g.Bt + (size_t)nxt.pn * tstep : cB;
        for (int t = 0; t < nt; t += 2) {
            const bool last = (t == nt - 2);
            const char* a1 = cA + (size_t)(t + 1) * kstep;
            const char* a2 = last ? nA : cA + (size_t)(t + 2) * kstep; const char* b2 = last ? nB : cB + (size_t)(t + 2) * kstep;
            const char* a3 = a2 + kstep; const char* b3 = b2 + kstep;
            if (last && has_next) S.a_ready(nxt);
            if constexpr (SP2) {
            PG8_LDB(B0, 0, 0); PG8_LDB(B1, 0, 1); PG8_SCHED; PG8_LDA(At, 0, 0); PG8_STAGE(PG8_SA(1, 1), a1 + hstep, voffA);
            PG8_WAIT_V(8); PG8_WAIT_L(0); PG8_BAR; PG8_MMA(0, 0, At, B0); PG8_MMA(0, 1, At, B1); PG8_BAR; PG8_SCHED;
            PG8_LDA(At, 0, 1); PG8_STAGE(PG8_SB(0, 0), b2, voffB); PG8_STAGE(PG8_SB(0, 1), b2 + hstep, voffB); PG8_STAGE(PG8_SA(0, 0), a2, voffA);
            PG8_WAIT_V(8); PG8_WAIT_L(0); PG8_BAR; PG8_MMA(1, 0, At, B0); PG8_MMA(1, 1, At, B1); PG8_BAR; PG8_SCHED;
            PG8_LDB(B0, 1, 0); PG8_LDB(B1, 1, 1); PG8_SCHED; PG8_LDA(At, 1, 0); PG8_STAGE(PG8_SA(0, 1), a2 + hstep, voffA);
            PG8_WAIT_V(8); PG8_WAIT_L(0); PG8_BAR; PG8_MMA(0, 0, At, B0); PG8_MMA(0, 1, At, B1); PG8_BAR; PG8_SCHED;
            PG8_LDA(At, 1, 1); PG8_STAGE(PG8_SB(1, 0), b3, voffB); PG8_STAGE(PG8_SB(1, 1), b3 + hstep, voffB); PG8_STAGE(PG8_SA(1, 0), a3, voffA);
            PG8_WAIT_V(8); PG8_WAIT_L(0); PG8_BAR; PG8_MMA(1, 0, At, B0); PG8_MMA(1, 1, At, B1); PG8_BAR; PG8_SCHED;
            } else {
            PG8_LDB(B0, 0, 0); PG8_SCHED; PG8_LDA(At, 0, 0); PG8_STAGE(PG8_SA(1, 1), a1 + hstep, voffA);
            PG8_WAIT_L(8); PG8_BAR; PG8_WAIT_L(0); PG8_MMA(0, 0, At, B0); PG8_BAR; PG8_SCHED;
            PG8_LDB(B1, 0, 1); PG8_STAGE(PG8_SB(0, 0), b2, voffB);
            PG8_BAR; PG8_WAIT_L(0); PG8_MMA(0, 1, At, B1); PG8_BAR;
            PG8_LDA(At, 0, 1); PG8_STAGE(PG8_SA(0, 0), a2, voffA);
            PG8_BAR; PG8_WAIT_L(0); PG8_MMA(1, 0, At, B0); PG8_BAR; PG8_SCHED;
            PG8_STAGE(PG8_SB(0, 1), b2 + hstep, voffB);
            PG8_WAIT_V(6); PG8_BAR; PG8_MMA(1, 1, At, B1); PG8_BAR;
            PG8_LDB(B0, 1, 0); PG8_SCHED; PG8_LDA(At, 1, 0); PG8_STAGE(PG8_SA(0, 1), a2 + hstep, voffA);
            PG8_WAIT_L(8); PG8_BAR; PG8_WAIT_L(0); PG8_MMA(0, 0, At, B0); PG8_BAR; PG8_SCHED;
            PG8_LDB(B1, 1, 1); PG8_STAGE(PG8_SB(1, 0), b3, voffB);
            PG8_BAR; PG8_WAIT_L(0); PG8_MMA(0, 1, At, B1); PG8_BAR;
            PG8_LDA(At, 1, 1); PG8_STAGE(PG8_SA(1, 0), a3, voffA);
            PG8_BAR; PG8_WAIT_L(0); PG8_MMA(1, 0, At, B0); PG8_BAR; PG8_SCHED;
            PG8_STAGE(PG8_SB(1, 1), b3 + hstep, voffB);
            PG8_WAIT_V(6); PG8_BAR; PG8_MMA(1, 1, At, B1); PG8_BAR;
            }
        }
        if constexpr (ALIGN_EPI) { if (wr == 0) PG8_BAR; }
        if constexpr (!Epi::AFTER_DRAIN) { E(acc, cur, wr, wc, fr, fq); S.done(cur); }
        if (!has_next) break;
#pragma unroll
        for (int a = 0; a < 2; ++a)
#pragma unroll
            for (int b = 0; b < 2; ++b)
#pragma unroll
                for (int m = 0; m < 4; ++m)
#pragma unroll
                    for (int n = 0; n < 2; ++n) acc[a][b][m][n] = (f32x4){0.f, 0.f, 0.f, 0.f};
        cur = nxt; cA = nA; cB = nB; ++ui;
        if constexpr (ALIGN_EPI) { if (wr == 1) PG8_BAR; }
    }
    PG8_WAIT_V(0);
    if constexpr (!ALIGN_EPI) { if (wr == 0) PG8_BAR; }
    PG8_BAR;
    if constexpr (Epi::AFTER_DRAIN) { E.fused(acc, cur, wr, wc, fr, fq, lds, wid, lane); S.done(cur); }
#undef PG8_SA
#undef PG8_SB
#undef PG8_STAGE
#undef PG8_LDA
#undef PG8_LDB
#undef PG8_MMA
#undef PG8_WAIT_V
#undef PG8_WAIT_L
#undef PG8_BAR
#undef PG8_SCHED
}
}
#define GAS __attribute__((address_space(1)))
#define LAS __attribute__((address_space(3)))
typedef unsigned short bf16;
typedef unsigned v4u __attribute__((ext_vector_type(4)));
typedef float f32x4 __attribute__((ext_vector_type(4)));
typedef short bf16x8 __attribute__((ext_vector_type(8)));
typedef GAS unsigned gu32;
typedef GAS unsigned long long gu64;
#define RLX_AGENT __ATOMIC_RELAXED, __HIP_MEMORY_SCOPE_AGENT
#define LDS_WAIT() asm volatile("s_waitcnt lgkmcnt(0)" ::: "memory")
#define VM_WAIT() asm volatile("s_waitcnt vmcnt(0)" ::: "memory")
__device__ __forceinline__ unsigned long long rt() { return __builtin_amdgcn_s_memrealtime(); }
__device__ __forceinline__ unsigned f2bf(float f) { unsigned u = __builtin_bit_cast(unsigned, f); return (u + 0x7fffu + ((u >> 16) & 1u)) >> 16; }
__device__ __forceinline__ unsigned pk2(float lo, float hi) { return f2bf(lo) | (f2bf(hi) << 16); }

#define XB_TMO      128
#define XB_XCNT(j)  (256  + 64 * (j))
#define XB_XSUB(j)  (1280 + 64 * (j))
#define XB_XGEN(j)  (2304 + 64 * (j))
#define XB_TOP      3328
#define XB_TOPGEN   3392
#define XCD_BAR_WORDS 3456
#define XB_SPIN_CAP (1u << 18)

__device__ __forceinline__ unsigned xb_ld(unsigned* p)              { return __hip_atomic_load(p, __ATOMIC_RELAXED, __HIP_MEMORY_SCOPE_AGENT); }
__device__ __forceinline__ unsigned xb_add(unsigned* p, unsigned v) { return __hip_atomic_fetch_add(p, v, __ATOMIC_RELAXED, __HIP_MEMORY_SCOPE_AGENT); }
__device__ __forceinline__ unsigned xb_xcc_id() { return (unsigned)__builtin_amdgcn_s_getreg((3 << 11) | 20) & 0xFu; }
#define XB_SPIN(cond, bar) do { unsigned _sp = 0; while (cond) { __builtin_amdgcn_s_sleep(1); \
    if ((++_sp & 255u) == 0u) { if (xb_ld(&(bar)[XB_TMO])) break; if (_sp > XB_SPIN_CAP) { atomicAdd(&(bar)[XB_TMO], 1u); break; } } } } while (0)

struct XcdBarrier {
    unsigned* bar; unsigned x; bool t0;
    volatile LAS unsigned* st;
};

__device__ __forceinline__ XcdBarrier xcd_barrier_post(unsigned* bar, volatile LAS unsigned* st, bool t0) {
    XcdBarrier b; b.bar = bar; b.x = xb_xcc_id(); b.st = st; b.t0 = t0;
    if (b.t0) (void)xb_add(&bar[XB_XCNT(b.x)], 1u);
    return b;
}
__device__ __forceinline__ void xcd_barrier_complete(unsigned* bar, unsigned x, unsigned& nloc, unsigned& nx) {
    const unsigned G = gridDim.x * gridDim.y * gridDim.z;
    unsigned sum, cnt, mine, sp = 0u;
    for (;;) {
        sum = 0u; cnt = 0u; mine = 0u;
#pragma unroll
        for (unsigned j = 0; j < 16; ++j) { const unsigned c = xb_ld(&bar[XB_XCNT(j)]); sum += c; cnt += (c > 0u) ? 1u : 0u; mine = (j == x) ? c : mine; }
        if (sum == G) break;
        __builtin_amdgcn_s_sleep(1);
        if ((++sp & 255u) == 0u) { if (xb_ld(&bar[XB_TMO])) break; if (sp > XB_SPIN_CAP) { atomicAdd(&bar[XB_TMO], 1u); break; } }
    }
    nloc = mine > 0u ? mine : 1u; nx = cnt > 0u ? cnt : 1u;
}

__device__ __forceinline__ void xcd_barrier(const XcdBarrier& b) {
    asm volatile("s_waitcnt vmcnt(0)" ::: "memory");
    __syncthreads();
    if (b.t0) {
        unsigned* bar = b.bar;
        __builtin_amdgcn_s_waitcnt(0);
        unsigned nloc = b.st[0], nx = b.st[1];
        if (nloc == 0u) { xcd_barrier_complete(bar, b.x, nloc, nx); b.st[0] = nloc; b.st[1] = nx; }
        const unsigned old = xb_add(&bar[XB_XSUB(b.x)], 1u);
        const unsigned gen = old / nloc;
        if (old + 1u == (gen + 1u) * nloc) {
            __builtin_amdgcn_fence(__ATOMIC_RELEASE, "agent");
            asm volatile("s_waitcnt vmcnt(0)" ::: "memory");
            const unsigned og = xb_add(&bar[XB_TOP], 1u);
            const unsigned tg = og / nx;
            if (og + 1u == (tg + 1u) * nx) xb_add(&bar[XB_TOPGEN], 1u);
            else XB_SPIN(xb_ld(&bar[XB_TOPGEN]) == tg, bar);
            __builtin_amdgcn_fence(__ATOMIC_ACQUIRE, "agent");
            xb_add(&bar[XB_XGEN(b.x)], 1u);
            asm volatile("s_waitcnt vmcnt(0)" ::: "memory");
        } else {
            XB_SPIN(xb_ld(&bar[XB_XGEN(b.x)]) == gen, bar);
            __builtin_amdgcn_fence(__ATOMIC_ACQUIRE, "agent");
            asm volatile("s_waitcnt vmcnt(0)" ::: "memory");
        }
    }
    __syncthreads();
}

constexpr int NWAVES = 8;
constexpr int DM = 1024, NB = 16, SEQ = 4096, CTXL = 256, NH = 8, HD = 64;
constexpr int ML = NB * SEQ;
constexpr int MC = NB * CTXL;
constexpr int MT = ML + MC;
constexpr int PW = 3840;
constexpr int PCW = 1792;
constexpr int PC_NAK = 0, PC_RWK = 512, PC_RWV = 1024, PC_WD = 1536, PC_AD = 1664, PC_RWR = 1792, PC_NAQ = 2304, PC_NAG = 2816, PC_RWG = 3328;
constexpr float RMS_EPS = 1e-6f, GN_EPS = 64e-5f;
constexpr float LOG2E = 1.4426950408889634f;

constexpr size_t MiB = 1u << 20;
constexpr size_t WS_CTL = 0, CTL_ZERO_BYTES = 1 * MiB;
constexpr size_t WS_MOD = 256 * 1024;
constexpr size_t WS_SUMSQ = 512 * 1024;
constexpr size_t WS_WOUT = 2 * MiB;
constexpr size_t WS_WIN = 4 * MiB;
constexpr size_t WS_BONUS = 16 * MiB;
constexpr size_t WS_EDGE = 24 * MiB;
constexpr size_t WS_XN = 32 * MiB;
constexpr size_t WS_P = 168 * MiB;
constexpr size_t WS_VT = 678 * MiB;
constexpr int VTP = MT + 64;
constexpr size_t WS_MIX = 747 * MiB;
constexpr size_t WS_Y = 876 * MiB;
constexpr size_t WS_LFR = 1004 * MiB;
constexpr size_t WS_END = 1012 * MiB;
static_assert(WS_WIN + (size_t)4352 * 1024 * 2 <= WS_BONUS && WS_BONUS + (size_t)ML * 16 * 4 <= WS_XN && WS_XN + (size_t)MT * 1024 * 2 <= WS_P && WS_P + (size_t)MT * PW * 2 <= WS_VT && WS_VT + (size_t)512 * VTP * 2 <= WS_MIX && WS_MIX + (size_t)ML * 1024 * 2 <= WS_END, "ws map");
constexpr int CW_BAR = 4096;

constexpr int LDS_BYTES = 160 * 1024;
constexpr int MISC_OFF = LDS_BYTES - 256;

__device__ __forceinline__ int lane_id_() { int l; asm volatile("v_mbcnt_lo_u32_b32 %0, -1, 0\n\tv_mbcnt_hi_u32_b32 %0, -1, %0" : "=v"(l)); return l; }
struct Frame {
    LAS unsigned char* lds;
    int wave, vcu, G;
    const float *x, *c, *ctx, *c_ctx, *w_mod, *b_mod, *norm_g, *w_in, *conv_w, *decay_w0, *decay_w2, *aaa_a0, *aaa_a2, *k_k, *k_a, *r_k, *gn_w, *gn_b, *na_rpb, *w_out, *final_g;
    float* out; unsigned char* ws;
    float *mod, *sumsq, *bonus;
    bf16 *WoutT, *WinT, *XN, *P, *VT, *MIX, *Y;
};

__device__ __forceinline__ float wave_sum(float v) {
#pragma unroll
    for (int o = 1; o < 64; o <<= 1) v += __shfl_xor(v, o);
    return v;
}
__device__ __forceinline__ float bf2f(unsigned h) { return __uint_as_float(h << 16); }
__device__ __forceinline__ float sigmoidf_(float x) { return __builtin_amdgcn_rcpf(1.f + __builtin_amdgcn_exp2f(-1.4426950408889634f * x)); }
__device__ __forceinline__ float siluf_(float x) { return x * __builtin_amdgcn_rcpf(1.f + __builtin_amdgcn_exp2f(-1.4426950408889634f * x)); }
typedef float f32x16 __attribute__((ext_vector_type(16)));
typedef unsigned u32x2 __attribute__((ext_vector_type(2)));
typedef float f32x2_t __attribute__((ext_vector_type(2))); typedef __bf16 bf16x2_t __attribute__((ext_vector_type(2)));
__device__ __forceinline__ unsigned cvtpk(float lo, float hi) { f32x2_t v = {lo, hi}; bf16x2_t b = __builtin_convertvector(v, bf16x2_t); return __builtin_bit_cast(unsigned, b); }
__device__ __forceinline__ u32x2 pk4(float a, float b, float c, float d) { u32x2 r; r.x = cvtpk(a, b); r.y = cvtpk(c, d); return r; }
template <int CTRL> __device__ __forceinline__ float dpp_mov(float x) { return __builtin_bit_cast(float, __builtin_amdgcn_update_dpp(0, __builtin_bit_cast(int, x), CTRL, 0xf, 0xf, true)); }
__device__ __forceinline__ float red8(float x) { x += dpp_mov<0xB1>(x); x += dpp_mov<0x4E>(x); x += dpp_mov<0x141>(x); return x; }
__device__ __forceinline__ float red16(float x) { x = red8(x); x += dpp_mov<0x140>(x); return x; }
__device__ __forceinline__ float sum32x(float x) { auto rr = __builtin_amdgcn_permlane32_swap(__float_as_uint(x), __float_as_uint(x), false, false); return __uint_as_float(rr[0]) + __uint_as_float(rr[1]); }
__device__ __forceinline__ float max32x(float x) { auto rr = __builtin_amdgcn_permlane32_swap(__float_as_uint(x), __float_as_uint(x), false, false); return fmaxf(__uint_as_float(rr[0]), __uint_as_float(rr[1])); }
__device__ __forceinline__ float sum16x(float x) { auto rr = __builtin_amdgcn_permlane16_swap(__float_as_uint(x), __float_as_uint(x), false, false); return __uint_as_float(rr[0]) + __uint_as_float(rr[1]); }
__device__ __forceinline__ float xlane32(float x, int hh) { auto rr = __builtin_amdgcn_permlane32_swap(__float_as_uint(x), __float_as_uint(x), false, false); return __uint_as_float(hh ? rr[0] : rr[1]); }
__device__ __forceinline__ float xlane16(float x, int godd) { auto rr = __builtin_amdgcn_permlane16_swap(__float_as_uint(x), __float_as_uint(x), false, false); return __uint_as_float(godd ? rr[0] : rr[1]); }

__device__ __forceinline__ void p0_transpose_item(const float* W, int K, int N, bf16* WT, int k0, int n0, int drow0, LAS float* scr, int lane) {
#pragma unroll 8
    for (int i = 0; i < 32; ++i) { const int kk = 2 * i + (lane >> 5); scr[kk * 33 + (lane & 31)] = W[(size_t)(k0 + kk) * N + n0 + (lane & 31)]; }
    LDS_WAIT(); asm volatile("" ::: "memory");
    const int c = lane & 7;
#pragma unroll
    for (int j = 0; j < 4; ++j) { const int n = (lane >> 3) + 8 * j; const LAS float* s = scr + (8 * c) * 33 + n;
        v4u o; o.x = pk2(s[0 * 33], s[1 * 33]); o.y = pk2(s[2 * 33], s[3 * 33]); o.z = pk2(s[4 * 33], s[5 * 33]); o.w = pk2(s[6 * 33], s[7 * 33]);
        *(GAS v4u*)(WT + (size_t)(drow0 + n) * K + k0 + 8 * c) = o; }
    LDS_WAIT(); asm volatile("" ::: "memory");
}
__device__ __forceinline__ void p0_prologue(Frame& F) {
    LAS float* scr = (LAS float*)(F.lds + F.wave * 16384);
    const int gw = F.vcu * NWAVES + F.wave, NGW = F.G * NWAVES, lane = lane_id_();
    for (int it = gw; it < 48 * 32; it += NGW) {
        const int cc = it % 48, ks = it / 48, n = cc * 64 + lane, k0 = ks * 32;
        for (int e = lane; e < 17 * 32; e += 64) { const int row = e >> 5, kk = e & 31; const float cv = (row < 16) ? F.c[row * 1024 + k0 + kk] : F.c_ctx[k0 + kk]; scr[e] = siluf_(cv); }
        LDS_WAIT(); asm volatile("" ::: "memory");
        float acc[17];
#pragma unroll
        for (int r = 0; r < 17; ++r) acc[r] = 0.f;
        for (int kk = 0; kk < 32; ++kk) { const float w = F.w_mod[(size_t)(k0 + kk) * 3072 + n];
#pragma unroll
            for (int r = 0; r < 17; ++r) acc[r] += scr[r * 32 + kk] * w; }
        if (ks == 0) { const float bb = F.b_mod[n];
#pragma unroll
            for (int r = 0; r < 17; ++r) acc[r] += bb; }
#pragma unroll
        for (int r = 0; r < 17; ++r) atomicAdd(F.mod + r * 3072 + n, acc[r]);
        LDS_WAIT(); asm volatile("" ::: "memory");
    }
    constexpr int I_IN = 16 * 136, I_OUT = 16 * 32;
    for (int it = gw; it < I_IN + I_OUT; it += NGW) {
        if (it < I_IN) { const int kb = it / 136, nb = it % 136, n0 = nb * 32; const int drow0 = (n0 < 512) ? n0 : (n0 < 1024 ? n0 + 3328 : n0 - 512);
            p0_transpose_item(F.w_in, 1024, 4352, F.WinT, kb * 64, n0, drow0, scr, lane); }
        else { const int r = it - I_IN, kb = r / 32, nb = r % 32; p0_transpose_item(F.w_out, 1024, 1024, F.WoutT, kb * 64, nb * 32, nb * 32, scr, lane); }
    }
}

__device__ __forceinline__ void p1_xn(Frame& F, const int bb0, const int bb1) {
    const int gw = F.vcu * NWAVES + F.wave, NGW = F.G * NWAVES, lane = lane_id_();
    f32x4 g[4];
#pragma unroll
    for (int j = 0; j < 4; ++j) g[j] = *(const f32x4*)(F.norm_g + 4 * (lane + 64 * j));
    for (int bb = bb0; bb < bb1; ++bb) {
        const float* md = F.mod + bb * 3072;
        f32x4 sh[4], sc[4];
#pragma unroll
        for (int j = 0; j < 4; ++j) { sh[j] = *(const f32x4*)(md + 4 * (lane + 64 * j)); sc[j] = *(const f32x4*)(md + 1024 + 4 * (lane + 64 * j)) + 1.0f; }
        for (int r0 = 2 * gw; r0 < 4096; r0 += 2 * NGW) {
            const size_t m0 = (size_t)bb * 4096 + r0;
            const float* xbase = (bb < 16) ? F.x + m0 * DM : F.ctx + (size_t)r0 * DM;
            f32x4 v[2][4]; float ss[2] = {0.f, 0.f};
#pragma unroll
            for (int u = 0; u < 2; ++u)
#pragma unroll
                for (int j = 0; j < 4; ++j) v[u][j] = *((const GAS f32x4*)(xbase + (size_t)u * DM) + lane + 64 * j);
#pragma unroll
            for (int u = 0; u < 2; ++u) {
#pragma unroll
                for (int j = 0; j < 4; ++j) ss[u] += (v[u][j].x * v[u][j].x + v[u][j].y * v[u][j].y) + (v[u][j].z * v[u][j].z + v[u][j].w * v[u][j].w);
                ss[u] = sum32x(sum16x(red16(ss[u])));
            }
#pragma unroll
            for (int u = 0; u < 2; ++u) {
                const float rstd = rsqrtf(ss[u] * (1.f / DM) + RMS_EPS);
                GAS unsigned long long* o8 = (GAS unsigned long long*)(F.XN + (m0 + u) * DM) + lane;
#pragma unroll
                for (int j = 0; j < 4; ++j) {
                    const f32x4 y = (v[u][j] * rstd * g[j]) * sc[j] + sh[j];
                    o8[64 * j] = (unsigned long long)cvtpk(y.x, y.y) | ((unsigned long long)cvtpk(y.z, y.w) << 32);
                }
            }
        }
    }
}

__device__ __forceinline__ void p1_lat_weighted(Frame& F) {
    const int lane = lane_id_(); const int bx = (int)blockIdx.x;
    const int nrow = bx < 144 ? 18 : 50;
    const int R0 = bx < 144 ? 44800 + (bx * NWAVES + F.wave) * 18 : ((bx - 144) * NWAVES + F.wave) * 50;
    f32x4 g[4];
#pragma unroll
    for (int j = 0; j < 4; ++j) g[j] = *(const f32x4*)(F.norm_g + 4 * (lane + 64 * j));
    f32x4 vn[2][4];
#pragma unroll
    for (int u = 0; u < 2; ++u)
#pragma unroll
        for (int j = 0; j < 4; ++j) vn[u][j] = *((const GAS f32x4*)(F.x + ((size_t)R0 + u) * DM) + lane + 64 * j);
    int bbc = -1; f32x4 sh[4], sc[4];
    for (int r = 0; r < nrow; r += 2) {
        const int R = R0 + r, bb = R >> 12;
        f32x4 v[2][4];
#pragma unroll
        for (int u = 0; u < 2; ++u)
#pragma unroll
            for (int j = 0; j < 4; ++j) v[u][j] = vn[u][j];
        if (r + 2 < nrow) {
#pragma unroll
            for (int u = 0; u < 2; ++u)
#pragma unroll
                for (int j = 0; j < 4; ++j) vn[u][j] = *((const GAS f32x4*)(F.x + ((size_t)R + 2 + u) * DM) + lane + 64 * j);
        }
        if (bb != bbc) { bbc = bb; const float* md = F.mod + bb * 3072;
#pragma unroll
            for (int j = 0; j < 4; ++j) { sh[j] = *(const f32x4*)(md + 4 * (lane + 64 * j)); sc[j] = *(const f32x4*)(md + 1024 + 4 * (lane + 64 * j)) + 1.0f; } }
        float ss[2] = {0.f, 0.f};
#pragma unroll
        for (int u = 0; u < 2; ++u) {
#pragma unroll
            for (int j = 0; j < 4; ++j) ss[u] += (v[u][j].x * v[u][j].x + v[u][j].y * v[u][j].y) + (v[u][j].z * v[u][j].z + v[u][j].w * v[u][j].w);
            ss[u] = sum32x(sum16x(red16(ss[u])));
        }
#pragma unroll
        for (int u = 0; u < 2; ++u) {
            const float rstd = rsqrtf(ss[u] * (1.f / DM) + RMS_EPS);
            GAS unsigned long long* o8 = (GAS unsigned long long*)(F.XN + ((size_t)R + u) * DM) + lane;
#pragma unroll
            for (int j = 0; j < 4; ++j) {
                const f32x4 y = (v[u][j] * rstd * g[j]) * sc[j] + sh[j];
                o8[64 * j] = (unsigned long long)cvtpk(y.x, y.y) | ((unsigned long long)cvtpk(y.z, y.w) << 32);
            }
        }
    }
}

constexpr int AT_SLOT = 18432, AT_VOFF = 9216, AT_NSLOT = 7, AT_WS = AT_NSLOT * AT_SLOT, AT_ROW = 72;
static_assert(AT_WS + 8 * 4096 <= MISC_OFF, "attention LDS map");
__device__ __forceinline__ void p3_attention(Frame& F) {
    LAS unsigned char* L = F.lds;
    LAS float* wsf = (LAS float*)(L + AT_WS + F.wave * 4096);
    LAS float* bt = wsf + 192;
    const int wave = F.wave, lane = lane_id_(), tid = wave * 64 + lane, q = lane & 31, hh = lane >> 5;
    const int ldk = tid >> 3, ldc = tid & 7;
    const float C2 = 0.125f * LOG2E;
    for (int bu = F.vcu * 8; bu < NB * NH * 16; bu += F.G * 8) {
        const int h = (bu >> 4) & 7, b = bu >> 7;
        for (int e = lane; e < 15 * 31; e += 64) bt[e] = F.na_rpb[h * 465 + e] * LOG2E;
        bf16x8 qf[4];
        for (int uu = 0; uu < 8; ++uu) {
            const int band = (bu + uu) & 15, i0 = 4 * band, i = i0 + (wave >> 1), J = wave & 1;
            const int r0 = min(max(i - 4, 0), 56), rmin = min(max(i0 - 4, 0), 56), dl = r0 - rmin;
            const int qc = 32 * J + q, c0 = min(max(qc - 8, 0), 48);
            const size_t qrow = (size_t)(b * SEQ + i * 64 + qc);
            if (uu == 0) {
#pragma unroll
                for (int s = 0; s < 4; ++s) qf[s] = *(const bf16x8*)(F.P + qrow * PW + PC_NAQ + h * 64 + 16 * s + 8 * hh);
            }
            float m_run = -1e30f, l_run = 0.f;
            f32x16 o0, o1;
#pragma unroll
            for (int r = 0; r < 16; ++r) { o0[r] = 0.f; o1[r] = 0.f; }
            const bf16* kgl = F.P + PC_NAK + h * 64 + 8 * ldc;
            const bf16* vgl = F.VT + (size_t)(h * 64 + ldk) * VTP + 8 * ldc;
            if (uu == 0) {
                const size_t tb0 = (size_t)ML + (size_t)b * CTXL;
                const v4u kr = *(const GAS v4u*)(kgl + (tb0 + ldk) * PW), vr = *(const GAS v4u*)(vgl + tb0);
                *(LAS v4u*)(L + 5 * AT_SLOT + (ldk * AT_ROW + 8 * ldc) * 2) = kr; *(LAS v4u*)(L + 5 * AT_SLOT + AT_VOFF + (ldk * AT_ROW + 8 * ldc) * 2) = vr;
            }
            asm volatile("" : "+v"(qf[0]), "+v"(qf[1]), "+v"(qf[2]), "+v"(qf[3]));
            if (uu == 0) __syncthreads();
            for (int ph = 0; ph < 8; ++ph) {
                v4u kreg[2], vreg[2]; int nslot[2]; bool nval[2];
#pragma unroll
                for (int x = 0; x < 2; ++x) {
                    const unsigned ktab = x == 0 ? 0xF9753FFFu : 0xFA864210u;
                    const int k = (int)((ktab >> (4 * ph)) & 15u), chunk = (ph + 1) & 7;
                    const bool cload = x == 0 && (ph < 3 || (ph == 7 && uu < 7));
                    const bool lload = k != 15 && rmin + k < 64;
                    nval[x] = cload || lload;
                    nslot[x] = cload ? 5 + (chunk & 1) : (k < 7 ? k : k - 7);
                    const size_t tb = cload ? (size_t)ML + (size_t)b * CTXL + 64 * chunk : (size_t)b * SEQ + 64 * (rmin + (k & 15));
                    if (nval[x]) { kreg[x] = *(const GAS v4u*)(kgl + (tb + ldk) * PW); vreg[x] = *(const GAS v4u*)(vgl + tb); }
                }
                const bool isctx = ph < 4;
                const int p = ph - 4;
                {
                    const int ka = dl + 2 * p;
                    const int sA = isctx ? 5 + (ph & 1) : ka % 7, sB = isctx ? sA : (ka + 1) % 7;
                    const int ntile = isctx ? 2 : 3;
                    f32x16 scs[3];
                    {
                        bf16x8 kf[3][4];
#pragma unroll
                        for (int tile = 0; tile < 3; ++tile) {
                            if (tile >= ntile) break;
                            const int cb = J + tile;
                            const LAS bf16* kp = isctx ? (const LAS bf16*)(L + sA * AT_SLOT) + (32 * tile + q) * AT_ROW + 8 * hh
                                                       : (const LAS bf16*)(L + ((q >> 4) ? sB : sA) * AT_SLOT) + (16 * cb + (q & 15)) * AT_ROW + 8 * hh;
#pragma unroll
                            for (int s = 0; s < 4; ++s) kf[tile][s] = *(const LAS bf16x8*)(kp + 16 * s);
                        }
                        __builtin_amdgcn_sched_barrier(0);
#pragma unroll
                        for (int tile = 0; tile < 3; ++tile) {
                            if (tile >= ntile) break;
#pragma unroll
                            for (int r = 0; r < 16; ++r) scs[tile][r] = 0.f;
#pragma unroll
                            for (int s = 0; s < 4; ++s) scs[tile] = __builtin_amdgcn_mfma_f32_32x32x16_bf16(kf[tile][s], qf[s], scs[tile], 0, 0, 0);
                        }
                    }
                    if (ph == 7 && uu < 7) {
                        const size_t qrow_n = (size_t)(b * SEQ + (i + 4) * 64 + qc);
#pragma unroll
                        for (int s = 0; s < 4; ++s) qf[s] = *(const bf16x8*)(F.P + qrow_n * PW + PC_NAQ + h * 64 + 16 * s + 8 * hh);
                    }
                    float tmax = -1e30f;
                    if (isctx) {
#pragma unroll
                        for (int tile = 0; tile < 2; ++tile)
#pragma unroll
                            for (int r = 0; r < 16; ++r) { scs[tile][r] *= C2; tmax = fmaxf(tmax, scs[tile][r]); }
                    } else {
                        float bvv[3][2][8];
#pragma unroll
                        for (int tile = 0; tile < 3; ++tile) {
                            const LAS float* bp = bt + (rmin + ka - i + 7) * 31 + 16 * (J + tile) - qc + 15 + 4 * hh;
#pragma unroll
                            for (int hf = 0; hf < 2; ++hf)
#pragma unroll
                                for (int r = 0; r < 8; ++r) bvv[tile][hf][r] = bp[31 * hf + (r & 3) + 8 * ((r >> 2) & 1)];
                        }
#pragma unroll
                        for (int tile = 0; tile < 3; ++tile)
#pragma unroll
                            for (int hf = 0; hf < 2; ++hf)
                                asm volatile("" : "+v"(bvv[tile][hf][0]), "+v"(bvv[tile][hf][1]), "+v"(bvv[tile][hf][2]), "+v"(bvv[tile][hf][3]), "+v"(bvv[tile][hf][4]), "+v"(bvv[tile][hf][5]), "+v"(bvv[tile][hf][6]), "+v"(bvv[tile][hf][7]));
#pragma unroll
                        for (int tile = 0; tile < 3; ++tile) {
                            const int t0 = 16 * (J + tile) - c0 + 4 * hh;
#pragma unroll
                            for (int hf = 0; hf < 2; ++hf)
#pragma unroll
                                for (int r = 0; r < 8; ++r) {
                                    const int co = (r & 3) + 8 * ((r >> 2) & 1);
                                    const bool valid = (unsigned)(t0 + co) < 16u;
                                    const float val = valid ? scs[tile][8 * hf + r] * C2 + bvv[tile][hf][r] : -1e30f;
                                    scs[tile][8 * hf + r] = val; tmax = fmaxf(tmax, val);
                                }
                        }
                    }
                    tmax = max32x(tmax);
                    {
                        const float m_new = fmaxf(m_run, tmax), alpha = __builtin_amdgcn_exp2f(m_run - m_new);
                        m_run = m_new; l_run *= alpha;
#pragma unroll
                        for (int r = 0; r < 16; ++r) { o0[r] *= alpha; o1[r] *= alpha; }
                    }
#pragma unroll
                    for (int tile = 0; tile < 3; ++tile) {
                        if (tile >= ntile) break;
                        const int cb = J + tile;
                        bf16x8 vf[2][2];
#pragma unroll
                        for (int db = 0; db < 2; ++db)
#pragma unroll
                            for (int s = 0; s < 2; ++s) {
                                const LAS bf16* vp = isctx ? (const LAS bf16*)(L + sA * AT_SLOT + AT_VOFF) + (32 * db + q) * AT_ROW + 32 * tile + 16 * s + 4 * hh
                                                           : (const LAS bf16*)(L + (s ? sB : sA) * AT_SLOT + AT_VOFF) + (32 * db + q) * AT_ROW + 16 * cb + 4 * hh;
                                const u32x2 lo = *(const LAS u32x2*)vp, hi = *(const LAS u32x2*)(vp + 8);
                                v4u w; w.x = lo.x; w.y = lo.y; w.z = hi.x; w.w = hi.y;
                                vf[db][s] = __builtin_bit_cast(bf16x8, w);
                            }
                        float psum = 0.f; f32x16 sc;
#pragma unroll
                        for (int r = 0; r < 16; ++r) { sc[r] = __builtin_amdgcn_exp2f(scs[tile][r] - m_run); psum += sc[r]; }
                        l_run += psum;
                        bf16x8 pa[2];
#pragma unroll
                        for (int s = 0; s < 2; ++s) { v4u w; w.x = cvtpk(sc[8 * s + 0], sc[8 * s + 1]); w.y = cvtpk(sc[8 * s + 2], sc[8 * s + 3]); w.z = cvtpk(sc[8 * s + 4], sc[8 * s + 5]); w.w = cvtpk(sc[8 * s + 6], sc[8 * s + 7]); pa[s] = __builtin_bit_cast(bf16x8, w); }
#pragma unroll
                        for (int s = 0; s < 2; ++s) { o0 = __builtin_amdgcn_mfma_f32_32x32x16_bf16(vf[0][s], pa[s], o0, 0, 0, 0); o1 = __builtin_amdgcn_mfma_f32_32x32x16_bf16(vf[1][s], pa[s], o1, 0, 0, 0); }
                    }
                }
#pragma unroll
                for (int x = 0; x < 2; ++x) if (nval[x]) {
                    *(LAS v4u*)(L + nslot[x] * AT_SLOT + (ldk * AT_ROW + 8 * ldc) * 2) = kreg[x]; *(LAS v4u*)(L + nslot[x] * AT_SLOT + AT_VOFF + (ldk * AT_ROW + 8 * ldc) * 2) = vreg[x]; }
                __syncthreads();
            }
            const float inv = 1.f / sum32x(l_run);
            {
                const int erow = lane_id_() >> 3, epc = lane_id_() & 7;
                const size_t tq0 = (size_t)(b * SEQ + i * 64 + 32 * J);
                v4u gv[4];
#pragma unroll
                for (int ps = 0; ps < 4; ++ps) gv[ps] = *(const GAS v4u*)(F.P + (tq0 + 8 * ps + erow) * PW + PC_NAG + h * 64 + 8 * epc);
                LAS bf16* TO = (LAS bf16*)(L + wave * 4608);
#pragma unroll
                for (int db = 0; db < 2; ++db)
#pragma unroll
                    for (int gg = 0; gg < 4; ++gg) {
                        const int d0 = 32 * db + 8 * gg + 4 * hh;
                        float o[4];
#pragma unroll
                        for (int e = 0; e < 4; ++e) o[e] = (db ? o1[4 * gg + e] : o0[4 * gg + e]) * inv;
                        *(LAS u32x2*)(TO + q * 72 + d0) = pk4(o[0], o[1], o[2], o[3]);
                    }
                LDS_WAIT(); asm volatile("" ::: "memory");
#pragma unroll
                for (int ps = 0; ps < 4; ++ps) {
                    const v4u ov = *(const LAS v4u*)(TO + (8 * ps + erow) * 72 + 8 * epc);
                    v4u w;
#pragma unroll
                    for (int e2 = 0; e2 < 4; ++e2) {
                        const float oa = __uint_as_float(ov[e2] << 16), ob = __uint_as_float(ov[e2] & 0xffff0000u), ga = __uint_as_float(gv[ps][e2] << 16), gb = __uint_as_float(gv[ps][e2] & 0xffff0000u);
                        w[e2] = cvtpk(oa * siluf_(ga), ob * siluf_(gb));
                    }
                    *(GAS v4u*)(F.MIX + (tq0 + 8 * ps + erow) * DM + h * 64 + 8 * epc) = w;
                }
            }
            __syncthreads();
        }
    }
}

constexpr int SX_KC = 0, SX_VC = 16384, SX_RC = 24576, SX_TW = 32768, SX_AD = 41984, SX_INVN = 51200;
constexpr int SX_NBAT = 0, SX_NKA = 8192, SX_QBRT = 13312, SX_QKRT = 18432, SX_TT = 27648, SX_G = 32768, SX_M = 43008, SX_E1T = 48128, SX_ZT = 57344;
constexpr int SY0 = 62464, SY_AB = SY0, SY_BB = SY0 + 9216, SY_KB = SY0 + 18432, SY_RB = SY0 + 27648, SY_PCT = SY0;
constexpr int SZ0 = 99328, SZ_ABT = SZ0, SZ_BCT = SZ0 + 10240, SZ_KCT = SZ0 + 20480, SZ_VT = SZ0 + 30720, SZ_DCT = SZ0;
constexpr int SS_ST = 140288  , SM_GC = 158720, SM_BON = SM_GC + 512, SCAN_LDS_END = SM_BON + 256;
constexpr int SC_CW = SCAN_LDS_END;
constexpr int SC_RAW = 52224;
constexpr int SC_BONP = 53504;
static_assert(SC_CW + 4096 <= MISC_OFF && SC_RAW + 1280 <= SC_BONP && SC_BONP + 1024 <= SX_ZT, "scan LDS map");
constexpr int TS = 72, CS = 40;

template <int NK> __device__ __forceinline__ f32x16 tile_mm(const LAS bf16* xrow, const LAS bf16* yrow) {
    f32x16 acc;
#pragma unroll
    for (int r = 0; r < 16; ++r) acc[r] = 0.f;
#pragma unroll
    for (int s = 0; s < NK; ++s) acc = __builtin_amdgcn_mfma_f32_32x32x16_bf16(*(const LAS bf16x8*)(xrow + 16 * s), *(const LAS bf16x8*)(yrow + 16 * s), acc, 0, 0, 0);
    return acc;
}

typedef short bf16x4 __attribute__((ext_vector_type(4)));

template <bool ISP> __device__ __forceinline__ void f_tile(const LAS bf16* X, const LAS bf16* Y, const LAS bf16* Bp, LAS bf16* Op, const float gcv, const int dj, const int hh) {
    bf16x4 bvv[4];
    if (!ISP) {
#pragma unroll
        for (int gg = 0; gg < 4; ++gg) bvv[gg] = *(const LAS bf16x4*)(Bp + 8 * gg);
    }
    const f32x16 acc = tile_mm<2>(X, Y);
#pragma unroll
    for (int gg = 0; gg < 4; ++gg) {
        const int r0 = 8 * gg + 4 * hh;
        float o[4];
#pragma unroll
        for (int e = 0; e < 4; ++e) { const float base = ISP ? ((r0 + e) == dj ? gcv : 0.f) : bf2f((unsigned short)bvv[gg][e]); o[e] = base - acc[4 * gg + e]; }
        *(LAS u32x2*)(Op + r0) = pk4(o[0], o[1], o[2], o[3]);
    }
}
__device__ __forceinline__ v4u patch8(const v4u c, const v4u e, const LAS float* w) {
    const f32x4 wa = *(const LAS f32x4*)w, wb = *(const LAS f32x4*)(w + 4);
    v4u o;
#pragma unroll
    for (int e2 = 0; e2 < 4; ++e2) {
        const float wl = e2 < 2 ? wa[2 * e2] : wb[2 * e2 - 4], wh = e2 < 2 ? wa[2 * e2 + 1] : wb[2 * e2 - 3];
        o[e2] = cvtpk(__uint_as_float(c[e2] << 16) + wl * __uint_as_float(e[e2] << 16), __uint_as_float(c[e2] & 0xffff0000u) + wh * __uint_as_float(e[e2] & 0xffff0000u));
    }
    return o;
}
__device__ __forceinline__ void scan_a2(LAS unsigned char* L, const int wave, const int d, const bool lat_, const int p0_, v4u c0, v4u c1, v4u c2, v4u c3, v4u c4, const v4u prh) {
    const int lane_ = lane_id_(); const int tt = 8 * wave + (lane_ >> 3), nn = lane_ & 7;
    LAS float* KC = (LAS float*)(L + SX_KC); LAS bf16* VC = (LAS bf16*)(L + SX_VC); LAS bf16* RC = (LAS bf16*)(L + SX_RC);
    LAS bf16* TW = (LAS bf16*)(L + SX_TW); LAS bf16* AD = (LAS bf16*)(L + SX_AD); LAS float* INVN = (LAS float*)(L + SX_INVN); LAS float* BON = (LAS float*)(L + SM_BON);
    const LAS float* CW = (const LAS float*)(L + SC_CW);
    if ((wave == 0 || wave == 7) && lat_) {
        const int ttp = wave ? 63 : 0, idxp = d ? (SEQ - 1 - p0_ - ttp) : p0_ + ttp, em = idxp & 255;
        const bool np = em == 0 && idxp > 0, nx = em == 255 && idxp < SEQ - 1;
        if (np || nx) {
            LAS bf16* PT = (LAS bf16*)(L + SC_RAW) + (wave ? 320 : 0);
            if (lane_ < 40) *(LAS v4u*)(PT + lane_ * 8) = prh;
            asm volatile("s_waitcnt lgkmcnt(0)" ::: "memory");
            if (tt == ttp) {
                const LAS float* cw = CW + (np ? 0 : 640) + 8 * nn;
                c0 = patch8(c0, *(const LAS v4u*)(PT + 0 * 64 + 8 * nn), cw + 0 * 64); c1 = patch8(c1, *(const LAS v4u*)(PT + 1 * 64 + 8 * nn), cw + 1 * 64); c2 = patch8(c2, *(const LAS v4u*)(PT + 2 * 64 + 8 * nn), cw + 2 * 64);
                c3 = patch8(c3, *(const LAS v4u*)(PT + 3 * 64 + 8 * nn), cw + 3 * 64); c4 = patch8(c4, *(const LAS v4u*)(PT + 4 * 64 + 8 * nn), cw + 4 * 64);
            }
        }
    }
    {
        const f32x4 ka = *(const LAS f32x4*)(CW + 960 + 8 * nn), kb = *(const LAS f32x4*)(CW + 960 + 8 * nn + 4);
        float u[8]; float ss = 0.f;
#pragma unroll
        for (int e2 = 0; e2 < 4; ++e2) { u[2 * e2] = __uint_as_float(c0[e2] << 16); u[2 * e2 + 1] = __uint_as_float(c0[e2] & 0xffff0000u); }
#pragma unroll
        for (int e = 0; e < 8; ++e) { const float kq = u[e] * (e < 4 ? ka[e] : kb[e - 4]); ss += kq * kq; }
        *(LAS f32x4*)(KC + tt * 64 + 8 * nn) = (f32x4){u[0], u[1], u[2], u[3]}; *(LAS f32x4*)(KC + tt * 64 + 8 * nn + 4) = (f32x4){u[4], u[5], u[6], u[7]};
        ss = red8(ss);
        if (nn == 0) INVN[tt] = rsqrtf(fmaxf(ss, 1e-24f));
    }
    *(LAS v4u*)(VC + tt * 64 + 8 * nn) = c1;
    *(LAS v4u*)(RC + tt * 64 + 8 * nn) = c2;
    if (wave == 0 || wave == 7) {
        const int pos_ = p0_ + tt, idx_ = d ? ((lat_ ? SEQ : CTXL) - 1 - pos_) : pos_, em = idx_ & 255;
        if (em == 0 || em == 255) {
#pragma unroll
            for (int e2 = 0; e2 < 4; ++e2) {
                const float ta = __builtin_amdgcn_exp2f(__uint_as_float(c3[e2] << 16) * (2.f * LOG2E)), tb = __builtin_amdgcn_exp2f(__uint_as_float(c3[e2] & 0xffff0000u) * (2.f * LOG2E));
                c3[e2] = cvtpk(1.f - 2.f * __builtin_amdgcn_rcpf(ta + 1.f), 1.f - 2.f * __builtin_amdgcn_rcpf(tb + 1.f));
            }
        }
    }
    *(LAS v4u*)(TW + tt * TS + 8 * nn) = c3;
    *(LAS v4u*)(AD + tt * TS + 8 * nn) = c4;
}
__device__ __forceinline__ void p4_scan(Frame& F) {
    if (F.vcu >= NB * NH * 2) return;
    const int chain = F.vcu, d = chain & 1, h = (chain >> 1) & 7, b = chain >> 4;
    const int wave = F.wave, lane = lane_id_(), tid = wave * 64 + lane;
    LAS unsigned char* L = F.lds;
    LAS float* KC = (LAS float*)(L + SX_KC); LAS bf16* VC = (LAS bf16*)(L + SX_VC); LAS bf16* RC = (LAS bf16*)(L + SX_RC);
    LAS bf16* TW = (LAS bf16*)(L + SX_TW); LAS bf16* AD = (LAS bf16*)(L + SX_AD); LAS float* INVN = (LAS float*)(L + SX_INVN);
    LAS float* NBAT = (LAS float*)(L + SX_NBAT); LAS bf16* NKA = (LAS bf16*)(L + SX_NKA); LAS bf16* QBRT = (LAS bf16*)(L + SX_QBRT); LAS bf16* QKRT = (LAS bf16*)(L + SX_QKRT);
    LAS bf16* TT = (LAS bf16*)(L + SX_TT); LAS bf16* GG = (LAS bf16*)(L + SX_G); LAS bf16* MM = (LAS bf16*)(L + SX_M); LAS bf16* E1T = (LAS bf16*)(L + SY_KB);       LAS bf16* ZT = (LAS bf16*)(L + SX_ZT);
    LAS bf16* AB = (LAS bf16*)(L + SY_AB); LAS bf16* BB = (LAS bf16*)(L + SY_BB); LAS bf16* KB = (LAS bf16*)(L + SY_KB); LAS bf16* RB = (LAS bf16*)(L + SY_RB); LAS bf16* PCT = (LAS bf16*)(L + SY_PCT);
    LAS bf16* ABT = (LAS bf16*)(L + SZ_ABT); LAS bf16* BCT = (LAS bf16*)(L + SZ_BCT); LAS bf16* KCT = (LAS bf16*)(L + SZ_KCT); LAS bf16* VT = (LAS bf16*)(L + SZ_VT); LAS bf16* DCT = (LAS bf16*)(L + SZ_DCT);
    LAS bf16* SST = (LAS bf16*)(L + SS_ST); LAS float* GC = (LAS float*)(L + SM_GC); LAS float* BON = (LAS float*)(L + SM_BON); LAS float* BONP = (LAS float*)(L + SC_BONP);
    LAS float* CW = (LAS float*)(L + SC_CW);
    if (tid < 64) CW[960 + tid] = F.k_k[h * 64 + tid];
    for (int e = tid; e < 960; e += 512) { const int tap = e / 320, g = (e % 320) >> 6, c = e & 63;
        const int col = (g == 0 ? PC_RWK + h * 64 : g == 1 ? PC_RWV + h * 64 : g == 2 ? PC_RWR + h * 64 : g == 3 ? PC_WD + d * 64 : PC_AD + d * 64) + c;
        CW[e] = F.conv_w[tap * 1792 + col - 512]; }
    bf16x8 bwf[2], baf[2];
    { const int n_ = lane & 15, g_ = lane >> 4, cj_ = h * 64 + 16 * (wave & 3) + n_;
#pragma unroll
      for (int s2 = 0; s2 < 2; ++s2) { v4u ww, wa;
#pragma unroll
        for (int e2 = 0; e2 < 4; ++e2) { const int r0_ = 32 * s2 + 8 * g_ + 2 * e2;
            ww[e2] = cvtpk(F.decay_w2[((size_t)d * 64 + r0_) * 512 + cj_], F.decay_w2[((size_t)d * 64 + r0_ + 1) * 512 + cj_]);
            wa[e2] = cvtpk(F.aaa_a2[((size_t)d * 64 + r0_) * 512 + cj_], F.aaa_a2[((size_t)d * 64 + r0_ + 1) * 512 + cj_]); }
        bwf[s2] = __builtin_bit_cast(bf16x8, ww); baf[s2] = __builtin_bit_cast(bf16x8, wa); } }
    GAS v4u* lfr = (GAS v4u*)(F.ws + WS_LFR) + ((size_t)chain * 512 + tid) * 4;
    lfr[0] = __builtin_bit_cast(v4u, bwf[0]); lfr[1] = __builtin_bit_cast(v4u, bwf[1]); lfr[2] = __builtin_bit_cast(v4u, baf[0]); lfr[3] = __builtin_bit_cast(v4u, baf[1]);
    v4u lfrv[4] = {__builtin_bit_cast(v4u, bwf[0]), __builtin_bit_cast(v4u, bwf[1]), __builtin_bit_cast(v4u, baf[0]), __builtin_bit_cast(v4u, baf[1])};
    const int cjp_ = h * 64 + 16 * (wave & 3) + (lane & 15);
    const float w0 = F.decay_w0[d * 512 + cjp_], a0v = F.aaa_a0[d * 512 + cjp_], kkc = F.k_k[cjp_], kac = F.k_a[cjp_], rkc = F.r_k[cjp_];
    for (int e = tid; e < 2 * 64 * TS / 2; e += 512) ((LAS unsigned*)SST)[e] = 0u;
    int scur = 0;
#define SCAN_A_GEOM(SCN) const int sn_ = (SCN); const bool lat_ = sn_ >= 4; const int Lq_ = lat_ ? SEQ : CTXL; \
        const size_t rb_ = lat_ ? (size_t)b * SEQ : (size_t)ML + (size_t)b * CTXL; const int p0_ = lat_ ? sn_ * 64 - 256 : sn_ * 64; \
        const int tid_ = wave * 64 + lane_id_(); const int tt = tid_ >> 3, nn = tid_ & 7; \
        const int pos_ = p0_ + tt, idx_ = d ? (Lq_ - 1 - pos_) : pos_, lo_ = d ? (Lq_ - 64 - p0_) : p0_;
#define SCAN_COL(g) ((g) == 0 ? PC_RWK + hc_ : (g) == 1 ? PC_RWV + hc_ : (g) == 2 ? PC_RWR + hc_ : (g) == 3 ? PC_WD + dc_ : PC_AD + dc_)
#define SCAN_A_LOAD(SCN) do { SCAN_A_GEOM(SCN) int hc_ = h * 64, dc_ = d * 64; asm volatile("" : "+v"(hc_), "+v"(dc_));     \
        const bf16* prow = F.P + (rb_ + idx_) * PW; const v4u z = {0u, 0u, 0u, 0u}; \
        _Pragma("unroll") for (int g = 0; g < 5; ++g) { if (g == 2 && !lat_) prc[g] = z; else prc[g] = *(const GAS v4u*)(prow + SCAN_COL(g) + 8 * nn); } \
        prh = z; if ((wave == 0 || wave == 7) && lat_) { const int l_ = tid_ & 63, idxp_ = d ? (Lq_ - 1 - p0_ - (wave ? 63 : 0)) : p0_ + (wave ? 63 : 0), em_ = idxp_ & 255;        \
            const bool np_ = em_ == 0 && idxp_ > 0, nx_ = em_ == 255 && idxp_ < SEQ - 1; \
            if (l_ < 40 && (np_ || nx_)) { const int tl_ = (int)((rb_ + idxp_) >> 8), hg_ = l_ >> 3; \
                int colh_ = ((hg_ == 0) ? 0 : (hg_ == 1) ? 512 : (hg_ == 2) ? 1280 : (hg_ == 3) ? 1024 : 1152) + ((hg_ < 3) ? h : d) * 64 + 8 * nn; asm volatile("" : "+v"(colh_)); \
                prh = *(const GAS v4u*)((const bf16*)(F.ws + WS_EDGE) + (size_t)((np_ ? tl_ - 1 : tl_ + 1) * 2 + (np_ ? 1 : 0)) * 1792 + colh_); } } } while (0)
    { v4u prc[5], prh;
    SCAN_A_LOAD(0);
    __syncthreads();
    scan_a2(L, wave, d, false, 0, prc[0], prc[1], prc[2], prc[3], prc[4], prh); }
    __syncthreads();
    for (int sc = 0; sc < 68; ++sc) {
        const bool lat = sc >= 4;
        const int Lq = lat ? SEQ : CTXL;
        const size_t rbase = lat ? (size_t)b * SEQ : (size_t)ML + (size_t)b * CTXL;
        const int pos0 = lat ? sc * 64 - 256 : sc * 64;
        {
            const int lane_ = lane_id_();
            const int q = wave >> 2, cb = wave & 3, n = lane_ & 15, g = lane_ >> 4, j = 16 * cb + n, cj = h * 64 + j;
            int bo64 = (32 * q + 4 * g) * 64 + j, boTS = (32 * q + 4 * g) * TS + j; asm volatile("" : "+v"(bo64), "+v"(boTS));
            const LAS float* KCb = KC + bo64; const LAS unsigned short* VCu = (const LAS unsigned short*)VC + bo64; const LAS unsigned short* RCu = (const LAS unsigned short*)RC + bo64; const LAS float* INb = INVN + 32 * q + 4 * g;
            f32x2_t kq_[2][2], iq_[2][2]; unsigned vr_[2][4], rr_[2][4];
#pragma unroll
            for (int tb = 0; tb < 2; ++tb)
#pragma unroll
                for (int ep = 0; ep < 2; ++ep) { const int so = 16 * tb + 2 * ep;
                    kq_[tb][ep] = (f32x2_t){KCb[so * 64], KCb[(so + 1) * 64]};
                    vr_[tb][2 * ep] = VCu[so * 64]; vr_[tb][2 * ep + 1] = VCu[(so + 1) * 64];
                    rr_[tb][2 * ep] = RCu[so * 64]; rr_[tb][2 * ep + 1] = RCu[(so + 1) * 64];
                    iq_[tb][ep] = *(const LAS f32x2_t*)(INb + so); }
            f32x4 accW[2], accA[2];
#pragma unroll
            for (int tb = 0; tb < 2; ++tb) {
                accW[tb] = (f32x4){0.f, 0.f, 0.f, 0.f}; accA[tb] = (f32x4){0.f, 0.f, 0.f, 0.f};
#pragma unroll
                for (int s = 0; s < 2; ++s) {
                    const bf16x8 atw = *(const LAS bf16x8*)(TW + (32 * q + 16 * tb + n) * TS + 32 * s + 8 * g), aad = *(const LAS bf16x8*)(AD + (32 * q + 16 * tb + n) * TS + 32 * s + 8 * g);
                    const bf16x8 bw = __builtin_bit_cast(bf16x8, lfrv[s]), ba = __builtin_bit_cast(bf16x8, lfrv[2 + s]);
                    accW[tb] = __builtin_amdgcn_mfma_f32_16x16x32_bf16(atw, bw, accW[tb], 0, 0, 0);
                    accA[tb] = __builtin_amdgcn_mfma_f32_16x16x32_bf16(aad, ba, accA[tb], 0, 0, 0);
                }
            }
            float w0_ = w0, a0v_ = a0v, kkc_ = kkc, kac_ = kac, rkc_ = rkc; asm volatile("" : "+v"(w0_), "+v"(a0v_), "+v"(kkc_), "+v"(kac_), "+v"(rkc_));
            float lw[2][4], cl[2][4];
            float sA = 0.f, sB = 0.f;
#pragma unroll
            for (int tb = 0; tb < 2; ++tb)
#pragma unroll
                for (int ep = 0; ep < 2; ++ep) {
                    const f32x2_t aw = {accW[tb][2 * ep], accW[tb][2 * ep + 1]};
                    const f32x2_t arg = aw * (-LOG2E) + (-LOG2E * w0_);
                    f32x2_t den; den.x = __builtin_amdgcn_exp2f(arg.x); den.y = __builtin_amdgcn_exp2f(arg.y); den = den + 1.f;
                    lw[tb][2 * ep] = (-0.6065306597126334f * LOG2E) * __builtin_amdgcn_rcpf(den.x); lw[tb][2 * ep + 1] = (-0.6065306597126334f * LOG2E) * __builtin_amdgcn_rcpf(den.y);
                }
#pragma unroll
            for (int e = 0; e < 4; ++e) { sA += lw[0][e]; cl[0][e] = sA; sB += lw[1][e]; cl[1][e] = sB; }
            float pairA, pairB, totA, totB;
            { auto s1 = __builtin_amdgcn_permlane16_swap(__float_as_uint(sA), __float_as_uint(sA), false, false); pairA = __uint_as_float(s1[0]) + __uint_as_float(s1[1]);
              auto s2 = __builtin_amdgcn_permlane32_swap(__float_as_uint(pairA), __float_as_uint(pairA), false, false); totA = __uint_as_float(s2[0]) + __uint_as_float(s2[1]);
              auto s3 = __builtin_amdgcn_permlane16_swap(__float_as_uint(sB), __float_as_uint(sB), false, false); pairB = __uint_as_float(s3[0]) + __uint_as_float(s3[1]);
              auto s4 = __builtin_amdgcn_permlane32_swap(__float_as_uint(pairB), __float_as_uint(pairB), false, false); totB = __uint_as_float(s4[0]) + __uint_as_float(s4[1]); }
            const float m1 = (float)(g & 1), m2 = (float)(g >> 1);
            const float offA = m1 * (pairA - sA) + m2 * (totA - pairA);
            const float offB = totA + m1 * (pairB - sB) + m2 * (totB - pairB);
            const float clC = totA + totB, gC = __builtin_amdgcn_exp2f(clC);
            if (g == 0) GC[q * 64 + j] = gC;
            LAS unsigned short* ABu = (LAS unsigned short*)AB + boTS; LAS unsigned short* BBu = (LAS unsigned short*)BB + boTS; LAS unsigned short* KBu = (LAS unsigned short*)KB + boTS; LAS unsigned short* RBu = (LAS unsigned short*)RB + boTS;
            float bon[2][4];
#pragma unroll
            for (int tb = 0; tb < 2; ++tb) {
                const float offT = tb ? offB : offA;
                u32x2 alp, bcp, kcp, vtp;
                float gprev = 0.f;
#pragma unroll
                for (int ep = 0; ep < 2; ++ep) {
                    const int e0 = 2 * ep, so = 16 * tb + e0;
                    const f32x2_t c = (f32x2_t){cl[tb][e0], cl[tb][e0 + 1]} + offT;
                    f32x2_t gt; gt.x = __builtin_amdgcn_exp2f(c.x); gt.y = __builtin_amdgcn_exp2f(c.y);
                    f32x2_t gm1; gm1.x = ep ? gprev : __builtin_amdgcn_exp2f(c.x - lw[tb][0]); gm1.y = gt.x; gprev = gt.y;
                    f32x2_t ig; ig.x = __builtin_amdgcn_rcpf(gt.x); ig.y = __builtin_amdgcn_rcpf(gt.y);
                    const f32x2_t gce = ig * gC;
                    const f32x2_t k = kq_[tb][ep];
                    const f32x2_t r = {__uint_as_float(rr_[tb][e0] << 16), __uint_as_float(rr_[tb][e0 + 1] << 16)};
                    const f32x2_t invn = iq_[tb][ep];
                    const f32x2_t aarg = (f32x2_t){accA[tb][e0], accA[tb][e0 + 1]} * (-LOG2E) + (-LOG2E * a0v_);
                    f32x2_t ad_; ad_.x = __builtin_amdgcn_exp2f(aarg.x); ad_.y = __builtin_amdgcn_exp2f(aarg.y); ad_ = ad_ + 1.f;
                    f32x2_t a; a.x = __builtin_amdgcn_rcpf(ad_.x); a.y = __builtin_amdgcn_rcpf(ad_.y);
                    const f32x2_t kkv = k * kkc_ * invn, kdv = k * ((a - 1.f) * kac_ + 1.f), bv = kkv * a;
                    const f32x2_t al = kkv * gm1, be = bv * ig, ka = kdv * ig, rh = r * gt, bc = bv * gce, kc = kdv * gce, bn = r * kdv * rkc_;
                    const unsigned alq = cvtpk(al.x, al.y), beq = cvtpk(be.x, be.y), kaq = cvtpk(ka.x, ka.y), rhq = cvtpk(rh.x, rh.y);
                    ABu[so * TS] = (unsigned short)alq; ABu[(so + 1) * TS] = (unsigned short)(alq >> 16);
                    BBu[so * TS] = (unsigned short)beq; BBu[(so + 1) * TS] = (unsigned short)(beq >> 16);
                    KBu[so * TS] = (unsigned short)kaq; KBu[(so + 1) * TS] = (unsigned short)(kaq >> 16);
                    RBu[so * TS] = (unsigned short)rhq; RBu[(so + 1) * TS] = (unsigned short)(rhq >> 16);
                    alp[ep] = alq; bcp[ep] = cvtpk(bc.x, bc.y); kcp[ep] = cvtpk(kc.x, kc.y); vtp[ep] = vr_[tb][e0] | (vr_[tb][e0 + 1] << 16);
                    bon[tb][e0] = bn.x; bon[tb][e0 + 1] = bn.y;
                }
                const int to = (q * 64 + j) * CS + 16 * tb + 4 * g;
                *(LAS u32x2*)(ABT + to) = alp; *(LAS u32x2*)(BCT + to) = bcp; *(LAS u32x2*)(KCT + to) = kcp; *(LAS u32x2*)(VT + to) = vtp;
            }
            if (lat) {
                const bool b0 = n & 1, b1 = n & 2, b3 = n & 8;
                float k1[4];
#pragma unroll
                for (int e = 0; e < 4; ++e) { const float keep = b0 ? bon[1][e] : bon[0][e], send = b0 ? bon[0][e] : bon[1][e]; k1[e] = keep + dpp_mov<0xB1>(send); }
                float k2[2];
#pragma unroll
                for (int i = 0; i < 2; ++i) { const float keep = b1 ? k1[2 + i] : k1[i], send = b1 ? k1[i] : k1[2 + i]; k2[i] = keep + dpp_mov<0x4E>(send); }
                float k3; { const float keep = b3 ? k2[1] : k2[0], send = b3 ? k2[0] : k2[1]; k3 = keep + dpp_mov<0x128>(send); }
                k3 += dpp_mov<0x114>(k3);
                if (n & 4) BONP[cb * 64 + 32 * q + 16 * (n & 1) + 4 * g + 2 * ((n >> 1) & 1) + ((n >> 3) & 1)] = k3;
            }
        }
        __syncthreads();
        {
            const int lane_ = lane_id_(); const int l31 = lane_ & 31, hh = lane_ >> 5;
            const int q = wave >> 2, pi = wave & 3;
            if (lat || pi < 2) {
            const LAS bf16* X = (pi == 0 ? AB : pi == 1 ? AB : pi == 2 ? BB : KB) + (32 * q + l31) * TS + 8 * hh;
            const LAS bf16* Y = (pi == 0 ? BB : pi == 1 ? KB : RB) + (32 * q + l31) * TS + 8 * hh;
            const f32x16 acc = tile_mm<4>(X, Y);
            const int c = l31;
            const bool low = pi < 2;
            f32x4 o[4];
#pragma unroll
            for (int gg = 0; gg < 4; ++gg)
#pragma unroll
                for (int e = 0; e < 4; ++e) { const int r = 8 * gg + 4 * hh + e; const bool keep = low ? (c < r) : (r <= c); o[gg][e] = keep ? acc[4 * gg + e] : 0.f; }
            if (pi == 0) {
                LAS float* op = NBAT + (q * 32 + c) * 32 + 4 * hh;
#pragma unroll
                for (int gg = 0; gg < 4; ++gg) *(LAS f32x4*)(op + 8 * gg) = o[gg];
            } else {
                LAS bf16* op = (pi == 1 ? NKA : pi == 2 ? QBRT : QKRT) + (q * 32 + c) * CS + 4 * hh;
#pragma unroll
                for (int gg = 0; gg < 4; ++gg) *(LAS u32x2*)(op + 8 * gg) = pk4(o[gg][0], o[gg][1], o[gg][2], o[gg][3]);
            }
            }
        }
        __syncthreads();
        if (wave < 3) {
            const int lane_ = lane_id_();
            const int q = (wave < 2) ? wave : (lane_ >> 5);
            const LAS bf16* src = (wave < 2) ? ABT + (q * 64 + lane_) * CS : NKA + (q * 32 + (lane_ & 31)) * CS;
            LAS bf16* dst = (wave < 2) ? GG + (q * 64 + lane_) * CS : MM + (q * 32 + (lane_ & 31)) * CS;
            float x[32];
#pragma unroll
            for (int c4 = 0; c4 < 4; ++c4) { const v4u rv = *(const LAS v4u*)(src + 8 * c4);
#pragma unroll
                for (int e = 0; e < 4; ++e) { x[8 * c4 + 2 * e] = __uint_as_float(rv[e] << 16); x[8 * c4 + 2 * e + 1] = __uint_as_float(rv[e] & 0xffff0000u); } }
            const LAS float* nb_ = NBAT + q * 1024;
            f32x4 ra0, ra1, ra2, ra3, ra4, ra5, ra6, ra7, rb0, rb1, rb2, rb3, rb4, rb5, rb6, rb7;
            ra0 = *(const LAS f32x4*)(nb_ + 0);
            ra1 = *(const LAS f32x4*)(nb_ + 4);
            ra2 = *(const LAS f32x4*)(nb_ + 8);
            ra3 = *(const LAS f32x4*)(nb_ + 12);
            ra4 = *(const LAS f32x4*)(nb_ + 16);
            ra5 = *(const LAS f32x4*)(nb_ + 20);
            ra6 = *(const LAS f32x4*)(nb_ + 24);
            ra7 = *(const LAS f32x4*)(nb_ + 28);
            rb0 = *(const LAS f32x4*)(nb_ + 32);
            rb1 = *(const LAS f32x4*)(nb_ + 36);
            rb2 = *(const LAS f32x4*)(nb_ + 40);
            rb3 = *(const LAS f32x4*)(nb_ + 44);
            rb4 = *(const LAS f32x4*)(nb_ + 48);
            rb5 = *(const LAS f32x4*)(nb_ + 52);
            rb6 = *(const LAS f32x4*)(nb_ + 56);
            rb7 = *(const LAS f32x4*)(nb_ + 60);
            { const float xa = x[0];
              x[1] -= ra0[1] * xa;
              x[2] -= ra0[2] * xa;
              x[3] -= ra0[3] * xa;
              x[4] -= ra1[0] * xa;
              x[5] -= ra1[1] * xa;
              x[6] -= ra1[2] * xa;
              x[7] -= ra1[3] * xa;
              x[8] -= ra2[0] * xa;
              x[9] -= ra2[1] * xa;
              x[10] -= ra2[2] * xa;
              x[11] -= ra2[3] * xa;
              x[12] -= ra3[0] * xa;
              x[13] -= ra3[1] * xa;
              x[14] -= ra3[2] * xa;
              x[15] -= ra3[3] * xa;
              x[16] -= ra4[0] * xa;
              x[17] -= ra4[1] * xa;
              x[18] -= ra4[2] * xa;
              x[19] -= ra4[3] * xa;
              x[20] -= ra5[0] * xa;
              x[21] -= ra5[1] * xa;
              x[22] -= ra5[2] * xa;
              x[23] -= ra5[3] * xa;
              x[24] -= ra6[0] * xa;
              x[25] -= ra6[1] * xa;
              x[26] -= ra6[2] * xa;
              x[27] -= ra6[3] * xa;
              x[28] -= ra7[0] * xa;
              x[29] -= ra7[1] * xa;
              x[30] -= ra7[2] * xa;
              x[31] -= ra7[3] * xa;
            }
            __builtin_amdgcn_sched_barrier(0);
            ra0 = *(const LAS f32x4*)(nb_ + 64);
            ra1 = *(const LAS f32x4*)(nb_ + 68);
            ra2 = *(const LAS f32x4*)(nb_ + 72);
            ra3 = *(const LAS f32x4*)(nb_ + 76);
            ra4 = *(const LAS f32x4*)(nb_ + 80);
            ra5 = *(const LAS f32x4*)(nb_ + 84);
            ra6 = *(const LAS f32x4*)(nb_ + 88);
            ra7 = *(const LAS f32x4*)(nb_ + 92);
            { const float xa = x[1];
              x[2] -= rb0[2] * xa;
              x[3] -= rb0[3] * xa;
              x[4] -= rb1[0] * xa;
              x[5] -= rb1[1] * xa;
              x[6] -= rb1[2] * xa;
              x[7] -= rb1[3] * xa;
              x[8] -= rb2[0] * xa;
              x[9] -= rb2[1] * xa;
              x[10] -= rb2[2] * xa;
              x[11] -= rb2[3] * xa;
              x[12] -= rb3[0] * xa;
              x[13] -= rb3[1] * xa;
              x[14] -= rb3[2] * xa;
              x[15] -= rb3[3] * xa;
              x[16] -= rb4[0] * xa;
              x[17] -= rb4[1] * xa;
              x[18] -= rb4[2] * xa;
              x[19] -= rb4[3] * xa;
              x[20] -= rb5[0] * xa;
              x[21] -= rb5[1] * xa;
              x[22] -= rb5[2] * xa;
              x[23] -= rb5[3] * xa;
              x[24] -= rb6[0] * xa;
              x[25] -= rb6[1] * xa;
              x[26] -= rb6[2] * xa;
              x[27] -= rb6[3] * xa;
              x[28] -= rb7[0] * xa;
              x[29] -= rb7[1] * xa;
              x[30] -= rb7[2] * xa;
              x[31] -= rb7[3] * xa;
            }
            __builtin_amdgcn_sched_barrier(0);
            rb1 = *(const LAS f32x4*)(nb_ + 100);
            rb2 = *(const LAS f32x4*)(nb_ + 104);
            rb3 = *(const LAS f32x4*)(nb_ + 108);
            rb4 = *(const LAS f32x4*)(nb_ + 112);
            rb5 = *(const LAS f32x4*)(nb_ + 116);
            rb6 = *(const LAS f32x4*)(nb_ + 120);
            rb7 = *(const LAS f32x4*)(nb_ + 124);
            { const float xa = x[2];
              x[3] -= ra0[3] * xa;
              x[4] -= ra1[0] * xa;
              x[5] -= ra1[1] * xa;
              x[6] -= ra1[2] * xa;
              x[7] -= ra1[3] * xa;
              x[8] -= ra2[0] * xa;
              x[9] -= ra2[1] * xa;
              x[10] -= ra2[2] * xa;
              x[11] -= ra2[3] * xa;
              x[12] -= ra3[0] * xa;
              x[13] -= ra3[1] * xa;
              x[14] -= ra3[2] * xa;
              x[15] -= ra3[3] * xa;
              x[16] -= ra4[0] * xa;
              x[17] -= ra4[1] * xa;
              x[18] -= ra4[2] * xa;
              x[19] -= ra4[3] * xa;
              x[20] -= ra5[0] * xa;
              x[21] -= ra5[1] * xa;
              x[22] -= ra5[2] * xa;
              x[23] -= ra5[3] * xa;
              x[24] -= ra6[0] * xa;
              x[25] -= ra6[1] * xa;
              x[26] -= ra6[2] * xa;
              x[27] -= ra6[3] * xa;
              x[28] -= ra7[0] * xa;
              x[29] -= ra7[1] * xa;
              x[30] -= ra7[2] * xa;
              x[31] -= ra7[3] * xa;
            }
            __builtin_amdgcn_sched_barrier(0);
            ra1 = *(const LAS f32x4*)(nb_ + 132);
            ra2 = *(const LAS f32x4*)(nb_ + 136);
            ra3 = *(const LAS f32x4*)(nb_ + 140);
            ra4 = *(const LAS f32x4*)(nb_ + 144);
            ra5 = *(const LAS f32x4*)(nb_ + 148);
            ra6 = *(const LAS f32x4*)(nb_ + 152);
            ra7 = *(const LAS f32x4*)(nb_ + 156);
            { const float xa = x[3];
              x[4] -= rb1[0] * xa;
              x[5] -= rb1[1] * xa;
              x[6] -= rb1[2] * xa;
              x[7] -= rb1[3] * xa;
              x[8] -= rb2[0] * xa;
              x[9] -= rb2[1] * xa;
              x[10] -= rb2[2] * xa;
              x[11] -= rb2[3] * xa;
              x[12] -= rb3[0] * xa;
              x[13] -= rb3[1] * xa;
              x[14] -= rb3[2] * xa;
              x[15] -= rb3[3] * xa;
              x[16] -= rb4[0] * xa;
              x[17] -= rb4[1] * xa;
              x[18] -= rb4[2] * xa;
              x[19] -= rb4[3] * xa;
              x[20] -= rb5[0] * xa;
              x[21] -= rb5[1] * xa;
              x[22] -= rb5[2] * xa;
              x[23] -= rb5[3] * xa;
              x[24] -= rb6[0] * xa;
              x[25] -= rb6[1] * xa;
              x[26] -= rb6[2] * xa;
              x[27] -= rb6[3] * xa;
              x[28] -= rb7[0] * xa;
              x[29] -= rb7[1] * xa;
              x[30] -= rb7[2] * xa;
              x[31] -= rb7[3] * xa;
            }
            __builtin_amdgcn_sched_barrier(0);
            rb1 = *(const LAS f32x4*)(nb_ + 164);
            rb2 = *(const LAS f32x4*)(nb_ + 168);
            rb3 = *(const LAS f32x4*)(nb_ + 172);
            rb4 = *(const LAS f32x4*)(nb_ + 176);
            rb5 = *(const LAS f32x4*)(nb_ + 180);
            rb6 = *(const LAS f32x4*)(nb_ + 184);
            rb7 = *(const LAS f32x4*)(nb_ + 188);
            { const float xa = x[4];
              x[5] -= ra1[1] * xa;
              x[6] -= ra1[2] * xa;
              x[7] -= ra1[3] * xa;
              x[8] -= ra2[0] * xa;
              x[9] -= ra2[1] * xa;
              x[10] -= ra2[2] * xa;
              x[11] -= ra2[3] * xa;
              x[12] -= ra3[0] * xa;
              x[13] -= ra3[1] * xa;
              x[14] -= ra3[2] * xa;
              x[15] -= ra3[3] * xa;
              x[16] -= ra4[0] * xa;
              x[17] -= ra4[1] * xa;
              x[18] -= ra4[2] * xa;
              x[19] -= ra4[3] * xa;
              x[20] -= ra5[0] * xa;
              x[21] -= ra5[1] * xa;
              x[22] -= ra5[2] * xa;
              x[23] -= ra5[3] * xa;
              x[24] -= ra6[0] * xa;
              x[25] -= ra6[1] * xa;
              x[26] -= ra6[2] * xa;
              x[27] -= ra6[3] * xa;
              x[28] -= ra7[0] * xa;
              x[29] -= ra7[1] * xa;
              x[30] -= ra7[2] * xa;
              x[31] -= ra7[3] * xa;
            }
            __builtin_amdgcn_sched_barrier(0);
            ra1 = *(const LAS f32x4*)(nb_ + 196);
            ra2 = *(const LAS f32x4*)(nb_ + 200);
            ra3 = *(const LAS f32x4*)(nb_ + 204);
            ra4 = *(const LAS f32x4*)(nb_ + 208);
            ra5 = *(const LAS f32x4*)(nb_ + 212);
            ra6 = *(const LAS f32x4*)(nb_ + 216);
            ra7 = *(const LAS f32x4*)(nb_ + 220);
            { const float xa = x[5];
              x[6] -= rb1[2] * xa;
              x[7] -= rb1[3] * xa;
              x[8] -= rb2[0] * xa;
              x[9] -= rb2[1] * xa;
              x[10] -= rb2[2] * xa;
              x[11] -= rb2[3] * xa;
              x[12] -= rb3[0] * xa;
              x[13] -= rb3[1] * xa;
              x[14] -= rb3[2] * xa;
              x[15] -= rb3[3] * xa;
              x[16] -= rb4[0] * xa;
              x[17] -= rb4[1] * xa;
              x[18] -= rb4[2] * xa;
              x[19] -= rb4[3] * xa;
              x[20] -= rb5[0] * xa;
              x[21] -= rb5[1] * xa;
              x[22] -= rb5[2] * xa;
              x[23] -= rb5[3] * xa;
              x[24] -= rb6[0] * xa;
              x[25] -= rb6[1] * xa;
              x[26] -= rb6[2] * xa;
              x[27] -= rb6[3] * xa;
              x[28] -= rb7[0] * xa;
              x[29] -= rb7[1] * xa;
              x[30] -= rb7[2] * xa;
              x[31] -= rb7[3] * xa;
            }
            __builtin_amdgcn_sched_barrier(0);
            rb2 = *(const LAS f32x4*)(nb_ + 232);
            rb3 = *(const LAS f32x4*)(nb_ + 236);
            rb4 = *(const LAS f32x4*)(nb_ + 240);
            rb5 = *(const LAS f32x4*)(nb_ + 244);
            rb6 = *(const LAS f32x4*)(nb_ + 248);
            rb7 = *(const LAS f32x4*)(nb_ + 252);
            { const float xa = x[6];
              x[7] -= ra1[3] * xa;
              x[8] -= ra2[0] * xa;
              x[9] -= ra2[1] * xa;
              x[10] -= ra2[2] * xa;
              x[11] -= ra2[3] * xa;
              x[12] -= ra3[0] * xa;
              x[13] -= ra3[1] * xa;
              x[14] -= ra3[2] * xa;
              x[15] -= ra3[3] * xa;
              x[16] -= ra4[0] * xa;
              x[17] -= ra4[1] * xa;
              x[18] -= ra4[2] * xa;
              x[19] -= ra4[3] * xa;
              x[20] -= ra5[0] * xa;
              x[21] -= ra5[1] * xa;
              x[22] -= ra5[2] * xa;
              x[23] -= ra5[3] * xa;
              x[24] -= ra6[0] * xa;
              x[25] -= ra6[1] * xa;
              x[26] -= ra6[2] * xa;
              x[27] -= ra6[3] * xa;
              x[28] -= ra7[0] * xa;
              x[29] -= ra7[1] * xa;
              x[30] -= ra7[2] * xa;
              x[31] -= ra7[3] * xa;
            }
            __builtin_amdgcn_sched_barrier(0);
            ra2 = *(const LAS f32x4*)(nb_ + 264);
            ra3 = *(const LAS f32x4*)(nb_ + 268);
            ra4 = *(const LAS f32x4*)(nb_ + 272);
            ra5 = *(const LAS f32x4*)(nb_ + 276);
            ra6 = *(const LAS f32x4*)(nb_ + 280);
            ra7 = *(const LAS f32x4*)(nb_ + 284);
            { const float xa = x[7];
              x[8] -= rb2[0] * xa;
              x[9] -= rb2[1] * xa;
              x[10] -= rb2[2] * xa;
              x[11] -= rb2[3] * xa;
              x[12] -= rb3[0] * xa;
              x[13] -= rb3[1] * xa;
              x[14] -= rb3[2] * xa;
              x[15] -= rb3[3] * xa;
              x[16] -= rb4[0] * xa;
              x[17] -= rb4[1] * xa;
              x[18] -= rb4[2] * xa;
              x[19] -= rb4[3] * xa;
              x[20] -= rb5[0] * xa;
              x[21] -= rb5[1] * xa;
              x[22] -= rb5[2] * xa;
              x[23] -= rb5[3] * xa;
              x[24] -= rb6[0] * xa;
              x[25] -= rb6[1] * xa;
              x[26] -= rb6[2] * xa;
              x[27] -= rb6[3] * xa;
              x[28] -= rb7[0] * xa;
              x[29] -= rb7[1] * xa;
              x[30] -= rb7[2] * xa;
              x[31] -= rb7[3] * xa;
            }
            __builtin_amdgcn_sched_barrier(0);
            rb2 = *(const LAS f32x4*)(nb_ + 296);
            rb3 = *(const LAS f32x4*)(nb_ + 300);
            rb4 = *(const LAS f32x4*)(nb_ + 304);
            rb5 = *(const LAS f32x4*)(nb_ + 308);
            rb6 = *(const LAS f32x4*)(nb_ + 312);
            rb7 = *(const LAS f32x4*)(nb_ + 316);
            { const float xa = x[8];
              x[9] -= ra2[1] * xa;
              x[10] -= ra2[2] * xa;
              x[11] -= ra2[3] * xa;
              x[12] -= ra3[0] * xa;
              x[13] -= ra3[1] * xa;
              x[14] -= ra3[2] * xa;
              x[15] -= ra3[3] * xa;
              x[16] -= ra4[0] * xa;
              x[17] -= ra4[1] * xa;
              x[18] -= ra4[2] * xa;
              x[19] -= ra4[3] * xa;
              x[20] -= ra5[0] * xa;
              x[21] -= ra5[1] * xa;
              x[22] -= ra5[2] * xa;
              x[23] -= ra5[3] * xa;
              x[24] -= ra6[0] * xa;
              x[25] -= ra6[1] * xa;
              x[26] -= ra6[2] * xa;
              x[27] -= ra6[3] * xa;
              x[28] -= ra7[0] * xa;
              x[29] -= ra7[1] * xa;
              x[30] -= ra7[2] * xa;
              x[31] -= ra7[3] * xa;
            }
            __builtin_amdgcn_sched_barrier(0);
            ra2 = *(const LAS f32x4*)(nb_ + 328);
            ra3 = *(const LAS f32x4*)(nb_ + 332);
            ra4 = *(const LAS f32x4*)(nb_ + 336);
            ra5 = *(const LAS f32x4*)(nb_ + 340);
            ra6 = *(const LAS f32x4*)(nb_ + 344);
            ra7 = *(const LAS f32x4*)(nb_ + 348);
            { const float xa = x[9];
              x[10] -= rb2[2] * xa;
              x[11] -= rb2[3] * xa;
              x[12] -= rb3[0] * xa;
              x[13] -= rb3[1] * xa;
              x[14] -= rb3[2] * xa;
              x[15] -= rb3[3] * xa;
              x[16] -= rb4[0] * xa;
              x[17] -= rb4[1] * xa;
              x[18] -= rb4[2] * xa;
              x[19] -= rb4[3] * xa;
              x[20] -= rb5[0] * xa;
              x[21] -= rb5[1] * xa;
              x[22] -= rb5[2] * xa;
              x[23] -= rb5[3] * xa;
              x[24] -= rb6[0] * xa;
              x[25] -= rb6[1] * xa;
              x[26] -= rb6[2] * xa;
              x[27] -= rb6[3] * xa;
              x[28] -= rb7[0] * xa;
              x[29] -= rb7[1] * xa;
              x[30] -= rb7[2] * xa;
              x[31] -= rb7[3] * xa;
            }
            __builtin_amdgcn_sched_barrier(0);
            rb3 = *(const LAS f32x4*)(nb_ + 364);
            rb4 = *(const LAS f32x4*)(nb_ + 368);
            rb5 = *(const LAS f32x4*)(nb_ + 372);
            rb6 = *(const LAS f32x4*)(nb_ + 376);
            rb7 = *(const LAS f32x4*)(nb_ + 380);
            { const float xa = x[10];
              x[11] -= ra2[3] * xa;
              x[12] -= ra3[0] * xa;
              x[13] -= ra3[1] * xa;
              x[14] -= ra3[2] * xa;
              x[15] -= ra3[3] * xa;
              x[16] -= ra4[0] * xa;
              x[17] -= ra4[1] * xa;
              x[18] -= ra4[2] * xa;
              x[19] -= ra4[3] * xa;
              x[20] -= ra5[0] * xa;
              x[21] -= ra5[1] * xa;
              x[22] -= ra5[2] * xa;
              x[23] -= ra5[3] * xa;
              x[24] -= ra6[0] * xa;
              x[25] -= ra6[1] * xa;
              x[26] -= ra6[2] * xa;
              x[27] -= ra6[3] * xa;
              x[28] -= ra7[0] * xa;
              x[29] -= ra7[1] * xa;
              x[30] -= ra7[2] * xa;
              x[31] -= ra7[3] * xa;
            }
            __builtin_amdgcn_sched_barrier(0);
            ra3 = *(const LAS f32x4*)(nb_ + 396);
            ra4 = *(const LAS f32x4*)(nb_ + 400);
            ra5 = *(const LAS f32x4*)(nb_ + 404);
            ra6 = *(const LAS f32x4*)(nb_ + 408);
            ra7 = *(const LAS f32x4*)(nb_ + 412);
            { const float xa = x[11];
              x[12] -= rb3[0] * xa;
              x[13] -= rb3[1] * xa;
              x[14] -= rb3[2] * xa;
              x[15] -= rb3[3] * xa;
              x[16] -= rb4[0] * xa;
              x[17] -= rb4[1] * xa;
              x[18] -= rb4[2] * xa;
              x[19] -= rb4[3] * xa;
              x[20] -= rb5[0] * xa;
              x[21] -= rb5[1] * xa;
              x[22] -= rb5[2] * xa;
              x[23] -= rb5[3] * xa;
              x[24] -= rb6[0] * xa;
              x[25] -= rb6[1] * xa;
              x[26] -= rb6[2] * xa;
              x[27] -= rb6[3] * xa;
              x[28] -= rb7[0] * xa;
              x[29] -= rb7[1] * xa;
              x[30] -= rb7[2] * xa;
              x[31] -= rb7[3] * xa;
            }
            __builtin_amdgcn_sched_barrier(0);
            rb3 = *(const LAS f32x4*)(nb_ + 428);
            rb4 = *(const LAS f32x4*)(nb_ + 432);
            rb5 = *(const LAS f32x4*)(nb_ + 436);
            rb6 = *(const LAS f32x4*)(nb_ + 440);
            rb7 = *(const LAS f32x4*)(nb_ + 444);
            { const float xa = x[12];
              x[13] -= ra3[1] * xa;
              x[14] -= ra3[2] * xa;
              x[15] -= ra3[3] * xa;
              x[16] -= ra4[0] * xa;
              x[17] -= ra4[1] * xa;
              x[18] -= ra4[2] * xa;
              x[19] -= ra4[3] * xa;
              x[20] -= ra5[0] * xa;
              x[21] -= ra5[1] * xa;
              x[22] -= ra5[2] * xa;
              x[23] -= ra5[3] * xa;
              x[24] -= ra6[0] * xa;
              x[25] -= ra6[1] * xa;
              x[26] -= ra6[2] * xa;
              x[27] -= ra6[3] * xa;
              x[28] -= ra7[0] * xa;
              x[29] -= ra7[1] * xa;
              x[30] -= ra7[2] * xa;
              x[31] -= ra7[3] * xa;
            }
            __builtin_amdgcn_sched_barrier(0);
            ra3 = *(const LAS f32x4*)(nb_ + 460);
            ra4 = *(const LAS f32x4*)(nb_ + 464);
            ra5 = *(const LAS f32x4*)(nb_ + 468);
            ra6 = *(const LAS f32x4*)(nb_ + 472);
            ra7 = *(const LAS f32x4*)(nb_ + 476);
            { const float xa = x[13];
              x[14] -= rb3[2] * xa;
              x[15] -= rb3[3] * xa;
              x[16] -= rb4[0] * xa;
              x[17] -= rb4[1] * xa;
              x[18] -= rb4[2] * xa;
              x[19] -= rb4[3] * xa;
              x[20] -= rb5[0] * xa;
              x[21] -= rb5[1] * xa;
              x[22] -= rb5[2] * xa;
              x[23] -= rb5[3] * xa;
              x[24] -= rb6[0] * xa;
              x[25] -= rb6[1] * xa;
              x[26] -= rb6[2] * xa;
              x[27] -= rb6[3] * xa;
              x[28] -= rb7[0] * xa;
              x[29] -= rb7[1] * xa;
              x[30] -= rb7[2] * xa;
              x[31] -= rb7[3] * xa;
            }
            __builtin_amdgcn_sched_barrier(0);
            rb4 = *(const LAS f32x4*)(nb_ + 496);
            rb5 = *(const LAS f32x4*)(nb_ + 500);
            rb6 = *(const LAS f32x4*)(nb_ + 504);
            rb7 = *(const LAS f32x4*)(nb_ + 508);
            { const float xa = x[14];
              x[15] -= ra3[3] * xa;
              x[16] -= ra4[0] * xa;
              x[17] -= ra4[1] * xa;
              x[18] -= ra4[2] * xa;
              x[19] -= ra4[3] * xa;
              x[20] -= ra5[0] * xa;
              x[21] -= ra5[1] * xa;
              x[22] -= ra5[2] * xa;
              x[23] -= ra5[3] * xa;
              x[24] -= ra6[0] * xa;
              x[25] -= ra6[1] * xa;
              x[26] -= ra6[2] * xa;
              x[27] -= ra6[3] * xa;
              x[28] -= ra7[0] * xa;
              x[29] -= ra7[1] * xa;
              x[30] -= ra7[2] * xa;
              x[31] -= ra7[3] * xa;
            }
            __builtin_amdgcn_sched_barrier(0);
            ra4 = *(const LAS f32x4*)(nb_ + 528);
            ra5 = *(const LAS f32x4*)(nb_ + 532);
            ra6 = *(const LAS f32x4*)(nb_ + 536);
            ra7 = *(const LAS f32x4*)(nb_ + 540);
            { const float xa = x[15];
              x[16] -= rb4[0] * xa;
              x[17] -= rb4[1] * xa;
              x[18] -= rb4[2] * xa;
              x[19] -= rb4[3] * xa;
              x[20] -= rb5[0] * xa;
              x[21] -= rb5[1] * xa;
              x[22] -= rb5[2] * xa;
              x[23] -= rb5[3] * xa;
              x[24] -= rb6[0] * xa;
              x[25] -= rb6[1] * xa;
              x[26] -= rb6[2] * xa;
              x[27] -= rb6[3] * xa;
              x[28] -= rb7[0] * xa;
              x[29] -= rb7[1] * xa;
              x[30] -= rb7[2] * xa;
              x[31] -= rb7[3] * xa;
            }
            __builtin_amdgcn_sched_barrier(0);
            rb4 = *(const LAS f32x4*)(nb_ + 560);
            rb5 = *(const LAS f32x4*)(nb_ + 564);
            rb6 = *(const LAS f32x4*)(nb_ + 568);
            rb7 = *(const LAS f32x4*)(nb_ + 572);
            { const float xa = x[16];
              x[17] -= ra4[1] * xa;
              x[18] -= ra4[2] * xa;
              x[19] -= ra4[3] * xa;
              x[20] -= ra5[0] * xa;
              x[21] -= ra5[1] * xa;
              x[22] -= ra5[2] * xa;
              x[23] -= ra5[3] * xa;
              x[24] -= ra6[0] * xa;
              x[25] -= ra6[1] * xa;
              x[26] -= ra6[2] * xa;
              x[27] -= ra6[3] * xa;
              x[28] -= ra7[0] * xa;
              x[29] -= ra7[1] * xa;
              x[30] -= ra7[2] * xa;
              x[31] -= ra7[3] * xa;
            }
            __builtin_amdgcn_sched_barrier(0);
            ra4 = *(const LAS f32x4*)(nb_ + 592);
            ra5 = *(const LAS f32x4*)(nb_ + 596);
            ra6 = *(const LAS f32x4*)(nb_ + 600);
            ra7 = *(const LAS f32x4*)(nb_ + 604);
            { const float xa = x[17];
              x[18] -= rb4[2] * xa;
              x[19] -= rb4[3] * xa;
              x[20] -= rb5[0] * xa;
              x[21] -= rb5[1] * xa;
              x[22] -= rb5[2] * xa;
              x[23] -= rb5[3] * xa;
              x[24] -= rb6[0] * xa;
              x[25] -= rb6[1] * xa;
              x[26] -= rb6[2] * xa;
              x[27] -= rb6[3] * xa;
              x[28] -= rb7[0] * xa;
              x[29] -= rb7[1] * xa;
              x[30] -= rb7[2] * xa;
              x[31] -= rb7[3] * xa;
            }
            __builtin_amdgcn_sched_barrier(0);
            rb5 = *(const LAS f32x4*)(nb_ + 628);
            rb6 = *(const LAS f32x4*)(nb_ + 632);
            rb7 = *(const LAS f32x4*)(nb_ + 636);
            { const float xa = x[18];
              x[19] -= ra4[3] * xa;
              x[20] -= ra5[0] * xa;
              x[21] -= ra5[1] * xa;
              x[22] -= ra5[2] * xa;
              x[23] -= ra5[3] * xa;
              x[24] -= ra6[0] * xa;
              x[25] -= ra6[1] * xa;
              x[26] -= ra6[2] * xa;
              x[27] -= ra6[3] * xa;
              x[28] -= ra7[0] * xa;
              x[29] -= ra7[1] * xa;
              x[30] -= ra7[2] * xa;
              x[31] -= ra7[3] * xa;
            }
            __builtin_amdgcn_sched_barrier(0);
            ra5 = *(const LAS f32x4*)(nb_ + 660);
            ra6 = *(const LAS f32x4*)(nb_ + 664);
            ra7 = *(const LAS f32x4*)(nb_ + 668);
            { const float xa = x[19];
              x[20] -= rb5[0] * xa;
              x[21] -= rb5[1] * xa;
              x[22] -= rb5[2] * xa;
              x[23] -= rb5[3] * xa;
              x[24] -= rb6[0] * xa;
              x[25] -= rb6[1] * xa;
              x[26] -= rb6[2] * xa;
              x[27] -= rb6[3] * xa;
              x[28] -= rb7[0] * xa;
              x[29] -= rb7[1] * xa;
              x[30] -= rb7[2] * xa;
              x[31] -= rb7[3] * xa;
            }
            __builtin_amdgcn_sched_barrier(0);
            rb5 = *(const LAS f32x4*)(nb_ + 692);
            rb6 = *(const LAS f32x4*)(nb_ + 696);
            rb7 = *(const LAS f32x4*)(nb_ + 700);
            { const float xa = x[20];
              x[21] -= ra5[1] * xa;
              x[22] -= ra5[2] * xa;
              x[23] -= ra5[3] * xa;
              x[24] -= ra6[0] * xa;
              x[25] -= ra6[1] * xa;
              x[26] -= ra6[2] * xa;
              x[27] -= ra6[3] * xa;
              x[28] -= ra7[0] * xa;
              x[29] -= ra7[1] * xa;
              x[30] -= ra7[2] * xa;
              x[31] -= ra7[3] * xa;
            }
            __builtin_amdgcn_sched_barrier(0);
            ra5 = *(const LAS f32x4*)(nb_ + 724);
            ra6 = *(const LAS f32x4*)(nb_ + 728);
            ra7 = *(const LAS f32x4*)(nb_ + 732);
            { const float xa = x[21];
              x[22] -= rb5[2] * xa;
              x[23] -= rb5[3] * xa;
              x[24] -= rb6[0] * xa;
              x[25] -= rb6[1] * xa;
              x[26] -= rb6[2] * xa;
              x[27] -= rb6[3] * xa;
              x[28] -= rb7[0] * xa;
              x[29] -= rb7[1] * xa;
              x[30] -= rb7[2] * xa;
              x[31] -= rb7[3] * xa;
            }
            __builtin_amdgcn_sched_barrier(0);
            rb6 = *(const LAS f32x4*)(nb_ + 760);
            rb7 = *(const LAS f32x4*)(nb_ + 764);
            { const float xa = x[22];
              x[23] -= ra5[3] * xa;
              x[24] -= ra6[0] * xa;
              x[25] -= ra6[1] * xa;
              x[26] -= ra6[2] * xa;
              x[27] -= ra6[3] * xa;
              x[28] -= ra7[0] * xa;
              x[29] -= ra7[1] * xa;
              x[30] -= ra7[2] * xa;
              x[31] -= ra7[3] * xa;
            }
            __builtin_amdgcn_sched_barrier(0);
            ra6 = *(const LAS f32x4*)(nb_ + 792);
            ra7 = *(const LAS f32x4*)(nb_ + 796);
            { const float xa = x[23];
              x[24] -= rb6[0] * xa;
              x[25] -= rb6[1] * xa;
              x[26] -= rb6[2] * xa;
              x[27] -= rb6[3] * xa;
              x[28] -= rb7[0] * xa;
              x[29] -= rb7[1] * xa;
              x[30] -= rb7[2] * xa;
              x[31] -= rb7[3] * xa;
            }
            __builtin_amdgcn_sched_barrier(0);
            rb6 = *(const LAS f32x4*)(nb_ + 824);
            rb7 = *(const LAS f32x4*)(nb_ + 828);
            { const float xa = x[24];
              x[25] -= ra6[1] * xa;
              x[26] -= ra6[2] * xa;
              x[27] -= ra6[3] * xa;
              x[28] -= ra7[0] * xa;
              x[29] -= ra7[1] * xa;
              x[30] -= ra7[2] * xa;
              x[31] -= ra7[3] * xa;
            }
            __builtin_amdgcn_sched_barrier(0);
            ra6 = *(const LAS f32x4*)(nb_ + 856);
            ra7 = *(const LAS f32x4*)(nb_ + 860);
            { const float xa = x[25];
              x[26] -= rb6[2] * xa;
              x[27] -= rb6[3] * xa;
              x[28] -= rb7[0] * xa;
              x[29] -= rb7[1] * xa;
              x[30] -= rb7[2] * xa;
              x[31] -= rb7[3] * xa;
            }
            __builtin_amdgcn_sched_barrier(0);
            rb7 = *(const LAS f32x4*)(nb_ + 892);
            { const float xa = x[26];
              x[27] -= ra6[3] * xa;
              x[28] -= ra7[0] * xa;
              x[29] -= ra7[1] * xa;
              x[30] -= ra7[2] * xa;
              x[31] -= ra7[3] * xa;
            }
            __builtin_amdgcn_sched_barrier(0);
            ra7 = *(const LAS f32x4*)(nb_ + 924);
            { const float xa = x[27];
              x[28] -= rb7[0] * xa;
              x[29] -= rb7[1] * xa;
              x[30] -= rb7[2] * xa;
              x[31] -= rb7[3] * xa;
            }
            __builtin_amdgcn_sched_barrier(0);
            rb7 = *(const LAS f32x4*)(nb_ + 956);
            { const float xa = x[28];
              x[29] -= ra7[1] * xa;
              x[30] -= ra7[2] * xa;
              x[31] -= ra7[3] * xa;
            }
            __builtin_amdgcn_sched_barrier(0);
            ra7 = *(const LAS f32x4*)(nb_ + 988);
            { const float xa = x[29];
              x[30] -= rb7[2] * xa;
              x[31] -= rb7[3] * xa;
            }
            __builtin_amdgcn_sched_barrier(0);
            { const float xa = x[30];
              x[31] -= ra7[3] * xa;
            }
            __builtin_amdgcn_sched_barrier(0);
#pragma unroll
            for (int c4 = 0; c4 < 4; ++c4) { v4u w; w.x = cvtpk(x[8 * c4], x[8 * c4 + 1]); w.y = cvtpk(x[8 * c4 + 2], x[8 * c4 + 3]); w.z = cvtpk(x[8 * c4 + 4], x[8 * c4 + 5]); w.w = cvtpk(x[8 * c4 + 6], x[8 * c4 + 7]);
                *(LAS v4u*)(dst + 8 * c4) = w; }
        }
        __syncthreads();
        v4u prc[5], prh;
        { const v4u z0 = {0u, 0u, 0u, 0u}; prc[0] = z0; prc[1] = z0; prc[2] = z0; prc[3] = z0; prc[4] = z0; prh = z0; }
        if (sc + 1 < 68) SCAN_A_LOAD(sc + 1);
        {
            const int lane_ = lane_id_(); const int l31 = lane_ & 31, hh = lane_ >> 5;
            {
                const int q = wave >> 2, jb = wave & 1, jbp = (wave >> 1) & 1;
                f_tile<true>(GG + (q * 64 + 32 * jb + l31) * CS + 8 * hh, BCT + (q * 64 + 32 * jbp + l31) * CS + 8 * hh, BCT, PCT + (q * 64 + 32 * jbp + l31) * TS + 32 * jb, GC[q * 64 + 32 * jbp + l31], 32 * jbp + l31 - 32 * jb, hh);
            }
            if (wave >= 4 || lat) {
                const bool isE = wave < 4; const int q = (wave >> 1) & 1, x = wave & 1;
                const LAS bf16* X = (isE ? GG + (q * 64 + 32 * x) * CS : MM + (q * 32) * CS) + l31 * CS + 8 * hh;
                const LAS bf16* Y = (isE ? QBRT + (q * 32) * CS : BCT + (q * 64 + 32 * x) * CS) + l31 * CS + 8 * hh;
                const int str = isE ? TS : CS;
                const LAS bf16* Bp = (isE ? RB + (32 * q) * TS + 32 * x : KCT + (q * 64 + 32 * x) * CS) + l31 * str + 4 * hh;
                LAS bf16* Op = (isE ? E1T + (q * 32) * TS + 32 * x : DCT + (q * 64 + 32 * x) * CS) + l31 * str;
                f_tile<false>(X, Y, Bp, Op, 0.f, 0, hh);
            }
            if (lat && (wave == 1 || wave == 6)) {
                const int q = wave == 6;
                f_tile<false>(MM + (q * 32 + l31) * CS + 8 * hh, QBRT + (q * 32 + l31) * CS + 8 * hh, QKRT + (q * 32 + l31) * CS + 4 * hh, ZT + (q * 32 + l31) * CS, 0.f, 0, hh);
            }
        }
        __syncthreads();
        { GAS v4u* lp = lfr;
#pragma unroll
          for (int e4 = 0; e4 < 4; ++e4) lfrv[e4] = lp[e4]; }
        if (sc + 1 < 68) scan_a2(L, wave, d, sc + 1 >= 4, (sc + 1 >= 4) ? (sc + 1) * 64 - 256 : (sc + 1) * 64, prc[0], prc[1], prc[2], prc[3], prc[4], prh);
#pragma unroll
        for (int q = 0; q < 2; ++q) {
            if (wave < 2) {
                if (lat) {
                    const int lane_ = lane_id_(); const int l31 = lane_ & 31, hh = lane_ >> 5, ib = wave;
                    const LAS bf16* Scur = SST + scur * (64 * TS) + (32 * ib + l31) * TS + 8 * hh;
                    const LAS bf16* A1 = E1T + (q * 32 + l31) * TS + 8 * hh;
                    const LAS bf16* A2p = ZT + (q * 32 + l31) * CS + 8 * hh;
                    const LAS bf16* Vp = VT + (q * 64 + 32 * ib + l31) * CS + 8 * hh;
                    f32x16 acc;
#pragma unroll
                    for (int r = 0; r < 16; ++r) acc[r] = 0.f;
#pragma unroll
                    for (int s2 = 0; s2 < 2; ++s2) acc = __builtin_amdgcn_mfma_f32_32x32x16_bf16(*(const LAS bf16x8*)(Vp + 16 * s2), *(const LAS bf16x8*)(A2p + 16 * s2), acc, 0, 0, 0);
#pragma unroll
                    for (int s4 = 0; s4 < 4; ++s4) acc = __builtin_amdgcn_mfma_f32_32x32x16_bf16(*(const LAS bf16x8*)(Scur + 16 * s4), *(const LAS bf16x8*)(A1 + 16 * s4), acc, 0, 0, 0);
                    const unsigned yu = (unsigned)__builtin_amdgcn_readfirstlane((int)(((unsigned)d * ML + (unsigned)rbase) * 512u + (unsigned)(h * 64 + 32 * ib)));
                    GAS bf16* yb = (GAS bf16*)F.Y;
                    const int pos = pos0 + 32 * q + l31, idx = d ? (SEQ - 1 - pos) : pos;
                    const unsigned yo = yu + (unsigned)(idx * 512 + 4 * hh);
#pragma unroll
                    for (int gg = 0; gg < 4; ++gg) *(GAS u32x2*)(yb + yo + 8 * gg) = pk4(acc[4 * gg], acc[4 * gg + 1], acc[4 * gg + 2], acc[4 * gg + 3]);
                }
            } else if (wave < 6) {
                const int lane_ = lane_id_(); const int l31 = lane_ & 31, hh = lane_ >> 5, ib = (wave - 2) & 1, jbp = (wave - 2) >> 1;
                const LAS bf16* Scur = SST + scur * (64 * TS) + (32 * ib + l31) * TS + 8 * hh;
                const LAS bf16* A1 = PCT + (q * 64 + 32 * jbp + l31) * TS + 8 * hh;
                const LAS bf16* A2p = DCT + (q * 64 + 32 * jbp + l31) * CS + 8 * hh;
                const LAS bf16* Vp = VT + (q * 64 + 32 * ib + l31) * CS + 8 * hh;
                f32x16 acc;
#pragma unroll
                for (int r = 0; r < 16; ++r) acc[r] = 0.f;
#pragma unroll
                for (int s2 = 0; s2 < 2; ++s2) acc = __builtin_amdgcn_mfma_f32_32x32x16_bf16(*(const LAS bf16x8*)(A2p + 16 * s2), *(const LAS bf16x8*)(Vp + 16 * s2), acc, 0, 0, 0);
#pragma unroll
                for (int s4 = 0; s4 < 4; ++s4) acc = __builtin_amdgcn_mfma_f32_32x32x16_bf16(*(const LAS bf16x8*)(A1 + 16 * s4), *(const LAS bf16x8*)(Scur + 16 * s4), acc, 0, 0, 0);
                LAS bf16* Snx = SST + (scur ^ 1) * (64 * TS) + (32 * ib + l31) * TS + 32 * jbp;
#pragma unroll
                for (int gg = 0; gg < 4; ++gg) *(LAS u32x2*)(Snx + 8 * gg + 4 * hh) = pk4(acc[4 * gg], acc[4 * gg + 1], acc[4 * gg + 2], acc[4 * gg + 3]);
            } else if (wave == 6 && q == 0 && lat) {
                const int ln_ = lane_id_(); const int pos = pos0 + ln_, idx = d ? (SEQ - 1 - pos) : pos;
                F.bonus[(rbase + idx) * 16 + h * 2 + d] = (BONP[ln_] + BONP[64 + ln_]) + (BONP[128 + ln_] + BONP[192 + ln_]);
            }
            scur ^= 1;
            __syncthreads();
        }
    }
}
__device__ __forceinline__ void p5_readout(Frame& F, const bool own_panel) {
    const int gw = own_panel ? (int)blockIdx.x * 256 + F.wave : F.vcu * NWAVES + F.wave, NGW = own_panel ? NWAVES : F.G * NWAVES, lane = lane_id_();
    const int mend = own_panel ? (int)blockIdx.x * 256 + 256 : ML;
    const int c8 = 8 * lane, hd = lane >> 3;
    float cw0[8], cw2[8], gw_[8], gb_[8];
#pragma unroll
    for (int e = 0; e < 8; ++e) { cw0[e] = F.conv_w[512 + c8 + e]; cw2[e] = F.conv_w[3584 + 512 + c8 + e]; gw_[e] = F.gn_w[c8 + e]; gb_[e] = F.gn_b[c8 + e]; }
    const bf16* EDGE = (const bf16*)(F.ws + WS_EDGE);
    for (int m0 = gw; m0 < mend; m0 += 2 * NGW) {
        v4u ya[2], yb[2], v0[2], ve[2], gg[2]; float bon[2]; bool ok[2], npv[2];
        const v4u z = {0u, 0u, 0u, 0u};
#pragma unroll
        for (int u = 0; u < 2; ++u) {
            const int m = m0 + u * NGW; ok[u] = m < mend; const int mm = ok[u] ? m : m0;
            const int tl = mm & (SEQ - 1), em = mm & 255; const bool np = em == 0 && tl > 0, nx = em == 255 && tl + 1 < SEQ;
            ya[u] = *(const GAS v4u*)((const bf16*)F.Y + (size_t)mm * 512 + c8); yb[u] = *(const GAS v4u*)((const bf16*)F.Y + ((size_t)ML + mm) * 512 + c8);
            const bf16* prow = F.P + (size_t)mm * PW;
            v0[u] = *(const GAS v4u*)(prow + PC_RWV + c8); npv[u] = np;
            ve[u] = (np || nx) ? *(const GAS v4u*)(EDGE + (size_t)((np ? (mm >> 8) - 1 : (mm >> 8) + 1) * 2 + (np ? 1 : 0)) * 1792 + 512 + c8) : z;
            gg[u] = *(const GAS v4u*)(prow + PC_RWG + c8);
            bon[u] = F.bonus[(size_t)mm * 16 + hd * 2] + F.bonus[(size_t)mm * 16 + hd * 2 + 1];
        }
#pragma unroll
        for (int u = 0; u < 2; ++u) {
            float y[8];
#pragma unroll
            for (int e2 = 0; e2 < 4; ++e2) { y[2 * e2] = __uint_as_float(ya[u][e2] << 16) + __uint_as_float(yb[u][e2] << 16); y[2 * e2 + 1] = __uint_as_float(ya[u][e2] & 0xffff0000u) + __uint_as_float(yb[u][e2] & 0xffff0000u); }
            float s = 0.f;
#pragma unroll
            for (int e = 0; e < 8; ++e) s += y[e];
            s = red8(s);
            const float mu = s * (1.f / 64.f); float q = 0.f;
#pragma unroll
            for (int e = 0; e < 8; ++e) { y[e] -= mu; q += y[e] * y[e]; }
            q = red8(q);
            const float rstd = rsqrtf(q * (1.f / 64.f) + GN_EPS);
            float o[8];
#pragma unroll
            for (int e2 = 0; e2 < 4; ++e2) {
#pragma unroll
                for (int hb = 0; hb < 2; ++hb) {
                    const int e = 2 * e2 + hb;
                    const float pv_0 = hb ? __uint_as_float(v0[u][e2] & 0xffff0000u) : __uint_as_float(v0[u][e2] << 16), pv_e = hb ? __uint_as_float(ve[u][e2] & 0xffff0000u) : __uint_as_float(ve[u][e2] << 16);
                    const float vc = pv_0 + (npv[u] ? cw0[e] : cw2[e]) * pv_e;
                    const float g = hb ? __uint_as_float(gg[u][e2] & 0xffff0000u) : __uint_as_float(gg[u][e2] << 16);
                    const float yn = y[e] * rstd * gw_[e] + gb_[e];
                    o[e] = (yn + bon[u] * vc) * siluf_(g);
                }
            }
            if (ok[u]) { v4u w; w.x = cvtpk(o[0], o[1]); w.y = cvtpk(o[2], o[3]); w.z = cvtpk(o[4], o[5]); w.w = cvtpk(o[6], o[7]);
                *(GAS v4u*)(F.MIX + (size_t)(m0 + u * NGW) * DM + 512 + c8) = w; }
        }
    }
}
__device__ __forceinline__ void p7_final(Frame& F) {
    const int gw = F.vcu * NWAVES + F.wave, NGW = F.G * NWAVES;
    for (int m = gw; m < ML; m += NGW) {
        const float rstd = rsqrtf(__hip_atomic_load(F.sumsq + m, __ATOMIC_RELAXED, __HIP_MEMORY_SCOPE_AGENT) * (1.f / DM) + RMS_EPS);
        GAS f32x4* o = (GAS f32x4*)(F.out + (size_t)m * DM) + lane_id_();
#pragma unroll
        for (int j = 0; j < 4; ++j) { const f32x4 g = *(const f32x4*)(F.final_g + 4 * (lane_id_() + 64 * j)); o[64 * j] = o[64 * j] * rstd * g; }
    }
}

struct Args { const float* in[21]; float* out; unsigned char* ws; };
__global__ void __launch_bounds__(NWAVES * 64, 2) mk_fwd(Args args) {
    extern __shared__ __attribute__((aligned(16))) unsigned char lds[];
    Frame F;
    F.lds = (LAS unsigned char*)lds;
    volatile LAS unsigned* MISC = (volatile LAS unsigned*)(F.lds + MISC_OFF);
    F.wave = __builtin_amdgcn_readfirstlane((int)threadIdx.x >> 6);
    F.G = gridDim.x; { const int bx = blockIdx.x; F.vcu = (F.G % 8 == 0) ? (bx % 8) * (F.G / 8) + bx / 8 : bx; }
    unsigned char* ws = args.ws;
    gu32* ctl = (gu32*)(ws + WS_CTL);
    F.x = args.in[0]; F.c = args.in[1]; F.ctx = args.in[2]; F.c_ctx = args.in[3]; F.w_mod = args.in[4]; F.b_mod = args.in[5]; F.norm_g = args.in[6]; F.w_in = args.in[7];
    F.conv_w = args.in[8]; F.decay_w0 = args.in[9]; F.decay_w2 = args.in[10]; F.aaa_a0 = args.in[11]; F.aaa_a2 = args.in[12]; F.k_k = args.in[13]; F.k_a = args.in[14];
    F.r_k = args.in[15]; F.gn_w = args.in[16]; F.gn_b = args.in[17]; F.na_rpb = args.in[18]; F.w_out = args.in[19]; F.final_g = args.in[20];
    F.out = args.out; F.ws = args.ws;
    F.mod = (float*)(ws + WS_MOD); F.sumsq = (float*)(ws + WS_SUMSQ); F.bonus = (float*)(ws + WS_BONUS);
    F.WoutT = (bf16*)(ws + WS_WOUT); F.WinT = (bf16*)(ws + WS_WIN); F.XN = (bf16*)(ws + WS_XN); F.P = (bf16*)(ws + WS_P); F.VT = (bf16*)(ws + WS_VT); F.MIX = (bf16*)(ws + WS_MIX); F.Y = (bf16*)(ws + WS_Y);
    if (F.wave == 0) ((LAS unsigned*)(F.lds + MISC_OFF))[lane_id_()] = 0u;
    __syncthreads();
    XcdBarrier bar = xcd_barrier_post((unsigned*)(ctl + CW_BAR), MISC + 8, F.wave == 0 && lane_id_() == 0);

    p0_prologue(F);
    xcd_barrier(bar);
    p1_xn(F, 16, 17);
    xcd_barrier(bar);
    {
        static_assert(WS_XN == 64 * (512u << 10) && WS_WIN == 8 * (512u << 10), "absolute panel indices of MergedOrder");
        pg8::Gemm g{(const pg8::bf16_t*)ws, (const pg8::bf16_t*)ws, MT, PW, DM}; pg8::MergedOrder S; S.init(F.G, (int)blockIdx.x);
        pg8::EpiMerged E{F.P, F.VT, PW, VTP, (pg8::bf16_t*)(ws + WS_EDGE), F.lds};
        { LAS float* CWL = (LAS float*)(F.lds + pg8::EPI_CW_OFF); for (int e = F.wave * 64 + lane_id_(); e < 3 * 1792; e += NWAVES * 64) CWL[e] = F.conv_w[e]; }
        __syncthreads();
        S.base = 4352; S.limit = 4496;
        pg8::gemm_phase<pg8::EpiMerged, pg8::MergedOrder, true, true>(F.lds, g, S, E, F.wave);
        if (F.G == 256) p1_lat_weighted(F); else p1_xn(F, 0, 16);
        xcd_barrier(bar);
        S.base = 0; S.limit = 4352;
        pg8::gemm_phase<pg8::EpiMerged, pg8::MergedOrder, true, true>(F.lds, g, S, E, F.wave);
    }
    xcd_barrier(bar);
    p3_attention(F);
    __syncthreads();
    p4_scan(F);
    xcd_barrier(bar);
    p5_readout(F, F.G == 256);
    if (F.G != 256) xcd_barrier(bar);
    if (F.G == 256) {
        LAS float* ssq = (LAS float*)(F.lds + 131072);
        const int lane2 = lane_id_();
        if (F.wave < 4) ssq[F.wave * 64 + lane2] = 0.f;
        asm volatile("s_waitcnt vmcnt(0)" ::: "memory");
        __syncthreads();
        pg8::Gemm g{F.MIX, F.WoutT, ML, DM, DM}; pg8::PanelOrder S; S.init(F.G, (int)blockIdx.x);
        pg8::EpiOutH E{F.x, F.mod, (pg8::bf16_t*)F.XN, ssq, F.out, F.final_g, RMS_EPS};
        pg8::gemm_phase<pg8::EpiOutH, pg8::PanelOrder, true, true>(F.lds, g, S, E, F.wave);
        __syncthreads();
        const int pm = (int)blockIdx.x;
        f32x4 fg[2][2];
#pragma unroll
        for (int j = 0; j < 2; ++j)
#pragma unroll
            for (int n = 0; n < 2; ++n) fg[j][n] = *(const f32x4*)(F.final_g + 512 * j + 8 * lane2 + 4 * n);
        for (int r = F.wave * 32; r < F.wave * 32 + 32; r += 4) {
            v4u hv[4][2];
#pragma unroll
            for (int u = 0; u < 4; ++u)
#pragma unroll
                for (int j = 0; j < 2; ++j) if (j == 0 || lane2 < 32) hv[u][j] = *(const GAS v4u*)(F.XN + ((size_t)pm * 256 + r + u) * DM + 512 * j + 8 * lane2);
#pragma unroll
            for (int u = 0; u < 4; ++u) {
                const float rs = rsqrtf(ssq[r + u] * (1.f / DM) + RMS_EPS);
                GAS f32x4* o = (GAS f32x4*)(F.out + ((size_t)pm * 256 + r + u) * DM + 8 * lane2);
#pragma unroll
                for (int j = 0; j < 2; ++j) {
                    const v4u h4 = hv[u][j];
                    const f32x4 a = {__uint_as_float(h4.x << 16), __uint_as_float(h4.x & 0xffff0000u), __uint_as_float(h4.y << 16), __uint_as_float(h4.y & 0xffff0000u)};
                    const f32x4 c = {__uint_as_float(h4.z << 16), __uint_as_float(h4.z & 0xffff0000u), __uint_as_float(h4.w << 16), __uint_as_float(h4.w & 0xffff0000u)};
                    if (j == 0 || lane2 < 32) { o[128 * j] = a * rs * fg[j][0]; o[128 * j + 1] = c * rs * fg[j][1]; }
                }
            }
        }
    } else {
        { pg8::Gemm g{F.MIX, F.WoutT, ML, DM, DM}; pg8::StaticOrder S; S.init(ML, DM, F.G, (int)blockIdx.x);
          pg8::EpiOut E{F.x, F.mod, F.out, F.sumsq};
          pg8::gemm_phase<pg8::EpiOut, pg8::StaticOrder, true, true>(F.lds, g, S, E, F.wave); }
        xcd_barrier(bar);
        p7_final(F);
    }
}

extern "C" void kernel_launch(void* const* d_in, const int* in_sizes, int n_in, void* d_out, int out_size, void* d_ws, size_t ws_size, hipStream_t stream) {
    static int grid = 0;
    if (grid == 0) {
        if (n_in != 21 || out_size != ML * DM || ws_size < WS_END) { fprintf(stderr, "kernel_launch: unexpected shapes (n_in %d, out %d, ws %zu)\n", n_in, out_size, ws_size); grid = -1; return; }
        int dev = 0, cus = 0, per_cu = 0;
        if (hipGetDevice(&dev) != hipSuccess || hipDeviceGetAttribute(&cus, hipDeviceAttributeMultiprocessorCount, dev) != hipSuccess) { grid = -1; return; }
        if (hipFuncSetAttribute((const void*)mk_fwd, hipFuncAttributeMaxDynamicSharedMemorySize, LDS_BYTES) != hipSuccess) { fprintf(stderr, "kernel_launch: hipFuncSetAttribute failed\n"); grid = -1; return; }
        if (hipOccupancyMaxActiveBlocksPerMultiprocessor(&per_cu, (const void*)mk_fwd, NWAVES * 64, LDS_BYTES) != hipSuccess || per_cu < 1) { fprintf(stderr, "kernel_launch: occupancy query says %d\n", per_cu); }
        (void)hipGetLastError();
        grid = cus;
    }
    if (grid < 0) return;
    if (hipMemsetAsync((char*)d_ws + WS_CTL, 0, CTL_ZERO_BYTES, stream) != hipSuccess) return;
    Args a{};
    for (int i = 0; i < 21; ++i) a.in[i] = (const float*)d_in[i];
    a.out = (float*)d_out; a.ws = (unsigned char*)d_ws;
    hipLaunchKernelGGL(mk_fwd, dim3(grid), dim3(NWAVES * 64), LDS_BYTES, stream, a);
}
```
